# Optimizing an MI355X kernel written in HIP

```python
import math
import jax, jax.numpy as jnp
from jax import lax
import numpy as np

D_MODEL = 1024
BATCH = 4
SEQ = 8192
DEPTH = 2

N_META = 16
CONV_WIDTH = 512
CONV_GROUPS = 8
CONV_K = 3
GDN_HEADS = 4
GDN_DK = 128
GDN_DV = 128
GDN_CONV_K = 4
GDN_CHUNK = 64
D_MIX = CONV_WIDTH + GDN_HEADS * GDN_DV
QKV_COLS = GDN_HEADS * (2 * GDN_DK + GDN_DV)
PROJ_COLS = 3 * CONV_WIDTH + QKV_COLS + GDN_HEADS * GDN_DV + 2 * GDN_HEADS
PEER_HEADS = 8
PEER_NKEYS = 128
PEER_N_EXPERTS = PEER_NKEYS * PEER_NKEYS
PEER_DKEY = 256
PEER_TOPK = 16
PEER_BLOCK = 256
DEEPNORM_ALPHA = (2.0 * DEPTH) ** 0.25
DEEPNORM_BETA = (8.0 * DEPTH) ** -0.25
LN_EPS = 1e-5
RMS_EPS = 1e-6

kernel_name = "hymba_conv_gdn_peer_deepnorm"


def layer_norm(x, g, b):
    xf = x.astype(jnp.float32)
    mu = xf.mean(-1, keepdims=True)
    var = jnp.square(xf - mu).mean(-1, keepdims=True)
    return ((xf - mu) * lax.rsqrt(var + LN_EPS) * g.astype(jnp.float32) + b.astype(jnp.float32)).astype(x.dtype)


def causal_dwconv(x, w):
    K = w.shape[0]
    L = x.shape[1]
    xp = jnp.pad(x, ((0, 0), (K - 1, 0), (0, 0)))
    y = xp[:, 0:L] * w[0]
    for j in range(1, K):
        y = y + xp[:, j:j + L] * w[j]
    return y


def l2norm(x):
    return x * lax.rsqrt(jnp.sum(x * x, axis=-1, keepdims=True) + RMS_EPS)


def gated_delta_rule_chunked(q, k, v, g, beta):
    Bb, H, T, DK = q.shape
    DV = v.shape[-1]
    C = GDN_CHUNK
    N = T // C
    q = q * (DK ** -0.5)
    q = q.reshape(Bb, H, N, C, DK)
    k = k.reshape(Bb, H, N, C, DK)
    v = v.reshape(Bb, H, N, C, DV)
    g = jnp.cumsum(g.reshape(Bb, H, N, C), axis=-1)
    beta = beta.reshape(Bb, H, N, C)
    causal = jnp.tril(jnp.ones((C, C), dtype=bool))
    strict = jnp.tril(jnp.ones((C, C), dtype=bool), -1)
    gdiff = g[..., :, None] - g[..., None, :]
    decay = jnp.where(causal, jnp.exp(jnp.where(causal, gdiff, 0.0)), 0.0)
    k_beta = k * beta[..., None]
    v_beta = v * beta[..., None]
    A = jnp.where(strict, jnp.einsum('bhncd,bhnsd->bhncs', k_beta, k) * decay, 0.0)
    eye = jnp.eye(C, dtype=q.dtype)
    t_inv = lax.linalg.triangular_solve(eye + A, jnp.broadcast_to(eye, A.shape),
                                        left_side=True, lower=True, unit_diagonal=True)
    u = jnp.einsum('bhncs,bhnsv->bhncv', t_inv, v_beta)
    w = jnp.einsum('bhncs,bhnsd->bhncd', t_inv, k_beta * jnp.exp(g)[..., None])
    attn_intra = jnp.where(causal, jnp.einsum('bhncd,bhnsd->bhncs', q, k) * decay, 0.0)
    g_last = g[..., -1]
    k_dec = k * jnp.exp(g_last[..., None] - g)[..., None]
    q_dec = q * jnp.exp(g)[..., None]

    def step(S, inp):
        q_c, k_c, u_c, w_c, a_c, gl_c = inp
        v_new = u_c - jnp.einsum('bhcd,bhdv->bhcv', w_c, S)
        o_c = jnp.einsum('bhcd,bhdv->bhcv', q_c, S) + jnp.einsum('bhcs,bhsv->bhcv', a_c, v_new)
        S = S * jnp.exp(gl_c)[..., None, None] + jnp.einsum('bhcd,bhcv->bhdv', k_c, v_new)
        return S, o_c

    to_front = lambda t: jnp.moveaxis(t, 2, 0)
    xs = (to_front(q_dec), to_front(k_dec), to_front(u), to_front(w), to_front(attn_intra), to_front(g_last))
    S0 = jnp.zeros((Bb, H, DK, DV), dtype=q.dtype)
    _, o = lax.scan(step, S0, xs)
    return jnp.moveaxis(o, 0, 2).reshape(Bb, H, T, DV)


def hybrid_mixer(x, w_in, conv_w, gdn_conv_w, a_log, dt_bias, gdn_norm_w, w_out):
    Bb, L, _ = x.shape
    proj = x @ w_in
    s0 = CONV_WIDTH
    s1 = 2 * CONV_WIDTH
    s2 = 3 * CONV_WIDTH
    s3 = s2 + QKV_COLS
    s4 = s3 + GDN_HEADS * GDN_DV
    s5 = s4 + GDN_HEADS
    cb, cc, ch, qkv, z, a, b = jnp.split(proj, [s0, s1, s2, s3, s4, s5], axis=-1)

    y_conv = cb * causal_dwconv(cc * ch, conv_w)

    qkv = jax.nn.silu(causal_dwconv(qkv, gdn_conv_w)).astype(jnp.float32)
    q, k, v = jnp.split(qkv, [GDN_HEADS * GDN_DK, 2 * GDN_HEADS * GDN_DK], axis=-1)
    q = l2norm(q.reshape(Bb, L, GDN_HEADS, GDN_DK))
    k = l2norm(k.reshape(Bb, L, GDN_HEADS, GDN_DK))
    v = v.reshape(Bb, L, GDN_HEADS, GDN_DV)
    g = -jnp.exp(a_log.astype(jnp.float32)) * jax.nn.softplus(a.astype(jnp.float32) + dt_bias.astype(jnp.float32))
    beta = jax.nn.sigmoid(b.astype(jnp.float32))
    pad = (-N_META) % GDN_CHUNK
    p4 = ((0, 0), (pad, 0), (0, 0), (0, 0))
    p3 = ((0, 0), (pad, 0), (0, 0))
    qh = jnp.pad(q, p4).transpose(0, 2, 1, 3)
    kh = jnp.pad(k, p4).transpose(0, 2, 1, 3)
    vh = jnp.pad(v, p4).transpose(0, 2, 1, 3)
    gh = jnp.pad(g, p3).transpose(0, 2, 1)
    bh = jnp.pad(beta, p3).transpose(0, 2, 1)
    o = gated_delta_rule_chunked(qh, kh, vh, gh, bh)[:, :, pad:]
    o = o.transpose(0, 2, 1, 3)
    zf = z.astype(jnp.float32).reshape(Bb, L, GDN_HEADS, GDN_DV)
    o = o * lax.rsqrt(jnp.mean(o * o, axis=-1, keepdims=True) + RMS_EPS) * gdn_norm_w.astype(jnp.float32) * jax.nn.silu(zf)
    y_gdn = o.reshape(Bb, L, GDN_HEADS * GDN_DV).astype(x.dtype)

    return jnp.concatenate([y_conv.astype(x.dtype), y_gdn], axis=-1) @ w_out


def peer_ffn(x, w_q, sub_k1, sub_k2, expert_u, expert_v):
    Bb, L, D = x.shape
    T = Bb * L
    n_blk = -(-T // PEER_BLOCK)
    xt = jnp.pad(x.reshape(T, D), ((0, n_blk * PEER_BLOCK - T), (0, 0))).reshape(n_blk, PEER_BLOCK, D)
    half = PEER_DKEY // 2

    def block(xb):
        q = (xb @ w_q).astype(jnp.float32).reshape(PEER_BLOCK, PEER_HEADS, 2, half)
        s1 = jnp.einsum('thd,kd->thk', q[:, :, 0], sub_k1.astype(jnp.float32))
        s2 = jnp.einsum('thd,kd->thk', q[:, :, 1], sub_k2.astype(jnp.float32))
        t1, i1 = lax.top_k(s1, PEER_TOPK)
        t2, i2 = lax.top_k(s2, PEER_TOPK)
        cand = (t1[..., :, None] + t2[..., None, :]).reshape(PEER_BLOCK, PEER_HEADS, PEER_TOPK * PEER_TOPK)
        top, ci = lax.top_k(cand, PEER_TOPK)
        e1 = jnp.take_along_axis(i1, ci // PEER_TOPK, axis=-1)
        e2 = jnp.take_along_axis(i2, ci % PEER_TOPK, axis=-1)
        idx = (e1 * PEER_NKEYS + e2).reshape(PEER_BLOCK, PEER_HEADS * PEER_TOPK)
        gate = jax.nn.softmax(top, axis=-1).reshape(PEER_BLOCK, PEER_HEADS * PEER_TOPK)
        u = expert_u[idx]
        act = jax.nn.gelu(jnp.einsum('td,ted->te', xb, u).astype(jnp.float32), approximate=False)
        coef = (gate * act).astype(xb.dtype)
        v = expert_v[idx]
        return jnp.einsum('te,ted->td', coef, v)

    y = lax.map(block, xt)
    return y.reshape(n_blk * PEER_BLOCK, D)[:T].reshape(Bb, L, D)


def setup_inputs(seed: int = 0) -> dict:
    key = jax.random.key(seed)
    ks = jax.random.split(key, 24)
    f32 = jnp.float32
    nrm = lambda k, shape, s: jax.random.normal(k, shape, f32) * s
    dt = jnp.exp(jax.random.uniform(ks[7], (DEPTH, GDN_HEADS), f32, math.log(1e-3), math.log(1e-1)))
    return {
        "x": jax.random.normal(ks[0], (BATCH, SEQ, D_MODEL), f32),
        "meta_tokens": nrm(ks[1], (N_META, D_MODEL), 1.0),
        "ln_in_g": 1.0 + nrm(ks[2], (D_MODEL,), 0.02),
        "ln_in_b": nrm(ks[3], (D_MODEL,), 0.02),
        "w_in": nrm(ks[4], (DEPTH, D_MODEL, PROJ_COLS), D_MODEL ** -0.5),
        "conv_w": nrm(ks[5], (DEPTH, CONV_K, CONV_WIDTH), CONV_K ** -0.5),
        "gdn_conv_w": nrm(ks[6], (DEPTH, GDN_CONV_K, QKV_COLS), GDN_CONV_K ** -0.5),
        "a_log": jnp.log(jax.random.uniform(ks[8], (DEPTH, GDN_HEADS), f32, 1.0, 16.0)),
        "dt_bias": dt + jnp.log(-jnp.expm1(-dt)),
        "gdn_norm_w": 1.0 + nrm(ks[9], (DEPTH, GDN_DV), 0.02),
        "w_out": nrm(ks[10], (DEPTH, D_MIX, D_MODEL), D_MIX ** -0.5 * DEEPNORM_BETA),
        "ln1_g": 1.0 + nrm(ks[11], (DEPTH, D_MODEL), 0.02),
        "ln1_b": nrm(ks[12], (DEPTH, D_MODEL), 0.02),
        "peer_w_q": nrm(ks[13], (DEPTH, D_MODEL, PEER_HEADS * PEER_DKEY), D_MODEL ** -0.5),
        "peer_k1": nrm(ks[14], (DEPTH, PEER_NKEYS, PEER_DKEY // 2), (PEER_DKEY // 2) ** -0.5),
        "peer_k2": nrm(ks[15], (DEPTH, PEER_NKEYS, PEER_DKEY // 2), (PEER_DKEY // 2) ** -0.5),
        "peer_u": nrm(ks[16], (DEPTH, PEER_N_EXPERTS, D_MODEL), D_MODEL ** -0.5),
        "peer_v": nrm(ks[17], (DEPTH, PEER_N_EXPERTS, D_MODEL), (PEER_HEADS * PEER_TOPK) ** -0.5 * DEEPNORM_BETA),
        "ln2_g": 1.0 + nrm(ks[18], (DEPTH, D_MODEL), 0.02),
        "ln2_b": nrm(ks[19], (DEPTH, D_MODEL), 0.02),
    }


def reference(x, meta_tokens, ln_in_g, ln_in_b, w_in, conv_w, gdn_conv_w, a_log, dt_bias, gdn_norm_w,
              w_out, ln1_g, ln1_b, peer_w_q, peer_k1, peer_k2, peer_u, peer_v, ln2_g, ln2_b):
    Bb = x.shape[0]
    meta = jnp.broadcast_to(meta_tokens[None].astype(x.dtype), (Bb, N_META, D_MODEL))
    h = jnp.concatenate([meta, x], axis=1)
    h = layer_norm(h, ln_in_g, ln_in_b)
    for l in range(DEPTH):
        mix = hybrid_mixer(h, w_in[l], conv_w[l], gdn_conv_w[l], a_log[l], dt_bias[l], gdn_norm_w[l], w_out[l])
        h = layer_norm(DEEPNORM_ALPHA * h + mix, ln1_g[l], ln1_b[l])
        ffn = peer_ffn(h, peer_w_q[l], peer_k1[l], peer_k2[l], peer_u[l], peer_v[l])
        h = layer_norm(DEEPNORM_ALPHA * h + ffn, ln2_g[l], ln2_b[l])
    return h[:, N_META:]
```

```cpp
#include <hip/hip_runtime.h>
#include <hip/hip_cooperative_groups.h>
#include <cstdio>
namespace cg = cooperative_groups;

typedef unsigned short u16;
typedef unsigned int u32;
using bf16x8 = __attribute__((ext_vector_type(8))) short;
using s16x4 = __attribute__((ext_vector_type(4))) short;
using f32x4 = __attribute__((ext_vector_type(4))) float;
using f32x2 = __attribute__((ext_vector_type(2))) float;

#define DI __device__ __forceinline__
#define MFMA16(a, b, c) __builtin_amdgcn_mfma_f32_16x16x32_bf16((a), (b), (c), 0, 0, 0)

constexpr int NB = 4, SEQ = 8192, NMETA = 16, DM = 1024;
constexpr int LP = 8256;
constexpr int PADR = 48;
constexpr int MR = NB * LP;
constexpr int NCH = 129;
constexpr int NPROJ = 3592, NPROJP = 3712;
constexpr float ALPHA = 1.4142135623730951f;
constexpr float LN_EPS = 1e-5f, RMS_EPS = 1e-6f;
constexpr float TSCALE = 64.0f, TINV = 1.0f / 64.0f;

constexpr size_t SZ_HB = (size_t)MR * 1024 * 2;
constexpr size_t OFF_HB = 0;
constexpr size_t OFF_R1 = OFF_HB + SZ_HB;
constexpr size_t SZ_R1 = (size_t)MR * 3072 * 2;
constexpr size_t OFF_ZB = OFF_R1 + SZ_R1;
constexpr size_t SZ_ZB = (size_t)MR * 512 * 2;
constexpr size_t OFF_QKV = OFF_ZB + SZ_ZB;
constexpr size_t SZ_QKV = (size_t)MR * 1536 * 2;
constexpr size_t OFF_TAB = OFF_QKV + SZ_HB;
constexpr size_t OFF_YB = OFF_QKV + SZ_QKV;
constexpr size_t OFF_AB = OFF_YB + SZ_HB;
constexpr size_t SZ_AB = (size_t)MR * 8 * 4;
constexpr size_t OFF_GB = OFF_AB + SZ_AB;
constexpr size_t OFF_WIN = OFF_GB + SZ_AB;
constexpr size_t SZ_WIN1 = (size_t)NPROJP * 1024 * 2;
constexpr size_t OFF_WOUT = OFF_WIN + 2 * SZ_WIN1;
constexpr size_t SZ_WOUT1 = (size_t)1024 * 1024 * 2;
constexpr size_t OFF_WQ = OFF_WOUT + 2 * SZ_WOUT1;
constexpr size_t SZ_WQ1 = (size_t)2048 * 1024 * 2;
constexpr size_t OFF_SK = OFF_WQ + 2 * SZ_WQ1;
constexpr size_t SZ_SK1 = (size_t)2 * 128 * 128 * 2;
constexpr size_t WS_NEED = OFF_SK + 2 * SZ_SK1;
constexpr size_t REC_BYTES = 58368;
constexpr size_t OFF_IDX = OFF_R1 + (size_t)MR * 2048 * 2;
constexpr size_t OFF_GATE = OFF_IDX + (size_t)MR * 128 * 4;
static_assert((size_t)NB * NCH * 4 * REC_BYTES <= SZ_R1, "rec");
static_assert(OFF_GATE + (size_t)MR * 128 * 4 <= OFF_R1 + SZ_R1, "idx");
static_assert((size_t)2 * 16384 * 1024 <= SZ_QKV - SZ_HB, "tab");
static_assert(WS_NEED <= (size_t)512 * 1024 * 1024, "ws");

struct Params {
  const float* x; const float* meta; const float* ln_in_g; const float* ln_in_b;
  const float* w_in; const float* conv_w; const float* gdn_conv_w; const float* a_log; const float* dt_bias;
  const float* gdn_norm_w; const float* w_out; const float* ln1_g; const float* ln1_b;
  const float* w_q; const float* k1; const float* k2; const float* pu; const float* pv;
  const float* ln2_g; const float* ln2_b;
  float* out; char* ws;
};

DI int opq(int x) { asm volatile("" : "+v"(x)); return x; }
DI char* opqp(char* w) { long z = 0; asm volatile("" : "+s"(z)); return w + z; }
DI int opqs(int x) { asm volatile("" : "+s"(x)); return x; }
#define SCHED_FENCE __builtin_amdgcn_sched_barrier(0)
DI u16 f2bf(float x) { u32 u = __float_as_uint(x); u += 0x7fffu + ((u >> 16) & 1u); return (u16)(u >> 16); }
DI float bf2f(u16 h) { return __uint_as_float(((u32)h) << 16); }
DI u32 pack2(float a, float b) { return (u32)f2bf(a) | ((u32)f2bf(b) << 16); }
DI float bflo(u32 w) { return __uint_as_float(w << 16); }
DI float bfhi(u32 w) { return __uint_as_float(w & 0xffff0000u); }
DI float wsum(float v) {
#pragma unroll
  for (int o = 32; o > 0; o >>= 1) v += __shfl_xor(v, o);
  return v;
}
DI float erf_as(float x) {
  const float ax = fabsf(x);
  const float t = 1.0f / (1.0f + 0.3275911f * ax);
  const float poly = t * (0.254829592f + t * (-0.284496736f + t * (1.421413741f + t * (-1.453152027f + t * 1.061405429f))));
  const float r = 1.0f - poly * __expf(-ax * ax);
  return x < 0.f ? -r : r;
}
DI float siluf(float x) { return x / (1.0f + __expf(-x)); }
DI void unpack8(const uint4& v, float* f) {
  f[0] = bflo(v.x); f[1] = bfhi(v.x); f[2] = bflo(v.y); f[3] = bfhi(v.y);
  f[4] = bflo(v.z); f[5] = bfhi(v.z); f[6] = bflo(v.w); f[7] = bfhi(v.w);
}
DI uint4 pack8(const float* f) {
  uint4 v; v.x = pack2(f[0], f[1]); v.y = pack2(f[2], f[3]); v.z = pack2(f[4], f[5]); v.w = pack2(f[6], f[7]); return v;
}
DI bf16x8 pack_acc2(const f32x4& a, const f32x4& b) {
  uint4 v; v.x = pack2(a[0], a[1]); v.y = pack2(a[2], a[3]); v.z = pack2(b[0], b[1]); v.w = pack2(b[2], b[3]);
  return __builtin_bit_cast(bf16x8, v);
}
DI bf16x8 read2x4(const u16* p, int c0, int c1) {
  uint2 lo = *(const uint2*)(p + c0);
  uint2 hi = *(const uint2*)(p + c1);
  uint4 v; v.x = lo.x; v.y = lo.y; v.z = hi.x; v.w = hi.y;
  return __builtin_bit_cast(bf16x8, v);
}
DI u32 enc_fp8x4(float a, float b, float c, float d) {
  int v = 0;
  v = __builtin_amdgcn_cvt_pk_fp8_f32(a, b, v, false);
  v = __builtin_amdgcn_cvt_pk_fp8_f32(c, d, v, true);
  return (u32)v;
}
DI void dec_fp8x16(const uint4& v, float* f) {
  f32x2 t;
  t = __builtin_amdgcn_cvt_pk_f32_fp8((int)v.x, false); f[0] = t[0]; f[1] = t[1];
  t = __builtin_amdgcn_cvt_pk_f32_fp8((int)v.x, true);  f[2] = t[0]; f[3] = t[1];
  t = __builtin_amdgcn_cvt_pk_f32_fp8((int)v.y, false); f[4] = t[0]; f[5] = t[1];
  t = __builtin_amdgcn_cvt_pk_f32_fp8((int)v.y, true);  f[6] = t[0]; f[7] = t[1];
  t = __builtin_amdgcn_cvt_pk_f32_fp8((int)v.z, false); f[8] = t[0]; f[9] = t[1];
  t = __builtin_amdgcn_cvt_pk_f32_fp8((int)v.z, true);  f[10] = t[0]; f[11] = t[1];
  t = __builtin_amdgcn_cvt_pk_f32_fp8((int)v.w, false); f[12] = t[0]; f[13] = t[1];
  t = __builtin_amdgcn_cvt_pk_f32_fp8((int)v.w, true);  f[14] = t[0]; f[15] = t[1];
}
DI u32 orderable(float f) { u32 u = __float_as_uint(f); return u ^ ((u >> 31) ? 0xffffffffu : 0x80000000u); }
#define INS16(v, xx) { u32 _x = (xx); _Pragma("unroll") for (int _i = 0; _i < 16; ++_i) { u32 _h = max(v[_i], _x); _x = min(v[_i], _x); v[_i] = _h; } }

DI void ln_row16(float* v, const float* __restrict__ g, const float* __restrict__ b, int lane) {
  float s = 0.f;
#pragma unroll
  for (int i = 0; i < 16; ++i) s += v[i];
  float mu = wsum(s) * (1.0f / 1024.0f);
  float q = 0.f;
#pragma unroll
  for (int i = 0; i < 16; ++i) { float d = v[i] - mu; q += d * d; }
  float var = wsum(q) * (1.0f / 1024.0f);
  float rs = rsqrtf(var + LN_EPS);
#pragma unroll
  for (int i4 = 0; i4 < 4; ++i4) {
    float4 gg = *(const float4*)(g + lane * 16 + i4 * 4);
    float4 bb = *(const float4*)(b + lane * 16 + i4 * 4);
    v[i4 * 4 + 0] = (v[i4 * 4 + 0] - mu) * rs * gg.x + bb.x;
    v[i4 * 4 + 1] = (v[i4 * 4 + 1] - mu) * rs * gg.y + bb.y;
    v[i4 * 4 + 2] = (v[i4 * 4 + 2] - mu) * rs * gg.z + bb.z;
    v[i4 * 4 + 3] = (v[i4 * 4 + 3] - mu) * rs * gg.w + bb.w;
  }
}
DI void store_row16_bf16(u16* dst, const float* v, int lane) {
  *(uint4*)(dst + lane * 16) = pack8(v);
  *(uint4*)(dst + lane * 16 + 8) = pack8(v + 8);
}

DI void transpose_convert(const float* __restrict__ W, int K, int N, int Npad, u16* __restrict__ Wt, char* smem) {
  float* tile = (float*)smem;
  const int tid = opq(threadIdx.x);
  const int ntn = Npad / 64, ntk = K / 64;
  for (int t = blockIdx.x; t < ntn * ntk; t += gridDim.x) {
    const int n0 = (t % ntn) * 64, k0 = (t / ntn) * 64;
#pragma unroll 4
    for (int i = 0; i < 16; ++i) {
      int idx = tid + i * 256; int kk = idx >> 6, nn = idx & 63;
      float val = (n0 + nn < N) ? W[(size_t)(k0 + kk) * N + n0 + nn] : 0.f;
      tile[kk * 65 + nn] = val;
    }
    __syncthreads();
#pragma unroll 4
    for (int i = 0; i < 16; ++i) {
      int idx = tid + i * 256; int nn = idx >> 6, kk = idx & 63;
      Wt[(size_t)(n0 + nn) * K + k0 + kk] = f2bf(tile[kk * 65 + nn]);
    }
    __syncthreads();
  }
}

DI void phase_prologue(const Params& p, char* smem) {
  char* const WS = opqp(p.ws);
  const int tid = opq(threadIdx.x), lane = tid & 63, w = tid >> 6;
  u16* HB = (u16*)(WS + OFF_HB);
  for (int r = blockIdx.x * 4 + w; r < MR; r += gridDim.x * 4) {
    const int b = r / LP, pp = r % LP;
    float v[16];
    if (pp < PADR) {
#pragma unroll
      for (int i = 0; i < 16; ++i) v[i] = 0.f;
    } else {
      const float* src = (pp < 64) ? (p.meta + (size_t)(pp - PADR) * DM) : (p.x + ((size_t)b * SEQ + (pp - 64)) * DM);
#pragma unroll
      for (int i4 = 0; i4 < 4; ++i4) {
        float4 t = *(const float4*)(src + lane * 16 + i4 * 4);
        v[i4 * 4] = t.x; v[i4 * 4 + 1] = t.y; v[i4 * 4 + 2] = t.z; v[i4 * 4 + 3] = t.w;
      }
      ln_row16(v, p.ln_in_g, p.ln_in_b, lane);
    }
    store_row16_bf16(HB + (size_t)r * DM, v, lane);
  }
  for (int l = 0; l < 2; ++l) {
    transpose_convert(p.w_in + (size_t)l * 1024 * NPROJ, 1024, NPROJ, NPROJP, (u16*)(WS + OFF_WIN + l * SZ_WIN1), smem);
    transpose_convert(p.w_out + (size_t)l * 1024 * 1024, 1024, 1024, 1024, (u16*)(WS + OFF_WOUT + l * SZ_WOUT1), smem);
    transpose_convert(p.w_q + (size_t)l * 1024 * 2048, 1024, 2048, 2048, (u16*)(WS + OFF_WQ + l * SZ_WQ1), smem);
  }
  u16* SK = (u16*)(WS + OFF_SK);
  for (int i = blockIdx.x * 256 + tid; i < 2 * 2 * 16384; i += gridDim.x * 256) {
    int l = i >> 15, rem = i & 32767, hf = rem >> 14, e = rem & 16383;
    const float* src = (hf ? p.k2 : p.k1) + (size_t)l * 16384;
    SK[i] = f2bf(src[e]);
  }
}

DI void convert_tables(const Params& p, int l) {
  char* const WS = opqp(p.ws);
  u32* TAB = (u32*)(WS + OFF_TAB);
  const size_t n16 = (size_t)2 * 16384 * 1024 / 16;
  for (size_t i = (size_t)(opqs(blockIdx.x) * 256 + opq(threadIdx.x)); i < n16; i += (size_t)gridDim.x * 256) {
    const size_t e0 = i * 16;
    const int which = (int)(e0 >> 24);
    const size_t off = e0 & (((size_t)1 << 24) - 1);
    const float* src = (which ? p.pv : p.pu) + (size_t)l * 16384 * 1024 + off;
    uint4 o;
    float4 a = *(const float4*)(src), b = *(const float4*)(src + 4), c = *(const float4*)(src + 8), d = *(const float4*)(src + 12);
    o.x = enc_fp8x4(a.x * TSCALE, a.y * TSCALE, a.z * TSCALE, a.w * TSCALE);
    o.y = enc_fp8x4(b.x * TSCALE, b.y * TSCALE, b.z * TSCALE, b.w * TSCALE);
    o.z = enc_fp8x4(c.x * TSCALE, c.y * TSCALE, c.z * TSCALE, c.w * TSCALE);
    o.w = enc_fp8x4(d.x * TSCALE, d.y * TSCALE, d.z * TSCALE, d.w * TSCALE);
    *(uint4*)(TAB + i * 4) = o;
  }
}

template <int EPI>
DI void gemm_phase(const Params& p, size_t offA, size_t offB, int ntn, char* smem) {
  char* const WS = opqp(p.ws);
  const u16* __restrict__ A = (const u16*)(WS + offA);
  const u16* __restrict__ Bt = (const u16*)(WS + offB);
  constexpr int K = 1024, LDS_ST = 72;
  u16* As = (u16*)smem;
  u16* Bs = As + 2 * 128 * LDS_ST;
  const int tid = opq(threadIdx.x), lane = tid & 63, w = tid >> 6, wm = w >> 1, wn = w & 1;
  const int l15 = lane & 15, q = lane >> 4;
  const int ntm = MR / 128;
  for (int tile = blockIdx.x; tile < ntm * ntn; tile += gridDim.x) {
    const int tm = tile / ntn, tn = tile % ntn;
    const u16* Ag = A + (size_t)(tm * 128) * K;
    const u16* Bg = Bt + (size_t)(tn * 128) * K;
    f32x4 acc[4][4];
#pragma unroll
    for (int i = 0; i < 4; ++i)
#pragma unroll
      for (int j = 0; j < 4; ++j) acc[i][j] = (f32x4){0.f, 0.f, 0.f, 0.f};
    uint4 ra[4], rb[4];
#pragma unroll
    for (int i = 0; i < 4; ++i) {
      int idx = tid + i * 256; int row = idx >> 3, c = idx & 7;
      ra[i] = *(const uint4*)(Ag + (size_t)row * K + c * 8);
      rb[i] = *(const uint4*)(Bg + (size_t)row * K + c * 8);
    }
#pragma unroll
    for (int i = 0; i < 4; ++i) {
      int idx = tid + i * 256; int row = idx >> 3, c = idx & 7;
      *(uint4*)(As + row * LDS_ST + c * 8) = ra[i];
      *(uint4*)(Bs + row * LDS_ST + c * 8) = rb[i];
    }
    __syncthreads();
    constexpr int nk = K / 64;
    for (int kt = 0; kt < nk; ++kt) {
      const int cur = kt & 1;
      if (kt + 1 < nk) {
        const int k0 = (kt + 1) * 64;
#pragma unroll
        for (int i = 0; i < 4; ++i) {
          int idx = tid + i * 256; int row = idx >> 3, c = idx & 7;
          ra[i] = *(const uint4*)(Ag + (size_t)row * K + k0 + c * 8);
          rb[i] = *(const uint4*)(Bg + (size_t)row * K + k0 + c * 8);
        }
      }
      const u16* Ac = As + cur * 128 * LDS_ST;
      const u16* Bc = Bs + cur * 128 * LDS_ST;
#pragma unroll
      for (int kk = 0; kk < 2; ++kk) {
        bf16x8 af[4], bfr[4];
#pragma unroll
        for (int mt = 0; mt < 4; ++mt) af[mt] = *(const bf16x8*)(Ac + (wm * 64 + mt * 16 + l15) * LDS_ST + kk * 32 + q * 8);
#pragma unroll
        for (int nt = 0; nt < 4; ++nt) bfr[nt] = *(const bf16x8*)(Bc + (wn * 64 + nt * 16 + l15) * LDS_ST + kk * 32 + q * 8);
#pragma unroll
        for (int mt = 0; mt < 4; ++mt)
#pragma unroll
          for (int nt = 0; nt < 4; ++nt) acc[mt][nt] = MFMA16(bfr[nt], af[mt], acc[mt][nt]);
      }
      if (kt + 1 < nk) {
        u16* An = As + (cur ^ 1) * 128 * LDS_ST;
        u16* Bn = Bs + (cur ^ 1) * 128 * LDS_ST;
#pragma unroll
        for (int i = 0; i < 4; ++i) {
          int idx = tid + i * 256; int row = idx >> 3, c = idx & 7;
          *(uint4*)(An + row * LDS_ST + c * 8) = ra[i];
          *(uint4*)(Bn + row * LDS_ST + c * 8) = rb[i];
        }
      }
      __syncthreads();
    }
#pragma unroll
    for (int mt = 0; mt < 4; ++mt) {
      const size_t m = (size_t)tm * 128 + wm * 64 + mt * 16 + l15;
#pragma unroll
      for (int nt = 0; nt < 4; ++nt) {
        const int n = tn * 128 + wn * 64 + nt * 16 + q * 4;
        const f32x4 a = acc[mt][nt];
        if (EPI == 1) {
          if (tn < 24) {
            uint2 o; o.x = pack2(a[0], a[1]); o.y = pack2(a[2], a[3]);
            *(uint2*)((u16*)(WS + OFF_R1) + m * 3072 + n) = o;
          } else if (tn < 28) {
            uint2 o; o.x = pack2(a[0], a[1]); o.y = pack2(a[2], a[3]);
            *(uint2*)((u16*)(WS + OFF_ZB) + m * 512 + (n - 3072)) = o;
          } else {
            if (n - 3584 < 8) *(float4*)((float*)(WS + OFF_AB) + m * 8 + (n - 3584)) = make_float4(a[0], a[1], a[2], a[3]);
          }
        } else if (EPI == 2) {
          *(float4*)((float*)(WS + OFF_R1) + m * 1024 + n) = make_float4(a[0], a[1], a[2], a[3]);
        } else {
          uint2 o; o.x = pack2(a[0], a[1]); o.y = pack2(a[2], a[3]);
          *(uint2*)((u16*)(WS + OFF_R1) + m * 2048 + n) = o;
        }
      }
    }
  }
}

DI void phase_p2(const Params& p, int l) {
  char* const WS = opqp(p.ws);
  const int tid = opq(threadIdx.x), lane = tid & 63, w = tid >> 6;
  const u16* R1 = (const u16*)(WS + OFF_R1);
  u16* QKV = (u16*)(WS + OFF_QKV);
  u16* YB = (u16*)(WS + OFF_YB);
  const float* AB = (const float*)(WS + OFF_AB);
  float* GB = (float*)(WS + OFF_GB);
  const float* cw = p.conv_w + (size_t)l * 3 * 512;
  const float* gw = p.gdn_conv_w + (size_t)l * 4 * 1536;
  for (int r = blockIdx.x * 4 + w; r < MR; r += gridDim.x * 4) {
    const int pp = r % LP;
    if (pp < PADR) {
      const uint4 z4 = make_uint4(0, 0, 0, 0);
#pragma unroll
      for (int i = 0; i < 3; ++i) *(uint4*)(QKV + (size_t)r * 1536 + i * 512 + lane * 8) = z4;
      *(uint4*)(YB + (size_t)r * 1024 + lane * 8) = z4;
      *(uint4*)(YB + (size_t)r * 1024 + 512 + lane * 8) = z4;
      if (lane < 8) GB[(size_t)r * 8 + lane] = 0.f;
      continue;
    }
    const int c0 = lane * 8;
    {
      float cb[8], acc[8];
      unpack8(*(const uint4*)(R1 + (size_t)r * 3072 + c0), cb);
#pragma unroll
      for (int i = 0; i < 8; ++i) acc[i] = 0.f;
#pragma unroll
      for (int j = 0; j < 3; ++j) {
        const size_t rr = (size_t)(r - 2 + j);
        float cc[8], ch[8];
        unpack8(*(const uint4*)(R1 + rr * 3072 + 512 + c0), cc);
        unpack8(*(const uint4*)(R1 + rr * 3072 + 1024 + c0), ch);
        float4 w0 = *(const float4*)(cw + j * 512 + c0), w1 = *(const float4*)(cw + j * 512 + c0 + 4);
        const float ww[8] = {w0.x, w0.y, w0.z, w0.w, w1.x, w1.y, w1.z, w1.w};
#pragma unroll
        for (int i = 0; i < 8; ++i) acc[i] += ww[i] * (cc[i] * ch[i]);
      }
#pragma unroll
      for (int i = 0; i < 8; ++i) acc[i] *= cb[i];
      *(uint4*)(YB + (size_t)r * 1024 + c0) = pack8(acc);
    }
#pragma unroll
    for (int part = 0; part < 3; ++part) {
      const int c = part * 512 + c0;
      float acc[8];
#pragma unroll
      for (int i = 0; i < 8; ++i) acc[i] = 0.f;
#pragma unroll
      for (int j = 0; j < 4; ++j) {
        const size_t rr = (size_t)(r - 3 + j);
        float xv[8];
        unpack8(*(const uint4*)(R1 + rr * 3072 + 1536 + c), xv);
        float4 w0 = *(const float4*)(gw + j * 1536 + c), w1 = *(const float4*)(gw + j * 1536 + c + 4);
        const float ww[8] = {w0.x, w0.y, w0.z, w0.w, w1.x, w1.y, w1.z, w1.w};
#pragma unroll
        for (int i = 0; i < 8; ++i) acc[i] += ww[i] * xv[i];
      }
      float ss = 0.f;
#pragma unroll
      for (int i = 0; i < 8; ++i) { acc[i] = siluf(acc[i]); ss += acc[i] * acc[i]; }
      if (part < 2) {
        ss += __shfl_xor(ss, 1); ss += __shfl_xor(ss, 2); ss += __shfl_xor(ss, 4); ss += __shfl_xor(ss, 8);
        float sc = rsqrtf(ss + RMS_EPS);
        if (part == 0) sc *= 0.08838834764831845f;
#pragma unroll
        for (int i = 0; i < 8; ++i) acc[i] *= sc;
      }
      *(uint4*)(QKV + (size_t)r * 1536 + c) = pack8(acc);
    }
    if (lane < 4) {
      const float a = AB[(size_t)r * 8 + lane], bb = AB[(size_t)r * 8 + 4 + lane];
      const float xx = a + p.dt_bias[l * 4 + lane];
      const float tt = __expf(-fabsf(xx));
      const float l1p = (tt < 0.01f) ? tt * (1.0f - tt * (0.5f - tt * 0.33333333f)) : __logf(1.0f + tt);
      const float sp = fmaxf(xx, 0.f) + l1p;
      GB[(size_t)r * 8 + lane] = -__expf(p.a_log[l * 4 + lane]) * sp;
      GB[(size_t)r * 8 + 4 + lane] = 1.0f / (1.0f + __expf(-bb));
    }
  }
}

DI void phase_p3(const Params& p, char* smem) {
  char* const WS = opqp(p.ws);
  constexpr int ST = 136, AST = 68;
  u16* kb = (u16*)smem;
  u16* qb = kb + 64 * ST;
  u16* kbb = qb + 64 * ST;
  float* As = (float*)(kbb + 64 * ST);
  float* s_gc = As + 64 * AST;
  float* s_bt = s_gc + 64;
  const int tid = opq(threadIdx.x), lane = tid & 63, w = tid >> 6, l15 = lane & 15, q = lane >> 4;
  const u16* QKV = (const u16*)(WS + OFF_QKV);
  const float* GB = (const float*)(WS + OFF_GB);
  for (int task = blockIdx.x; task < NB * NCH * 4; task += gridDim.x) {
    const int h = task & 3, bn = task >> 2, b = bn / NCH, n = bn % NCH;
    const size_t row0 = (size_t)b * LP + (size_t)n * 64;
    char* rec = WS + OFF_R1 + (size_t)task * REC_BYTES;
    u16* rec_u = (u16*)rec; u16* rec_w = rec_u + 8192; u16* rec_kT = rec_w + 8192; u16* rec_at = rec_kT + 8192;
    float* rec_eg = (float*)(rec + 57344); float* rec_egl = rec_eg + 64; float* rec_gl = rec_egl + 64;
    const int npad = (n == 0) ? PADR : 0;
    if (tid < 64) {
      const bool pad = tid < npad;
      float g = pad ? 0.f : GB[(row0 + tid) * 8 + h];
      float bt = pad ? 0.f : GB[(row0 + tid) * 8 + 4 + h];
#pragma unroll
      for (int o = 1; o < 64; o <<= 1) { float t = __shfl_up(g, o); if (lane >= o) g += t; }
      s_gc[tid] = g; s_bt[tid] = bt;
      const float gl = __shfl(g, 63);
      rec_eg[tid] = __expf(g);
      rec_egl[tid] = __expf(gl - g);
      if (tid == 0) rec_gl[0] = __expf(gl);
    }
    __syncthreads();
#pragma unroll
    for (int i = 0; i < 4; ++i) {
      int idx = tid + i * 256; int row = idx >> 4, c = idx & 15;
      uint4 kv = make_uint4(0, 0, 0, 0), qv = make_uint4(0, 0, 0, 0);
      if (row >= npad) {
        kv = *(const uint4*)(QKV + (row0 + row) * 1536 + 512 + h * 128 + c * 8);
        qv = *(const uint4*)(QKV + (row0 + row) * 1536 + h * 128 + c * 8);
      }
      *(uint4*)(kb + row * ST + c * 8) = kv;
      *(uint4*)(qb + row * ST + c * 8) = qv;
      float kf[8]; unpack8(kv, kf);
      const float bt = s_bt[row];
#pragma unroll
      for (int j = 0; j < 8; ++j) kf[j] *= bt;
      *(uint4*)(kbb + row * ST + c * 8) = pack8(kf);
    }
    __syncthreads();
#pragma unroll
    for (int it = 0; it < 4; ++it) {
      int idx = tid + it * 256; int d = idx >> 3, i8 = idx & 7;
      u32 t[4];
#pragma unroll
      for (int jj = 0; jj < 4; ++jj) t[jj] = (u32)kb[(i8 * 8 + 2 * jj) * ST + d] | ((u32)kb[(i8 * 8 + 2 * jj + 1) * ST + d] << 16);
      *(uint4*)(rec_kT + d * 64 + i8 * 8) = make_uint4(t[0], t[1], t[2], t[3]);
    }
    {
      const int mat = w >> 1;
      const u16* src = mat ? qb : kbb;
      f32x4 acc[2][4];
#pragma unroll
      for (int i = 0; i < 2; ++i)
#pragma unroll
        for (int j = 0; j < 4; ++j) acc[i][j] = (f32x4){0.f, 0.f, 0.f, 0.f};
#pragma unroll
      for (int ks = 0; ks < 4; ++ks) {
        bf16x8 a[2], bb[4];
#pragma unroll
        for (int mi = 0; mi < 2; ++mi) a[mi] = *(const bf16x8*)(src + (((w & 1) * 2 + mi) * 16 + l15) * ST + ks * 32 + q * 8);
#pragma unroll
        for (int nt = 0; nt < 4; ++nt) bb[nt] = *(const bf16x8*)(kb + (nt * 16 + l15) * ST + ks * 32 + q * 8);
#pragma unroll
        for (int mi = 0; mi < 2; ++mi)
#pragma unroll
          for (int nt = 0; nt < 4; ++nt) acc[mi][nt] = MFMA16(a[mi], bb[nt], acc[mi][nt]);
      }
#pragma unroll
      for (int mi = 0; mi < 2; ++mi)
#pragma unroll
        for (int nt = 0; nt < 4; ++nt)
#pragma unroll
          for (int r = 0; r < 4; ++r) {
            const int i = ((w & 1) * 2 + mi) * 16 + q * 4 + r, j = nt * 16 + l15;
            const float dec = __expf(s_gc[i] - s_gc[j]);
            if (mat == 0) As[i * AST + j] = (i > j) ? acc[mi][nt][r] * dec : 0.f;
            else rec_at[i * 64 + j] = f2bf((i >= j) ? acc[mi][nt][r] * dec : 0.f);
          }
    }
    __syncthreads();
    {
      const int mat = tid >> 7, c = tid & 127;
      float x[64];
      if (mat == 0) {
#pragma unroll
        for (int i = 0; i < 64; ++i) {
          const float vv = (i >= npad) ? bf2f(QKV[(row0 + i) * 1536 + 1024 + h * 128 + c]) : 0.f;
          x[i] = vv * s_bt[i];
        }
      } else {
#pragma unroll
        for (int i = 0; i < 64; ++i) x[i] = bf2f(kb[i * ST + c]) * s_bt[i] * __expf(s_gc[i]);
      }
#pragma unroll
      for (int i = 1; i < 64; ++i) {
        float s = x[i];
#pragma unroll
        for (int j4 = 0; j4 < (i + 3) / 4; ++j4) {
          const float4 a = *(const float4*)(As + i * AST + j4 * 4);
          s -= a.x * x[j4 * 4 + 0];
          if (j4 * 4 + 1 < i) s -= a.y * x[j4 * 4 + 1];
          if (j4 * 4 + 2 < i) s -= a.z * x[j4 * 4 + 2];
          if (j4 * 4 + 3 < i) s -= a.w * x[j4 * 4 + 3];
        }
        x[i] = s;
        if ((i & 3) == 3) SCHED_FENCE;
      }
      u16* dst = mat ? rec_w : rec_u;
#pragma unroll
      for (int i = 0; i < 64; ++i) dst[i * 128 + c] = f2bf(x[i]);
    }
    __syncthreads();
  }
}

DI void phase_scan(const Params& p, int l, char* smem) {
  char* const WS = opqp(p.ws);
  if (blockIdx.x >= 16) return;
  constexpr int ST = 136, ST2 = 72;
  u16* ws_ = (u16*)smem;
  u16* qs_ = ws_ + 64 * ST;
  u16* us_ = qs_ + 64 * ST;
  u16* kts = us_ + 64 * ST;
  u16* ats = kts + 128 * ST2;
  float* egs = (float*)(ats + 64 * ST2);
  float* egls = egs + 64;
  float* s_gl = egls + 64;
  const int tid = opq(threadIdx.x), lane = tid & 63, w = tid >> 6, l15 = lane & 15, q = lane >> 4;
  const int b = blockIdx.x >> 2, h = blockIdx.x & 3;
  const u16* QKV = (const u16*)(WS + OFF_QKV);
  const u16* ZB = (const u16*)(WS + OFF_ZB);
  u16* YB = (u16*)(WS + OFF_YB);
  const float* nw = p.gdn_norm_w + l * 128;
  f32x4 S[8][2];
#pragma unroll
  for (int i = 0; i < 8; ++i) { S[i][0] = (f32x4){0.f, 0.f, 0.f, 0.f}; S[i][1] = (f32x4){0.f, 0.f, 0.f, 0.f}; }
  for (int n = 0; n < NCH; ++n) {
    const int task = ((b * NCH + n) << 2) + h;
    const size_t row0 = (size_t)b * LP + (size_t)n * 64;
    const char* rec = WS + OFF_R1 + (size_t)task * REC_BYTES;
    const u16* rec_u = (const u16*)rec; const u16* rec_w = rec_u + 8192; const u16* rec_kT = rec_w + 8192; const u16* rec_at = rec_kT + 8192;
    const float* rec_eg = (const float*)(rec + 57344);
    {
      const int tid = opq(threadIdx.x);
      uint4 tw[4], tq[4], tu[4], tk[4], ta[2];
#pragma unroll
      for (int i = 0; i < 4; ++i) {
        int idx = tid + i * 256; int row = idx >> 4, c = idx & 15;
        tw[i] = *(const uint4*)(rec_w + row * 128 + c * 8);
        tu[i] = *(const uint4*)(rec_u + row * 128 + c * 8);
        tq[i] = *(const uint4*)(QKV + (row0 + row) * 1536 + h * 128 + c * 8);
        int rk = idx >> 3, ck = idx & 7;
        tk[i] = *(const uint4*)(rec_kT + rk * 64 + ck * 8);
      }
#pragma unroll
      for (int i = 0; i < 2; ++i) { int idx = tid + i * 256; int row = idx >> 3, c = idx & 7; ta[i] = *(const uint4*)(rec_at + row * 64 + c * 8); }
      float e0 = 0.f;
      if (tid < 129) e0 = rec_eg[tid];
#pragma unroll
      for (int i = 0; i < 4; ++i) {
        int idx = tid + i * 256; int row = idx >> 4, c = idx & 15;
        *(uint4*)(ws_ + row * ST + c * 8) = tw[i];
        *(uint4*)(us_ + row * ST + c * 8) = tu[i];
        *(uint4*)(qs_ + row * ST + c * 8) = tq[i];
        int rk = idx >> 3, ck = idx & 7;
        *(uint4*)(kts + rk * ST2 + ck * 8) = tk[i];
      }
#pragma unroll
      for (int i = 0; i < 2; ++i) { int idx = tid + i * 256; int row = idx >> 3, c = idx & 7; *(uint4*)(ats + row * ST2 + c * 8) = ta[i]; }
      if (tid < 128) egs[tid] = e0;
      if (tid == 128) s_gl[0] = e0;
    }
    __syncthreads();
    f32x4 P[4][2], O[4][2];
#pragma unroll
    for (int i = 0; i < 4; ++i) { P[i][0] = P[i][1] = O[i][0] = O[i][1] = (f32x4){0.f, 0.f, 0.f, 0.f}; }
#pragma unroll
    for (int ks = 0; ks < 4; ++ks) {
      const bf16x8 sb0 = pack_acc2(S[2 * ks][0], S[2 * ks + 1][0]);
      const bf16x8 sb1 = pack_acc2(S[2 * ks][1], S[2 * ks + 1][1]);
#pragma unroll
      for (int mt = 0; mt < 4; ++mt) {
        const bf16x8 aw = read2x4(ws_ + (mt * 16 + l15) * ST, ks * 32 + 4 * q, ks * 32 + 16 + 4 * q);
        const bf16x8 aq = read2x4(qs_ + (mt * 16 + l15) * ST, ks * 32 + 4 * q, ks * 32 + 16 + 4 * q);
        P[mt][0] = MFMA16(aw, sb0, P[mt][0]); P[mt][1] = MFMA16(aw, sb1, P[mt][1]);
        O[mt][0] = MFMA16(aq, sb0, O[mt][0]); O[mt][1] = MFMA16(aq, sb1, O[mt][1]);
      }
      SCHED_FENCE;
    }
    SCHED_FENCE;
#pragma unroll
    for (int mt = 0; mt < 4; ++mt)
#pragma unroll
      for (int ct = 0; ct < 2; ++ct)
#pragma unroll
        for (int r = 0; r < 4; ++r) {
          const int i = mt * 16 + 4 * q + r, c = w * 32 + ct * 16 + l15;
          P[mt][ct][r] = bf2f(us_[i * ST + c]) - P[mt][ct][r];
          O[mt][ct][r] *= egs[i];
        }
    SCHED_FENCE;
    {
      bf16x8 vb[2][2];
#pragma unroll
      for (int k2 = 0; k2 < 2; ++k2) { vb[k2][0] = pack_acc2(P[2 * k2][0], P[2 * k2 + 1][0]); vb[k2][1] = pack_acc2(P[2 * k2][1], P[2 * k2 + 1][1]); }
#pragma unroll
      for (int k2 = 0; k2 < 2; ++k2)
#pragma unroll
        for (int mt = 0; mt < 4; ++mt) {
          const bf16x8 aa = read2x4(ats + (mt * 16 + l15) * ST2, k2 * 32 + 4 * q, k2 * 32 + 16 + 4 * q);
          O[mt][0] = MFMA16(aa, vb[k2][0], O[mt][0]); O[mt][1] = MFMA16(aa, vb[k2][1], O[mt][1]);
        }
    }
    SCHED_FENCE;
    {
#pragma unroll
      for (int mt = 0; mt < 4; ++mt)
#pragma unroll
        for (int ct = 0; ct < 2; ++ct)
#pragma unroll
          for (int r = 0; r < 4; ++r) P[mt][ct][r] *= egls[mt * 16 + 4 * q + r];
      bf16x8 vb[2][2];
#pragma unroll
      for (int k2 = 0; k2 < 2; ++k2) { vb[k2][0] = pack_acc2(P[2 * k2][0], P[2 * k2 + 1][0]); vb[k2][1] = pack_acc2(P[2 * k2][1], P[2 * k2 + 1][1]); }
      const float egl = s_gl[0];
#pragma unroll
      for (int dt = 0; dt < 8; ++dt) { S[dt][0] *= egl; S[dt][1] *= egl; }
#pragma unroll
      for (int k2 = 0; k2 < 2; ++k2)
#pragma unroll
        for (int dt = 0; dt < 8; ++dt) {
          const bf16x8 ak = read2x4(kts + (dt * 16 + l15) * ST2, k2 * 32 + 4 * q, k2 * 32 + 16 + 4 * q);
          S[dt][0] = MFMA16(ak, vb[k2][0], S[dt][0]); S[dt][1] = MFMA16(ak, vb[k2][1], S[dt][1]);
          if (dt == 3 || dt == 7) SCHED_FENCE;
        }
    }
    SCHED_FENCE;
    __syncthreads();
    {
      float* Ol = (float*)smem;
#pragma unroll
      for (int mt = 0; mt < 4; ++mt)
#pragma unroll
        for (int ct = 0; ct < 2; ++ct)
#pragma unroll
          for (int r = 0; r < 4; ++r) Ol[(mt * 16 + 4 * q + r) * 132 + w * 32 + ct * 16 + l15] = O[mt][ct][r];
    }
    __syncthreads();
    {
      const float* Ol = (const float*)smem;
      const int te = opq(threadIdx.x);
      const int i = te >> 2, seg = te & 3;
      const int npad = (n == 0) ? PADR : 0;
      float ov[32];
#pragma unroll
      for (int k = 0; k < 8; ++k) {
        const float4 t = *(const float4*)(Ol + i * 132 + seg * 32 + k * 4);
        ov[k * 4] = t.x; ov[k * 4 + 1] = t.y; ov[k * 4 + 2] = t.z; ov[k * 4 + 3] = t.w;
      }
      float ss = 0.f;
#pragma unroll
      for (int k = 0; k < 32; ++k) ss += ov[k] * ov[k];
      ss += __shfl_xor(ss, 1); ss += __shfl_xor(ss, 2);
      const float rs = rsqrtf(ss * (1.0f / 128.0f) + RMS_EPS);
      if (i >= npad) {
        const u16* zp = ZB + (row0 + i) * 512 + h * 128 + seg * 32;
        u16* yp = YB + (row0 + i) * 1024 + 512 + h * 128 + seg * 32;
#pragma unroll
        for (int k = 0; k < 4; ++k) {
          float zf[8], yv[8];
          unpack8(*(const uint4*)(zp + k * 8), zf);
          const float4 n0 = *(const float4*)(nw + seg * 32 + k * 8), n1 = *(const float4*)(nw + seg * 32 + k * 8 + 4);
          const float nn[8] = {n0.x, n0.y, n0.z, n0.w, n1.x, n1.y, n1.z, n1.w};
#pragma unroll
          for (int j = 0; j < 8; ++j) yv[j] = ov[k * 8 + j] * rs * nn[j] * siluf(zf[j]);
          *(uint4*)(yp + k * 8) = pack8(yv);
        }
      }
    }
    __syncthreads();
  }
}

DI void phase_ln1(const Params& p, int l) {
  char* const WS = opqp(p.ws);
  const int tid = opq(threadIdx.x), lane = tid & 63, w = tid >> 6;
  const u16* HB = (const u16*)(WS + OFF_HB);
  const float* MIX = (const float*)(WS + OFF_R1);
  u16* H1 = (u16*)(WS + OFF_QKV);
  for (int r = blockIdx.x * 4 + w; r < MR; r += gridDim.x * 4) {
    const int pp = r % LP;
    float v[16];
    if (pp < PADR) {
#pragma unroll
      for (int i = 0; i < 16; ++i) v[i] = 0.f;
    } else {
      float hv[16];
      unpack8(*(const uint4*)(HB + (size_t)r * 1024 + lane * 16), hv);
      unpack8(*(const uint4*)(HB + (size_t)r * 1024 + lane * 16 + 8), hv + 8);
#pragma unroll
      for (int i4 = 0; i4 < 4; ++i4) {
        float4 t = *(const float4*)(MIX + (size_t)r * 1024 + lane * 16 + i4 * 4);
        v[i4 * 4] = ALPHA * hv[i4 * 4] + t.x; v[i4 * 4 + 1] = ALPHA * hv[i4 * 4 + 1] + t.y;
        v[i4 * 4 + 2] = ALPHA * hv[i4 * 4 + 2] + t.z; v[i4 * 4 + 3] = ALPHA * hv[i4 * 4 + 3] + t.w;
      }
      ln_row16(v, p.ln1_g + l * 1024, p.ln1_b + l * 1024, lane);
    }
    store_row16_bf16(H1 + (size_t)r * 1024, v, lane);
  }
}

DI void phase_p6(const Params& p, int l, char* smem) {
  char* const WS = opqp(p.ws);
  constexpr int KST = 136, SST = 132;
  u16* kh = (u16*)smem;
  u32* lst = (u32*)smem;
  float* sc = (float*)(smem + 128 * KST * 2);
  float* fin_t = sc + 64 * SST;
  unsigned char* fin_i = (unsigned char*)(fin_t + 64 * 32);
  const int tid = opq(threadIdx.x), lane = tid & 63, w = tid >> 6, l15 = lane & 15, q = lane >> 4;
  const u16* QP = (const u16*)(WS + OFF_R1);
  const u16* SK = (const u16*)(WS + OFF_SK) + (size_t)l * 2 * 16384;
  int* IDX = (int*)(WS + OFF_IDX);
  float* GATE = (float*)(WS + OFF_GATE);
  for (int task = blockIdx.x; task < (MR / 64) * 8; task += gridDim.x) {
    const int tt = task >> 3, hd = task & 7;
    const size_t row0 = (size_t)tt * 64;
    for (int hf = 0; hf < 2; ++hf) {
#pragma unroll
      for (int i = 0; i < 8; ++i) {
        int idx = tid + i * 256; int row = idx >> 4, c = idx & 15;
        *(uint4*)(kh + row * KST + c * 8) = *(const uint4*)(SK + hf * 16384 + row * 128 + c * 8);
      }
      __syncthreads();
      {
        f32x4 acc[8];
#pragma unroll
        for (int i = 0; i < 8; ++i) acc[i] = (f32x4){0.f, 0.f, 0.f, 0.f};
        const u16* qrow = QP + (row0 + w * 16 + l15) * 2048 + hd * 256 + hf * 128;
#pragma unroll
        for (int ks = 0; ks < 4; ++ks) {
          const bf16x8 af = *(const bf16x8*)(qrow + ks * 32 + q * 8);
#pragma unroll
          for (int nt = 0; nt < 8; ++nt) {
            const bf16x8 bk = *(const bf16x8*)(kh + (nt * 16 + l15) * KST + ks * 32 + q * 8);
            acc[nt] = MFMA16(af, bk, acc[nt]);
          }
        }
#pragma unroll
        for (int nt = 0; nt < 8; ++nt)
#pragma unroll
          for (int r = 0; r < 4; ++r) sc[(w * 16 + 4 * q + r) * SST + nt * 16 + l15] = acc[nt][r];
      }
      __syncthreads();
      {
        const int tok = tid >> 2, qr = tid & 3;
        u32 v[16];
#pragma unroll
        for (int i = 0; i < 16; ++i) v[i] = 0u;
#pragma unroll 4
        for (int j = 0; j < 32; ++j) {
          const int key = qr + 4 * j;
          const u32 pk = (orderable(sc[tok * SST + key]) & ~127u) | (u32)(127 - key);
          INS16(v, pk);
        }
#pragma unroll
        for (int i = 0; i < 4; ++i) *(uint4*)(lst + (tok * 4 + qr) * 16 + i * 4) = make_uint4(v[i * 4], v[i * 4 + 1], v[i * 4 + 2], v[i * 4 + 3]);
      }
      __syncthreads();
      if (tid < 64) {
        u32 v[16];
#pragma unroll
        for (int i = 0; i < 4; ++i) { uint4 t = *(const uint4*)(lst + (tid * 4) * 16 + i * 4); v[i * 4] = t.x; v[i * 4 + 1] = t.y; v[i * 4 + 2] = t.z; v[i * 4 + 3] = t.w; }
#pragma unroll 4
        for (int j = 16; j < 64; ++j) { const u32 pk = lst[tid * 64 + j]; INS16(v, pk); }
#pragma unroll
        for (int k = 0; k < 16; ++k) {
          const int key = 127 - (int)(v[k] & 127u);
          fin_t[tid * 32 + hf * 16 + k] = sc[tid * SST + key];
          fin_i[tid * 32 + hf * 16 + k] = (unsigned char)key;
        }
      }
      __syncthreads();
    }
    if (tid < 64) {
      float t1[16], t2[16];
#pragma unroll
      for (int k = 0; k < 16; ++k) { t1[k] = fin_t[tid * 32 + k]; t2[k] = fin_t[tid * 32 + 16 + k]; }
      u32 v[16];
#pragma unroll
      for (int i = 0; i < 16; ++i) v[i] = 0u;
#define CAND_ROW(a, nb) { _Pragma("unroll") for (int bq = 0; bq < (nb); ++bq) { const u32 pk = (orderable(t1[a] + t2[bq]) & ~255u) | (u32)(255 - ((a) * 16 + bq)); INS16(v, pk); } }
      CAND_ROW(0, 16) CAND_ROW(1, 8) CAND_ROW(2, 5) CAND_ROW(3, 4) CAND_ROW(4, 3) CAND_ROW(5, 2) CAND_ROW(6, 2) CAND_ROW(7, 2)
      CAND_ROW(8, 1) CAND_ROW(9, 1) CAND_ROW(10, 1) CAND_ROW(11, 1) CAND_ROW(12, 1) CAND_ROW(13, 1) CAND_ROW(14, 1) CAND_ROW(15, 1)
      float sm[16]; int ex[16];
      float mx = -1e30f;
#pragma unroll
      for (int k = 0; k < 16; ++k) {
        const int ci = 255 - (int)(v[k] & 255u);
        const int a = ci >> 4, bq = ci & 15;
        sm[k] = fin_t[tid * 32 + a] + fin_t[tid * 32 + 16 + bq];
        ex[k] = (int)fin_i[tid * 32 + a] * 128 + (int)fin_i[tid * 32 + 16 + bq];
        mx = fmaxf(mx, sm[k]);
      }
      float den = 0.f;
#pragma unroll
      for (int k = 0; k < 16; ++k) { sm[k] = __expf(sm[k] - mx); den += sm[k]; }
      const float inv = 1.0f / den;
      int* io = IDX + (row0 + tid) * 128 + hd * 16;
      float* go = GATE + (row0 + tid) * 128 + hd * 16;
#pragma unroll
      for (int k4 = 0; k4 < 4; ++k4) {
        *(int4*)(io + k4 * 4) = make_int4(ex[k4 * 4], ex[k4 * 4 + 1], ex[k4 * 4 + 2], ex[k4 * 4 + 3]);
        *(float4*)(go + k4 * 4) = make_float4(sm[k4 * 4] * inv, sm[k4 * 4 + 1] * inv, sm[k4 * 4 + 2] * inv, sm[k4 * 4 + 3] * inv);
      }
    }
    __syncthreads();
  }
}

DI void phase_p7(const Params& p, int l) {
  char* const WS = opqp(p.ws);
  const int tid = opq(threadIdx.x), lane = tid & 63, w = tid >> 6;
  const u16* H1 = (const u16*)(WS + OFF_QKV);
  u16* HB = (u16*)(WS + OFF_HB);
  const char* TU = WS + OFF_TAB;
  const char* TV = TU + (size_t)16384 * 1024;
  const int* IDX = (const int*)(WS + OFF_IDX);
  const float* GATE = (const float*)(WS + OFF_GATE);
  const bool last = (l == 1);
  const int per_b = last ? SEQ : (SEQ + NMETA);
  const int ntok = NB * per_b;
  for (int ti = blockIdx.x * 4 + w; ti < ntok; ti += gridDim.x * 4) {
    const int b = ti / per_b, pp = (last ? 64 : PADR) + ti % per_b;
    const size_t r = (size_t)b * LP + pp;
    float x[16];
    unpack8(*(const uint4*)(H1 + r * 1024 + lane * 16), x);
    unpack8(*(const uint4*)(H1 + r * 1024 + lane * 16 + 8), x + 8);
    const int id0 = IDX[r * 128 + lane], id1 = IDX[r * 128 + 64 + lane];
    const float g0 = GATE[r * 128 + lane], g1 = GATE[r * 128 + 64 + lane];
    float d0 = 0.f, d1 = 0.f;
    for (int eb = 0; eb < 128; eb += 8) {
      uint4 ud[8];
#pragma unroll
      for (int j = 0; j < 8; ++j) {
        const int e = eb + j;
        const int id = __builtin_amdgcn_readlane((eb < 64) ? id0 : id1, e & 63);
        ud[j] = *(const uint4*)(TU + (size_t)id * 1024 + lane * 16);
      }
#pragma unroll
      for (int j = 0; j < 8; ++j) {
        float f[16]; dec_fp8x16(ud[j], f);
        float s = 0.f;
#pragma unroll
        for (int i = 0; i < 16; ++i) s += x[i] * f[i];
        s = wsum(s);
        const int e = eb + j;
        if (lane == (e & 63)) { if (eb < 64) d0 = s; else d1 = s; }
      }
    }
    float c0, c1;
    { const float a = d0 * TINV; c0 = g0 * 0.5f * a * (1.0f + erf_as(a * 0.7071067811865476f)) * TINV; }
    { const float a = d1 * TINV; c1 = g1 * 0.5f * a * (1.0f + erf_as(a * 0.7071067811865476f)) * TINV; }
    float acc[16];
#pragma unroll
    for (int i = 0; i < 16; ++i) acc[i] = 0.f;
    for (int eb = 0; eb < 128; eb += 8) {
      uint4 vd[8];
#pragma unroll
      for (int j = 0; j < 8; ++j) {
        const int e = eb + j;
        const int id = __builtin_amdgcn_readlane((eb < 64) ? id0 : id1, e & 63);
        vd[j] = *(const uint4*)(TV + (size_t)id * 1024 + lane * 16);
      }
#pragma unroll
      for (int j = 0; j < 8; ++j) {
        const int e = eb + j;
        const float cf = __int_as_float(__builtin_amdgcn_readlane(__float_as_int((eb < 64) ? c0 : c1), e & 63));
        float f[16]; dec_fp8x16(vd[j], f);
#pragma unroll
        for (int i = 0; i < 16; ++i) acc[i] += cf * f[i];
      }
    }
#pragma unroll
    for (int i = 0; i < 16; ++i) acc[i] += ALPHA * x[i];
    ln_row16(acc, p.ln2_g + l * 1024, p.ln2_b + l * 1024, lane);
    if (!last) {
      store_row16_bf16(HB + r * 1024, acc, lane);
    } else {
      float* o = p.out + ((size_t)b * SEQ + (pp - 64)) * 1024 + lane * 16;
#pragma unroll
      for (int i4 = 0; i4 < 4; ++i4) *(float4*)(o + i4 * 4) = make_float4(acc[i4 * 4], acc[i4 * 4 + 1], acc[i4 * 4 + 2], acc[i4 * 4 + 3]);
    }
  }
}

template <int l>
DI void layer(const Params& p, char* smem, cg::grid_group& grid) {
  gemm_phase<1>(p, OFF_HB, OFF_WIN + l * SZ_WIN1, NPROJP / 128, smem);
  grid.sync();
  phase_p2(p, l);
  grid.sync();
  phase_p3(p, smem);
  grid.sync();
  phase_scan(p, l, smem);
  grid.sync();
  gemm_phase<2>(p, OFF_YB, OFF_WOUT + l * SZ_WOUT1, 8, smem);
  grid.sync();
  phase_ln1(p, l);
  grid.sync();
  convert_tables(p, l);
  gemm_phase<3>(p, OFF_QKV, OFF_WQ + l * SZ_WQ1, 16, smem);
  grid.sync();
  phase_p6(p, l, smem);
  grid.sync();
  phase_p7(p, l);
}
__global__ void __launch_bounds__(256, 2) fwd_megakernel(Params p) {
  __shared__ __attribute__((aligned(16))) char smem[81920];
  cg::grid_group grid = cg::this_grid();
  phase_prologue(p, smem);
  grid.sync();
  layer<0>(p, smem, grid);
  grid.sync();
  layer<1>(p, smem, grid);
}

extern "C" void kernel_launch(void* const* d_in, const int* in_sizes, int n_in, void* d_out,
                              int out_size, void* d_ws, size_t ws_size, hipStream_t stream) {
  static int grid_blocks = 0;
  if (!grid_blocks) {
    int dev = 0, cus = 0, per_cu = 0;
    (void)hipGetDevice(&dev);
    (void)hipDeviceGetAttribute(&cus, hipDeviceAttributeMultiprocessorCount, dev);
    (void)hipOccupancyMaxActiveBlocksPerMultiprocessor(&per_cu, fwd_megakernel, 256, 0);
    if (per_cu > 2) per_cu = 2;
    if (per_cu < 1) per_cu = 1;
    grid_blocks = cus * per_cu;
  }
  if (ws_size < WS_NEED) { fprintf(stderr, "workspace too small\n"); return; }
  Params p{};
  p.x = (const float*)d_in[0]; p.meta = (const float*)d_in[1]; p.ln_in_g = (const float*)d_in[2]; p.ln_in_b = (const float*)d_in[3];
  p.w_in = (const float*)d_in[4]; p.conv_w = (const float*)d_in[5]; p.gdn_conv_w = (const float*)d_in[6]; p.a_log = (const float*)d_in[7];
  p.dt_bias = (const float*)d_in[8]; p.gdn_norm_w = (const float*)d_in[9]; p.w_out = (const float*)d_in[10]; p.ln1_g = (const float*)d_in[11];
  p.ln1_b = (const float*)d_in[12]; p.w_q = (const float*)d_in[13]; p.k1 = (const float*)d_in[14]; p.k2 = (const float*)d_in[15];
  p.pu = (const float*)d_in[16]; p.pv = (const float*)d_in[17]; p.ln2_g = (const float*)d_in[18]; p.ln2_b = (const float*)d_in[19];
  p.out = (float*)d_out; p.ws = (char*)d_ws;
  void* args[] = {&p};
  hipError_t e = hipLaunchCooperativeKernel((void*)fwd_megakernel, dim3(grid_blocks), dim3(256), args, 0, stream);
  if (e != hipSuccess) fprintf(stderr, "cooperative launch failed: %s (grid %d)\n", hipGetErrorString(e), grid_blocks);
}
```

```cpp
#include <hip/hip_runtime.h>
#include <hip/hip_cooperative_groups.h>
#include <cstdio>
namespace cg = cooperative_groups;

typedef unsigned short u16;
typedef unsigned int u32;
using bf16x8 = __attribute__((ext_vector_type(8))) short;
using s16x4 = __attribute__((ext_vector_type(4))) short;
using f32x4 = __attribute__((ext_vector_type(4))) float;
using f32x2 = __attribute__((ext_vector_type(2))) float;

#define DI __device__ __forceinline__
#define MFMA16(a, b, c) __builtin_amdgcn_mfma_f32_16x16x32_bf16((a), (b), (c), 0, 0, 0)

constexpr int NB = 4, SEQ = 8192, NMETA = 16, DM = 1024;
constexpr int LP = 8256;
constexpr int PADR = 48;
constexpr int MR = NB * LP;
constexpr int NCH = 129;
constexpr int NPROJ = 3592, NPROJP = 3712;
constexpr float ALPHA = 1.4142135623730951f;
constexpr float LN_EPS = 1e-5f, RMS_EPS = 1e-6f;
constexpr float TSCALE = 64.0f, TINV = 1.0f / 64.0f;

constexpr size_t SZ_HB = (size_t)MR * 1024 * 2;
constexpr size_t OFF_HB = 0;
constexpr size_t OFF_R1 = OFF_HB + SZ_HB;
constexpr size_t SZ_R1 = (size_t)MR * 3072 * 2;
constexpr size_t OFF_ZB = OFF_R1 + SZ_R1;
constexpr size_t SZ_ZB = (size_t)MR * 512 * 2;
constexpr size_t OFF_QKV = OFF_ZB + SZ_ZB;
constexpr size_t SZ_QKV = (size_t)MR * 1536 * 2;
constexpr size_t OFF_TAB = OFF_QKV + SZ_HB;
constexpr size_t OFF_YB = OFF_QKV + SZ_QKV;
constexpr size_t OFF_AB = OFF_YB + SZ_HB;
constexpr size_t SZ_AB = (size_t)MR * 8 * 4;
constexpr size_t OFF_GB = OFF_AB + SZ_AB;
constexpr size_t OFF_WIN = OFF_GB + SZ_AB;
constexpr size_t SZ_WIN1 = (size_t)NPROJP * 1024 * 2;
constexpr size_t OFF_WOUT = OFF_WIN + 2 * SZ_WIN1;
constexpr size_t SZ_WOUT1 = (size_t)1024 * 1024 * 2;
constexpr size_t OFF_WQ = OFF_WOUT + 2 * SZ_WOUT1;
constexpr size_t SZ_WQ1 = (size_t)2048 * 1024 * 2;
constexpr size_t OFF_SK = OFF_WQ + 2 * SZ_WQ1;
constexpr size_t SZ_SK1 = (size_t)2 * 128 * 128 * 2;
constexpr size_t WS_NEED = OFF_SK + 2 * SZ_SK1;
constexpr size_t REC_BYTES = 58368;
constexpr size_t OFF_IDX = OFF_R1 + (size_t)MR * 2048 * 2;
constexpr size_t OFF_GATE = OFF_IDX + (size_t)MR * 128 * 4;
static_assert((size_t)NB * NCH * 4 * REC_BYTES <= SZ_R1, "rec");
static_assert(OFF_GATE + (size_t)MR * 128 * 4 <= OFF_R1 + SZ_R1, "idx");
static_assert((size_t)2 * 16384 * 1024 <= SZ_QKV - SZ_HB, "tab");
static_assert(WS_NEED <= (size_t)512 * 1024 * 1024, "ws");

struct Params {
  const float* x; const float* meta; const float* ln_in_g; const float* ln_in_b;
  const float* w_in; const float* conv_w; const float* gdn_conv_w; const float* a_log; const float* dt_bias;
  const float* gdn_norm_w; const float* w_out; const float* ln1_g; const float* ln1_b;
  const float* w_q; const float* k1; const float* k2; const float* pu; const float* pv;
  const float* ln2_g; const float* ln2_b;
  float* out; char* ws;
};

DI int opq(int x) { asm volatile("" : "+v"(x)); return x; }
DI char* opqp(char* w) { long z = 0; asm volatile("" : "+s"(z)); return w + z; }
DI int opqs(int x) { asm volatile("" : "+s"(x)); return x; }
#define SCHED_FENCE __builtin_amdgcn_sched_barrier(0)
typedef __bf16 hbf16x2 __attribute__((ext_vector_type(2)));
DI u32 pack2(float a, float b) { f32x2 v = {a, b}; hbf16x2 r = __builtin_convertvector(v, hbf16x2); return __builtin_bit_cast(u32, r); }
DI u16 f2bf(float x) { return (u16)(pack2(x, 0.f) & 0xffffu); }
DI float bf2f(u16 h) { return __uint_as_float(((u32)h) << 16); }
DI float bflo(u32 w) { return __uint_as_float(w << 16); }
DI float bfhi(u32 w) { return __uint_as_float(w & 0xffff0000u); }
DI float wsum(float v) {
#pragma unroll
  for (int o = 32; o > 0; o >>= 1) v += __shfl_xor(v, o);
  return v;
}
DI float erf_as(float x) {
  const float ax = fabsf(x);
  const float t = 1.0f / (1.0f + 0.3275911f * ax);
  const float poly = t * (0.254829592f + t * (-0.284496736f + t * (1.421413741f + t * (-1.453152027f + t * 1.061405429f))));
  const float r = 1.0f - poly * __expf(-ax * ax);
  return x < 0.f ? -r : r;
}
DI float siluf(float x) { return x / (1.0f + __expf(-x)); }
DI void unpack8(const uint4& v, float* f) {
  f[0] = bflo(v.x); f[1] = bfhi(v.x); f[2] = bflo(v.y); f[3] = bfhi(v.y);
  f[4] = bflo(v.z); f[5] = bfhi(v.z); f[6] = bflo(v.w); f[7] = bfhi(v.w);
}
DI uint4 pack8(const float* f) {
  uint4 v; v.x = pack2(f[0], f[1]); v.y = pack2(f[2], f[3]); v.z = pack2(f[4], f[5]); v.w = pack2(f[6], f[7]); return v;
}
DI bf16x8 pack_acc2(const f32x4& a, const f32x4& b) {
  uint4 v; v.x = pack2(a[0], a[1]); v.y = pack2(a[2], a[3]); v.z = pack2(b[0], b[1]); v.w = pack2(b[2], b[3]);
  return __builtin_bit_cast(bf16x8, v);
}
DI bf16x8 read2x4(const u16* p, int c0, int c1) {
  uint2 lo = *(const uint2*)(p + c0);
  uint2 hi = *(const uint2*)(p + c1);
  uint4 v; v.x = lo.x; v.y = lo.y; v.z = hi.x; v.w = hi.y;
  return __builtin_bit_cast(bf16x8, v);
}
DI u32 enc_fp8x4(float a, float b, float c, float d) {
  int v = 0;
  v = __builtin_amdgcn_cvt_pk_fp8_f32(a, b, v, false);
  v = __builtin_amdgcn_cvt_pk_fp8_f32(c, d, v, true);
  return (u32)v;
}
DI void dec_fp8x16(const uint4& v, float* f) {
  f32x2 t;
  t = __builtin_amdgcn_cvt_pk_f32_fp8((int)v.x, false); f[0] = t[0]; f[1] = t[1];
  t = __builtin_amdgcn_cvt_pk_f32_fp8((int)v.x, true);  f[2] = t[0]; f[3] = t[1];
  t = __builtin_amdgcn_cvt_pk_f32_fp8((int)v.y, false); f[4] = t[0]; f[5] = t[1];
  t = __builtin_amdgcn_cvt_pk_f32_fp8((int)v.y, true);  f[6] = t[0]; f[7] = t[1];
  t = __builtin_amdgcn_cvt_pk_f32_fp8((int)v.z, false); f[8] = t[0]; f[9] = t[1];
  t = __builtin_amdgcn_cvt_pk_f32_fp8((int)v.z, true);  f[10] = t[0]; f[11] = t[1];
  t = __builtin_amdgcn_cvt_pk_f32_fp8((int)v.w, false); f[12] = t[0]; f[13] = t[1];
  t = __builtin_amdgcn_cvt_pk_f32_fp8((int)v.w, true);  f[14] = t[0]; f[15] = t[1];
}
DI u32 orderable(float f) { u32 u = __float_as_uint(f); return u ^ ((u >> 31) ? 0xffffffffu : 0x80000000u); }
#define INS16(v, xx) { u32 _x = (xx); _Pragma("unroll") for (int _i = 0; _i < 16; ++_i) { u32 _h = max(v[_i], _x); _x = min(v[_i], _x); v[_i] = _h; } }

DI void ln_row16(float* v, const float* __restrict__ g, const float* __restrict__ b, int lane) {
  float s = 0.f;
#pragma unroll
  for (int i = 0; i < 16; ++i) s += v[i];
  float mu = wsum(s) * (1.0f / 1024.0f);
  float q = 0.f;
#pragma unroll
  for (int i = 0; i < 16; ++i) { float d = v[i] - mu; q += d * d; }
  float var = wsum(q) * (1.0f / 1024.0f);
  float rs = rsqrtf(var + LN_EPS);
#pragma unroll
  for (int i4 = 0; i4 < 4; ++i4) {
    float4 gg = *(const float4*)(g + lane * 16 + i4 * 4);
    float4 bb = *(const float4*)(b + lane * 16 + i4 * 4);
    v[i4 * 4 + 0] = (v[i4 * 4 + 0] - mu) * rs * gg.x + bb.x;
    v[i4 * 4 + 1] = (v[i4 * 4 + 1] - mu) * rs * gg.y + bb.y;
    v[i4 * 4 + 2] = (v[i4 * 4 + 2] - mu) * rs * gg.z + bb.z;
    v[i4 * 4 + 3] = (v[i4 * 4 + 3] - mu) * rs * gg.w + bb.w;
  }
}
DI void store_row16_bf16(u16* dst, const float* v, int lane) {
  *(uint4*)(dst + lane * 16) = pack8(v);
  *(uint4*)(dst + lane * 16 + 8) = pack8(v + 8);
}

DI void transpose_convert(const float* __restrict__ W, int K, int N, int Npad, u16* __restrict__ Wt, char* smem) {
  float* tile = (float*)smem;
  const int tid = opq(threadIdx.x);
  const int ntn = Npad / 64, ntk = K / 64;
  for (int t = blockIdx.x; t < ntn * ntk; t += gridDim.x) {
    const int n0 = (t % ntn) * 64, k0 = (t / ntn) * 64;
#pragma unroll 4
    for (int i = 0; i < 16; ++i) {
      int idx = tid + i * 256; int kk = idx >> 6, nn = idx & 63;
      float val = (n0 + nn < N) ? W[(size_t)(k0 + kk) * N + n0 + nn] : 0.f;
      tile[kk * 65 + nn] = val;
    }
    __syncthreads();
#pragma unroll 4
    for (int i = 0; i < 16; ++i) {
      int idx = tid + i * 256; int nn = idx >> 6, kk = idx & 63;
      Wt[(size_t)(n0 + nn) * K + k0 + kk] = f2bf(tile[kk * 65 + nn]);
    }
    __syncthreads();
  }
}

DI void phase_prologue(const Params& p, char* smem) {
  char* const WS = opqp(p.ws);
  const int tid = opq(threadIdx.x), lane = tid & 63, w = tid >> 6;
  u16* HB = (u16*)(WS + OFF_HB);
  for (int r = blockIdx.x * 4 + w; r < MR; r += gridDim.x * 4) {
    const int b = r / LP, pp = r % LP;
    float v[16];
    if (pp < PADR) {
#pragma unroll
      for (int i = 0; i < 16; ++i) v[i] = 0.f;
    } else {
      const float* src = (pp < 64) ? (p.meta + (size_t)(pp - PADR) * DM) : (p.x + ((size_t)b * SEQ + (pp - 64)) * DM);
#pragma unroll
      for (int i4 = 0; i4 < 4; ++i4) {
        float4 t = *(const float4*)(src + lane * 16 + i4 * 4);
        v[i4 * 4] = t.x; v[i4 * 4 + 1] = t.y; v[i4 * 4 + 2] = t.z; v[i4 * 4 + 3] = t.w;
      }
      ln_row16(v, p.ln_in_g, p.ln_in_b, lane);
    }
    store_row16_bf16(HB + (size_t)r * DM, v, lane);
  }
  for (int l = 0; l < 2; ++l) {
    transpose_convert(p.w_in + (size_t)l * 1024 * NPROJ, 1024, NPROJ, NPROJP, (u16*)(WS + OFF_WIN + l * SZ_WIN1), smem);
    transpose_convert(p.w_out + (size_t)l * 1024 * 1024, 1024, 1024, 1024, (u16*)(WS + OFF_WOUT + l * SZ_WOUT1), smem);
    transpose_convert(p.w_q + (size_t)l * 1024 * 2048, 1024, 2048, 2048, (u16*)(WS + OFF_WQ + l * SZ_WQ1), smem);
  }
  u16* SK = (u16*)(WS + OFF_SK);
  for (int i = blockIdx.x * 256 + tid; i < 2 * 2 * 16384; i += gridDim.x * 256) {
    int l = i >> 15, rem = i & 32767, hf = rem >> 14, e = rem & 16383;
    const float* src = (hf ? p.k2 : p.k1) + (size_t)l * 16384;
    SK[i] = f2bf(src[e]);
  }
}

DI void convert_tables(const Params& p, int l) {
  char* const WS = opqp(p.ws);
  u32* TAB = (u32*)(WS + OFF_TAB);
  const size_t n16 = (size_t)2 * 16384 * 1024 / 16;
  for (size_t i = (size_t)(opqs(blockIdx.x) * 256 + opq(threadIdx.x)); i < n16; i += (size_t)gridDim.x * 256) {
    const size_t e0 = i * 16;
    const int which = (int)(e0 >> 24);
    const size_t off = e0 & (((size_t)1 << 24) - 1);
    const float* src = (which ? p.pv : p.pu) + (size_t)l * 16384 * 1024 + off;
    uint4 o;
    float4 a = *(const float4*)(src), b = *(const float4*)(src + 4), c = *(const float4*)(src + 8), d = *(const float4*)(src + 12);
    o.x = enc_fp8x4(a.x * TSCALE, a.y * TSCALE, a.z * TSCALE, a.w * TSCALE);
    o.y = enc_fp8x4(b.x * TSCALE, b.y * TSCALE, b.z * TSCALE, b.w * TSCALE);
    o.z = enc_fp8x4(c.x * TSCALE, c.y * TSCALE, c.z * TSCALE, c.w * TSCALE);
    o.w = enc_fp8x4(d.x * TSCALE, d.y * TSCALE, d.z * TSCALE, d.w * TSCALE);
    *(uint4*)(TAB + i * 4) = o;
  }
}

template <int EPI>
DI void gemm_phase(const Params& p, size_t offA, size_t offB, int ntn, char* smem) {
  char* const WS = opqp(p.ws);
  const u16* __restrict__ A = (const u16*)(WS + offA);
  const u16* __restrict__ Bt = (const u16*)(WS + offB);
  constexpr int K = 1024, LDS_ST = 72;
  u16* As = (u16*)smem;
  u16* Bs = As + 2 * 128 * LDS_ST;
  const int tid = opq(threadIdx.x), lane = tid & 63, w = tid >> 6, wm = w >> 1, wn = w & 1;
  const int l15 = lane & 15, q = lane >> 4;
  const int ntm = MR / 128;
  for (int tile = blockIdx.x; tile < ntm * ntn; tile += gridDim.x) {
    const int tm = tile / ntn, tn = tile % ntn;
    const u16* Ag = A + (size_t)(tm * 128) * K;
    const u16* Bg = Bt + (size_t)(tn * 128) * K;
    f32x4 acc[4][4];
#pragma unroll
    for (int i = 0; i < 4; ++i)
#pragma unroll
      for (int j = 0; j < 4; ++j) acc[i][j] = (f32x4){0.f, 0.f, 0.f, 0.f};
    uint4 ra[4], rb[4];
#pragma unroll
    for (int i = 0; i < 4; ++i) {
      int idx = tid + i * 256; int row = idx >> 3, c = idx & 7;
      ra[i] = *(const uint4*)(Ag + (size_t)row * K + c * 8);
      rb[i] = *(const uint4*)(Bg + (size_t)row * K + c * 8);
    }
#pragma unroll
    for (int i = 0; i < 4; ++i) {
      int idx = tid + i * 256; int row = idx >> 3, c = idx & 7;
      *(uint4*)(As + row * LDS_ST + c * 8) = ra[i];
      *(uint4*)(Bs + row * LDS_ST + c * 8) = rb[i];
    }
    __syncthreads();
    constexpr int nk = K / 64;
    for (int kt = 0; kt < nk; ++kt) {
      const int cur = kt & 1;
      if (kt + 1 < nk) {
        const int k0 = (kt + 1) * 64;
#pragma unroll
        for (int i = 0; i < 4; ++i) {
          int idx = tid + i * 256; int row = idx >> 3, c = idx & 7;
          ra[i] = *(const uint4*)(Ag + (size_t)row * K + k0 + c * 8);
          rb[i] = *(const uint4*)(Bg + (size_t)row * K + k0 + c * 8);
        }
      }
      const u16* Ac = As + cur * 128 * LDS_ST;
      const u16* Bc = Bs + cur * 128 * LDS_ST;
#pragma unroll
      for (int kk = 0; kk < 2; ++kk) {
        bf16x8 af[4], bfr[4];
#pragma unroll
        for (int mt = 0; mt < 4; ++mt) af[mt] = *(const bf16x8*)(Ac + (wm * 64 + mt * 16 + l15) * LDS_ST + kk * 32 + q * 8);
#pragma unroll
        for (int nt = 0; nt < 4; ++nt) bfr[nt] = *(const bf16x8*)(Bc + (wn * 64 + nt * 16 + l15) * LDS_ST + kk * 32 + q * 8);
#pragma unroll
        for (int mt = 0; mt < 4; ++mt)
#pragma unroll
          for (int nt = 0; nt < 4; ++nt) acc[mt][nt] = MFMA16(bfr[nt], af[mt], acc[mt][nt]);
      }
      if (kt + 1 < nk) {
        u16* An = As + (cur ^ 1) * 128 * LDS_ST;
        u16* Bn = Bs + (cur ^ 1) * 128 * LDS_ST;
#pragma unroll
        for (int i = 0; i < 4; ++i) {
          int idx = tid + i * 256; int row = idx >> 3, c = idx & 7;
          *(uint4*)(An + row * LDS_ST + c * 8) = ra[i];
          *(uint4*)(Bn + row * LDS_ST + c * 8) = rb[i];
        }
      }
      __syncthreads();
    }
#pragma unroll
    for (int mt = 0; mt < 4; ++mt) {
      const size_t m = (size_t)tm * 128 + wm * 64 + mt * 16 + l15;
#pragma unroll
      for (int nt = 0; nt < 4; ++nt) {
        const int n = tn * 128 + wn * 64 + nt * 16 + q * 4;
        const f32x4 a = acc[mt][nt];
        if (EPI == 1) {
          if (tn < 24) {
            uint2 o; o.x = pack2(a[0], a[1]); o.y = pack2(a[2], a[3]);
            *(uint2*)((u16*)(WS + OFF_R1) + m * 3072 + n) = o;
          } else if (tn < 28) {
            uint2 o; o.x = pack2(a[0], a[1]); o.y = pack2(a[2], a[3]);
            *(uint2*)((u16*)(WS + OFF_ZB) + m * 512 + (n - 3072)) = o;
          } else {
            if (n - 3584 < 8) *(float4*)((float*)(WS + OFF_AB) + m * 8 + (n - 3584)) = make_float4(a[0], a[1], a[2], a[3]);
          }
        } else if (EPI == 2) {
          *(float4*)((float*)(WS + OFF_R1) + m * 1024 + n) = make_float4(a[0], a[1], a[2], a[3]);
        } else {
          uint2 o; o.x = pack2(a[0], a[1]); o.y = pack2(a[2], a[3]);
          *(uint2*)((u16*)(WS + OFF_R1) + m * 2048 + n) = o;
        }
      }
    }
  }
}

DI void phase_p2(const Params& p, int l) {
  char* const WS = opqp(p.ws);
  const int tid = opq(threadIdx.x), lane = tid & 63, w = tid >> 6;
  const u16* R1 = (const u16*)(WS + OFF_R1);
  u16* QKV = (u16*)(WS + OFF_QKV);
  u16* YB = (u16*)(WS + OFF_YB);
  const float* AB = (const float*)(WS + OFF_AB);
  float* GB = (float*)(WS + OFF_GB);
  const float* cw = p.conv_w + (size_t)l * 3 * 512;
  const float* gw = p.gdn_conv_w + (size_t)l * 4 * 1536;
  for (int r = blockIdx.x * 4 + w; r < MR; r += gridDim.x * 4) {
    const int pp = r % LP;
    if (pp < PADR) {
      const uint4 z4 = make_uint4(0, 0, 0, 0);
#pragma unroll
      for (int i = 0; i < 3; ++i) *(uint4*)(QKV + (size_t)r * 1536 + i * 512 + lane * 8) = z4;
      *(uint4*)(YB + (size_t)r * 1024 + lane * 8) = z4;
      *(uint4*)(YB + (size_t)r * 1024 + 512 + lane * 8) = z4;
      if (lane < 8) GB[(size_t)r * 8 + lane] = 0.f;
      continue;
    }
    const int c0 = lane * 8;
    {
      float cb[8], acc[8];
      unpack8(*(const uint4*)(R1 + (size_t)r * 3072 + c0), cb);
#pragma unroll
      for (int i = 0; i < 8; ++i) acc[i] = 0.f;
#pragma unroll
      for (int j = 0; j < 3; ++j) {
        const size_t rr = (size_t)(r - 2 + j);
        float cc[8], ch[8];
        unpack8(*(const uint4*)(R1 + rr * 3072 + 512 + c0), cc);
        unpack8(*(const uint4*)(R1 + rr * 3072 + 1024 + c0), ch);
        float4 w0 = *(const float4*)(cw + j * 512 + c0), w1 = *(const float4*)(cw + j * 512 + c0 + 4);
        const float ww[8] = {w0.x, w0.y, w0.z, w0.w, w1.x, w1.y, w1.z, w1.w};
#pragma unroll
        for (int i = 0; i < 8; ++i) acc[i] += ww[i] * (cc[i] * ch[i]);
      }
#pragma unroll
      for (int i = 0; i < 8; ++i) acc[i] *= cb[i];
      *(uint4*)(YB + (size_t)r * 1024 + c0) = pack8(acc);
    }
#pragma unroll
    for (int part = 0; part < 3; ++part) {
      const int c = part * 512 + c0;
      float acc[8];
#pragma unroll
      for (int i = 0; i < 8; ++i) acc[i] = 0.f;
#pragma unroll
      for (int j = 0; j < 4; ++j) {
        const size_t rr = (size_t)(r - 3 + j);
        float xv[8];
        unpack8(*(const uint4*)(R1 + rr * 3072 + 1536 + c), xv);
        float4 w0 = *(const float4*)(gw + j * 1536 + c), w1 = *(const float4*)(gw + j * 1536 + c + 4);
        const float ww[8] = {w0.x, w0.y, w0.z, w0.w, w1.x, w1.y, w1.z, w1.w};
#pragma unroll
        for (int i = 0; i < 8; ++i) acc[i] += ww[i] * xv[i];
      }
      float ss = 0.f;
#pragma unroll
      for (int i = 0; i < 8; ++i) { acc[i] = siluf(acc[i]); ss += acc[i] * acc[i]; }
      if (part < 2) {
        ss += __shfl_xor(ss, 1); ss += __shfl_xor(ss, 2); ss += __shfl_xor(ss, 4); ss += __shfl_xor(ss, 8);
        float sc = rsqrtf(ss + RMS_EPS);
        if (part == 0) sc *= 0.08838834764831845f;
#pragma unroll
        for (int i = 0; i < 8; ++i) acc[i] *= sc;
      }
      *(uint4*)(QKV + (size_t)r * 1536 + c) = pack8(acc);
    }
    if (lane < 4) {
      const float a = AB[(size_t)r * 8 + lane], bb = AB[(size_t)r * 8 + 4 + lane];
      const float xx = a + p.dt_bias[l * 4 + lane];
      const float tt = __expf(-fabsf(xx));
      const float l1p = (tt < 0.01f) ? tt * (1.0f - tt * (0.5f - tt * 0.33333333f)) : __logf(1.0f + tt);
      const float sp = fmaxf(xx, 0.f) + l1p;
      GB[(size_t)r * 8 + lane] = -__expf(p.a_log[l * 4 + lane]) * sp;
      GB[(size_t)r * 8 + 4 + lane] = 1.0f / (1.0f + __expf(-bb));
    }
  }
}

DI void phase_p3(const Params& p, char* smem) {
  char* const WS = opqp(p.ws);
  constexpr int ST = 136, AST = 68;
  u16* kb = (u16*)smem;
  u16* qb = kb + 64 * ST;
  u16* kbb = qb + 64 * ST;
  float* As = (float*)(kbb + 64 * ST);
  float* s_gc = As + 64 * AST;
  float* s_bt = s_gc + 64;
  const int tid = opq(threadIdx.x), lane = tid & 63, w = tid >> 6, l15 = lane & 15, q = lane >> 4;
  const u16* QKV = (const u16*)(WS + OFF_QKV);
  const float* GB = (const float*)(WS + OFF_GB);
  for (int task = blockIdx.x; task < NB * NCH * 4; task += gridDim.x) {
    const int h = task & 3, bn = task >> 2, b = bn / NCH, n = bn % NCH;
    const size_t row0 = (size_t)b * LP + (size_t)n * 64;
    char* rec = WS + OFF_R1 + (size_t)task * REC_BYTES;
    u16* rec_u = (u16*)rec; u16* rec_w = rec_u + 8192; u16* rec_kT = rec_w + 8192; u16* rec_at = rec_kT + 8192;
    float* rec_eg = (float*)(rec + 57344); float* rec_egl = rec_eg + 64; float* rec_gl = rec_egl + 64;
    const int npad = (n == 0) ? PADR : 0;
    if (tid < 64) {
      const bool pad = tid < npad;
      float g = pad ? 0.f : GB[(row0 + tid) * 8 + h];
      float bt = pad ? 0.f : GB[(row0 + tid) * 8 + 4 + h];
#pragma unroll
      for (int o = 1; o < 64; o <<= 1) { float t = __shfl_up(g, o); if (lane >= o) g += t; }
      s_gc[tid] = g; s_bt[tid] = bt;
      const float gl = __shfl(g, 63);
      rec_eg[tid] = __expf(g);
      rec_egl[tid] = __expf(gl - g);
      if (tid == 0) rec_gl[0] = __expf(gl);
    }
    __syncthreads();
#pragma unroll
    for (int i = 0; i < 4; ++i) {
      int idx = tid + i * 256; int row = idx >> 4, c = idx & 15;
      uint4 kv = make_uint4(0, 0, 0, 0), qv = make_uint4(0, 0, 0, 0);
      if (row >= npad) {
        kv = *(const uint4*)(QKV + (row0 + row) * 1536 + 512 + h * 128 + c * 8);
        qv = *(const uint4*)(QKV + (row0 + row) * 1536 + h * 128 + c * 8);
      }
      *(uint4*)(kb + row * ST + c * 8) = kv;
      *(uint4*)(qb + row * ST + c * 8) = qv;
      float kf[8]; unpack8(kv, kf);
      const float bt = s_bt[row];
#pragma unroll
      for (int j = 0; j < 8; ++j) kf[j] *= bt;
      *(uint4*)(kbb + row * ST + c * 8) = pack8(kf);
    }
    __syncthreads();
#pragma unroll
    for (int it = 0; it < 4; ++it) {
      int idx = tid + it * 256; int d = idx >> 3, i8 = idx & 7;
      u32 t[4];
#pragma unroll
      for (int jj = 0; jj < 4; ++jj) t[jj] = (u32)kb[(i8 * 8 + 2 * jj) * ST + d] | ((u32)kb[(i8 * 8 + 2 * jj + 1) * ST + d] << 16);
      *(uint4*)(rec_kT + d * 64 + i8 * 8) = make_uint4(t[0], t[1], t[2], t[3]);
    }
    {
      const int mat = w >> 1;
      const u16* src = mat ? qb : kbb;
      f32x4 acc[2][4];
#pragma unroll
      for (int i = 0; i < 2; ++i)
#pragma unroll
        for (int j = 0; j < 4; ++j) acc[i][j] = (f32x4){0.f, 0.f, 0.f, 0.f};
#pragma unroll
      for (int ks = 0; ks < 4; ++ks) {
        bf16x8 a[2], bb[4];
#pragma unroll
        for (int mi = 0; mi < 2; ++mi) a[mi] = *(const bf16x8*)(src + (((w & 1) * 2 + mi) * 16 + l15) * ST + ks * 32 + q * 8);
#pragma unroll
        for (int nt = 0; nt < 4; ++nt) bb[nt] = *(const bf16x8*)(kb + (nt * 16 + l15) * ST + ks * 32 + q * 8);
#pragma unroll
        for (int mi = 0; mi < 2; ++mi)
#pragma unroll
          for (int nt = 0; nt < 4; ++nt) acc[mi][nt] = MFMA16(a[mi], bb[nt], acc[mi][nt]);
      }
#pragma unroll
      for (int mi = 0; mi < 2; ++mi)
#pragma unroll
        for (int nt = 0; nt < 4; ++nt)
#pragma unroll
          for (int r = 0; r < 4; ++r) {
            const int i = ((w & 1) * 2 + mi) * 16 + q * 4 + r, j = nt * 16 + l15;
            const float dec = __expf(s_gc[i] - s_gc[j]);
            if (mat == 0) As[i * AST + j] = (i > j) ? acc[mi][nt][r] * dec : 0.f;
            else rec_at[i * 64 + j] = f2bf((i >= j) ? acc[mi][nt][r] * dec : 0.f);
          }
    }
    __syncthreads();
    {
      const int mat = tid >> 7, c = tid & 127;
      float x[64];
      if (mat == 0) {
#pragma unroll
        for (int i = 0; i < 64; ++i) {
          const float vv = (i >= npad) ? bf2f(QKV[(row0 + i) * 1536 + 1024 + h * 128 + c]) : 0.f;
          x[i] = vv * s_bt[i];
        }
      } else {
#pragma unroll
        for (int i = 0; i < 64; ++i) x[i] = bf2f(kb[i * ST + c]) * s_bt[i] * __expf(s_gc[i]);
      }
#pragma unroll
      for (int i = 1; i < 64; ++i) {
        float s = x[i];
#pragma unroll
        for (int j4 = 0; j4 < (i + 3) / 4; ++j4) {
          const float4 a = *(const float4*)(As + i * AST + j4 * 4);
          s -= a.x * x[j4 * 4 + 0];
          if (j4 * 4 + 1 < i) s -= a.y * x[j4 * 4 + 1];
          if (j4 * 4 + 2 < i) s -= a.z * x[j4 * 4 + 2];
          if (j4 * 4 + 3 < i) s -= a.w * x[j4 * 4 + 3];
        }
        x[i] = s;
        if ((i & 3) == 3) SCHED_FENCE;
      }
      if (mat) {
#pragma unroll
        for (int i = 0; i < 64; ++i) rec_w[i * 128 + c] = f2bf(x[i]);
      } else {
        const int ug = c >> 4, ul = c & 15;
#pragma unroll
        for (int mt = 0; mt < 4; ++mt)
#pragma unroll
          for (int qq = 0; qq < 4; ++qq) {
            const int i0 = mt * 16 + qq * 4;
            uint2 o; o.x = pack2(x[i0], x[i0 + 1]); o.y = pack2(x[i0 + 2], x[i0 + 3]);
            *(uint2*)(rec_u + ((ug * 64 + qq * 16 + ul) * 16 + mt * 4)) = o;
          }
      }
    }
    __syncthreads();
  }
}

DI void phase_scan(const Params& p, int l, char* smem) {
  char* const WS = opqp(p.ws);
  if (blockIdx.x >= 32) return;
  constexpr int ST = 136, ST2 = 72;
  u16* ws_ = (u16*)smem;
  u16* qs_ = ws_ + 64 * ST;
  u16* kts = qs_ + 64 * ST;
  u16* ats = kts + 128 * ST2;
  float* scl = (float*)(ats + 64 * ST2);
  const int tid = opq(threadIdx.x), lane = tid & 63, w = tid >> 6, l15 = lane & 15, q = lane >> 4;
  const int b = blockIdx.x >> 3, h = (blockIdx.x >> 1) & 3, half = blockIdx.x & 1;
  const u16* QKV = (const u16*)(WS + OFF_QKV);
  u16* YB = (u16*)(WS + OFF_YB);
  const int uoff = ((half * 4 + w) * 64 + lane) * 16;
  f32x4 S[8];
#pragma unroll
  for (int i = 0; i < 8; ++i) S[i] = (f32x4){0.f, 0.f, 0.f, 0.f};
  uint4 uc0, uc1;
  {
    const int task = ((b * NCH) << 2) + h;
    const size_t row0 = (size_t)b * LP;
    const char* rec = WS + OFF_R1 + (size_t)task * REC_BYTES;
    const u16* rec_u = (const u16*)rec; const u16* rec_w = rec_u + 8192; const u16* rec_kT = rec_w + 8192; const u16* rec_at = rec_kT + 8192;
    const float* rec_eg = (const float*)(rec + 57344);
#pragma unroll
    for (int i = 0; i < 4; ++i) {
      int idx = tid + i * 256; int row = idx >> 4, c = idx & 15;
      *(uint4*)(ws_ + row * ST + c * 8) = *(const uint4*)(rec_w + row * 128 + c * 8);
      *(uint4*)(qs_ + row * ST + c * 8) = *(const uint4*)(QKV + (row0 + row) * 1536 + h * 128 + c * 8);
      int rk = idx >> 3, ck = idx & 7;
      *(uint4*)(kts + rk * ST2 + ck * 8) = *(const uint4*)(rec_kT + rk * 64 + ck * 8);
    }
#pragma unroll
    for (int i = 0; i < 2; ++i) { int idx = tid + i * 256; int row = idx >> 3, c = idx & 7; *(uint4*)(ats + row * ST2 + c * 8) = *(const uint4*)(rec_at + row * 64 + c * 8); }
    if (tid < 129) scl[tid] = rec_eg[tid];
    uc0 = *(const uint4*)(rec_u + uoff); uc1 = *(const uint4*)(rec_u + uoff + 8);
  }
  __syncthreads();
  for (int n = 0; n < NCH; ++n) {
    const int cur = n & 1;
    const bool has_next = (n + 1 < NCH);
    const size_t row0 = (size_t)b * LP + (size_t)n * 64;
    const int taskn = ((b * NCH + (has_next ? n + 1 : n)) << 2) + h;
    const char* recn = WS + OFF_R1 + (size_t)taskn * REC_BYTES;
    const u16* recn_u = (const u16*)recn; const u16* recn_w = recn_u + 8192; const u16* recn_kT = recn_w + 8192; const u16* recn_at = recn_kT + 8192;
    const float* recn_eg = (const float*)(recn + 57344);
    const size_t row0n = has_next ? row0 + 64 : row0;
    const float* egs = scl + cur * 132;
    const float* egls = egs + 64;
    uint4 ra0, ra1, ra2, ra3, ra4, ra5, ra6, ra7;
    {
      const int tl = opq(threadIdx.x);
#define LD_A(i, RW, RQ) { const int idx = tl + (i) * 256; const int row = idx >> 4, c = idx & 15; \
        RW = *(const uint4*)(recn_w + row * 128 + c * 8); RQ = *(const uint4*)(QKV + (row0n + row) * 1536 + h * 128 + c * 8); }
      LD_A(0, ra0, ra4) LD_A(1, ra1, ra5) LD_A(2, ra2, ra6) LD_A(3, ra3, ra7)
    }
    f32x4 P[4], O[4];
#pragma unroll
    for (int i = 0; i < 4; ++i) { P[i] = O[i] = (f32x4){0.f, 0.f, 0.f, 0.f}; }
#pragma unroll
    for (int ks = 0; ks < 4; ++ks) {
      const bf16x8 sb0 = pack_acc2(S[2 * ks], S[2 * ks + 1]);
#pragma unroll
      for (int mt = 0; mt < 4; ++mt) {
        const bf16x8 aw = read2x4(ws_ + (mt * 16 + l15) * ST, ks * 32 + 4 * q, ks * 32 + 16 + 4 * q);
        const bf16x8 aq = read2x4(qs_ + (mt * 16 + l15) * ST, ks * 32 + 4 * q, ks * 32 + 16 + 4 * q);
        P[mt] = MFMA16(aw, sb0, P[mt]);
        O[mt] = MFMA16(aq, sb0, O[mt]);
      }
    }
    {
      const u32 uw_[8] = {uc0.x, uc0.y, uc0.z, uc0.w, uc1.x, uc1.y, uc1.z, uc1.w};
#pragma unroll
      for (int mt = 0; mt < 4; ++mt)
#pragma unroll
        for (int r = 0; r < 4; ++r) {
          const int i = mt * 16 + 4 * q + r;
          const int ui = mt * 4 + r;
          const float uv = (ui & 1) ? bfhi(uw_[ui >> 1]) : bflo(uw_[ui >> 1]);
          P[mt][r] = uv - P[mt][r];
          O[mt][r] *= egs[i];
        }
    }
    SCHED_FENCE;
    __syncthreads();
    uint4 rb0, rb1, rb2, rb3, rb4, rb5, un0, un1;
    float e_next = 0.f;
    {
      const int tl = opq(threadIdx.x);
#define ST_A(i, RW, RQ) { const int idx = tl + (i) * 256; const int row = idx >> 4, c = idx & 15; \
        *(uint4*)(ws_ + row * ST + c * 8) = RW; *(uint4*)(qs_ + row * ST + c * 8) = RQ; }
      ST_A(0, ra0, ra4) ST_A(1, ra1, ra5) ST_A(2, ra2, ra6) ST_A(3, ra3, ra7)
#define LD_K(i, R) { const int idx = tl + (i) * 256; const int rk = idx >> 3, ck = idx & 7; R = *(const uint4*)(recn_kT + rk * 64 + ck * 8); }
      LD_K(0, rb0) LD_K(1, rb1) LD_K(2, rb2) LD_K(3, rb3)
#define LD_T(i, R) { const int idx = tl + (i) * 256; const int row = idx >> 3, c = idx & 7; R = *(const uint4*)(recn_at + row * 64 + c * 8); }
      LD_T(0, rb4) LD_T(1, rb5)
      un0 = *(const uint4*)(recn_u + uoff);
      un1 = *(const uint4*)(recn_u + uoff + 8);
      if (tl < 129) e_next = recn_eg[tl];
    }
    {
      bf16x8 vb[2];
#pragma unroll
      for (int k2 = 0; k2 < 2; ++k2) vb[k2] = pack_acc2(P[2 * k2], P[2 * k2 + 1]);
#pragma unroll
      for (int k2 = 0; k2 < 2; ++k2)
#pragma unroll
        for (int mt = 0; mt < 4; ++mt) {
          const bf16x8 aa = read2x4(ats + (mt * 16 + l15) * ST2, k2 * 32 + 4 * q, k2 * 32 + 16 + 4 * q);
          O[mt] = MFMA16(aa, vb[k2], O[mt]);
        }
    }
    {
      const int npad = (n == 0) ? PADR : 0;
      u16* yp = YB + (row0 + 4 * q) * 1024 + 512 + h * 128 + half * 64 + w * 16 + l15;
#pragma unroll
      for (int mt = 0; mt < 4; ++mt)
#pragma unroll
        for (int r = 0; r < 4; ++r)
          if (mt * 16 + 4 * q + r >= npad) yp[(mt * 16 + r) * 1024] = f2bf(O[mt][r]);
    }
    {
#pragma unroll
      for (int mt = 0; mt < 4; ++mt)
#pragma unroll
        for (int r = 0; r < 4; ++r) P[mt][r] *= egls[mt * 16 + 4 * q + r];
      bf16x8 vb[2];
#pragma unroll
      for (int k2 = 0; k2 < 2; ++k2) vb[k2] = pack_acc2(P[2 * k2], P[2 * k2 + 1]);
      const float egl = egs[128];
#pragma unroll
      for (int dt = 0; dt < 8; ++dt) S[dt] *= egl;
#pragma unroll
      for (int k2 = 0; k2 < 2; ++k2)
#pragma unroll
        for (int dt = 0; dt < 8; ++dt) {
          const bf16x8 ak = read2x4(kts + (dt * 16 + l15) * ST2, k2 * 32 + 4 * q, k2 * 32 + 16 + 4 * q);
          S[dt] = MFMA16(ak, vb[k2], S[dt]);
        }
    }
    SCHED_FENCE;
    __syncthreads();
    {
      const int tl = opq(threadIdx.x);
#define ST_K(i, R) { const int idx = tl + (i) * 256; const int rk = idx >> 3, ck = idx & 7; *(uint4*)(kts + rk * ST2 + ck * 8) = R; }
      ST_K(0, rb0) ST_K(1, rb1) ST_K(2, rb2) ST_K(3, rb3)
#define ST_T(i, R) { const int idx = tl + (i) * 256; const int row = idx >> 3, c = idx & 7; *(uint4*)(ats + row * ST2 + c * 8) = R; }
      ST_T(0, rb4) ST_T(1, rb5)
      if (tl < 129) scl[(cur ^ 1) * 132 + tl] = e_next;
    }
    uc0 = un0; uc1 = un1;
    __syncthreads();
  }
}

DI void phase_p5(const Params& p, int l) {
  char* const WS = opqp(p.ws);
  const int tid = opq(threadIdx.x), lane = tid & 63, w = tid >> 6;
  const u16* ZB = (const u16*)(WS + OFF_ZB);
  u16* YB = (u16*)(WS + OFF_YB);
  const float* nw = p.gdn_norm_w + l * 128;
  const int c0 = (lane & 15) * 8;
  const float4 n0 = *(const float4*)(nw + c0), n1 = *(const float4*)(nw + c0 + 4);
  const float nn[8] = {n0.x, n0.y, n0.z, n0.w, n1.x, n1.y, n1.z, n1.w};
  for (int ti = blockIdx.x * 4 + w; ti < NB * (SEQ + NMETA); ti += gridDim.x * 4) {
    const int b = ti / (SEQ + NMETA), pp = PADR + ti % (SEQ + NMETA);
    const size_t r = (size_t)b * LP + pp;
    float ov[8], zf[8], yv[8];
    unpack8(*(const uint4*)(YB + r * 1024 + 512 + lane * 8), ov);
    unpack8(*(const uint4*)(ZB + r * 512 + lane * 8), zf);
    float ss = 0.f;
#pragma unroll
    for (int j = 0; j < 8; ++j) ss += ov[j] * ov[j];
    ss += __shfl_xor(ss, 1); ss += __shfl_xor(ss, 2); ss += __shfl_xor(ss, 4); ss += __shfl_xor(ss, 8);
    const float rs = rsqrtf(ss * (1.0f / 128.0f) + RMS_EPS);
#pragma unroll
    for (int j = 0; j < 8; ++j) yv[j] = ov[j] * rs * nn[j] * siluf(zf[j]);
    *(uint4*)(YB + r * 1024 + 512 + lane * 8) = pack8(yv);
  }
}

DI void phase_ln1(const Params& p, int l) {
  char* const WS = opqp(p.ws);
  const int tid = opq(threadIdx.x), lane = tid & 63, w = tid >> 6;
  const u16* HB = (const u16*)(WS + OFF_HB);
  const float* MIX = (const float*)(WS + OFF_R1);
  u16* H1 = (u16*)(WS + OFF_QKV);
  for (int r = blockIdx.x * 4 + w; r < MR; r += gridDim.x * 4) {
    const int pp = r % LP;
    float v[16];
    if (pp < PADR) {
#pragma unroll
      for (int i = 0; i < 16; ++i) v[i] = 0.f;
    } else {
      float hv[16];
      unpack8(*(const uint4*)(HB + (size_t)r * 1024 + lane * 16), hv);
      unpack8(*(const uint4*)(HB + (size_t)r * 1024 + lane * 16 + 8), hv + 8);
#pragma unroll
      for (int i4 = 0; i4 < 4; ++i4) {
        float4 t = *(const float4*)(MIX + (size_t)r * 1024 + lane * 16 + i4 * 4);
        v[i4 * 4] = ALPHA * hv[i4 * 4] + t.x; v[i4 * 4 + 1] = ALPHA * hv[i4 * 4 + 1] + t.y;
        v[i4 * 4 + 2] = ALPHA * hv[i4 * 4 + 2] + t.z; v[i4 * 4 + 3] = ALPHA * hv[i4 * 4 + 3] + t.w;
      }
      ln_row16(v, p.ln1_g + l * 1024, p.ln1_b + l * 1024, lane);
    }
    store_row16_bf16(H1 + (size_t)r * 1024, v, lane);
  }
}

DI void phase_p6(const Params& p, int l, char* smem) {
  char* const WS = opqp(p.ws);
  constexpr int KST = 136, SST = 132;
  u16* kh = (u16*)smem;
  u32* lst = (u32*)smem;
  float* sc = (float*)(smem + 128 * KST * 2);
  float* fin_t = sc + 64 * SST;
  unsigned char* fin_i = (unsigned char*)(fin_t + 64 * 32);
  const int tid = opq(threadIdx.x), lane = tid & 63, w = tid >> 6, l15 = lane & 15, q = lane >> 4;
  const u16* QP = (const u16*)(WS + OFF_R1);
  const u16* SK = (const u16*)(WS + OFF_SK) + (size_t)l * 2 * 16384;
  int* IDX = (int*)(WS + OFF_IDX);
  float* GATE = (float*)(WS + OFF_GATE);
  for (int task = blockIdx.x; task < (MR / 64) * 8; task += gridDim.x) {
    const int tt = task >> 3, hd = task & 7;
    const size_t row0 = (size_t)tt * 64;
    for (int hf = 0; hf < 2; ++hf) {
#pragma unroll
      for (int i = 0; i < 8; ++i) {
        int idx = tid + i * 256; int row = idx >> 4, c = idx & 15;
        *(uint4*)(kh + row * KST + c * 8) = *(const uint4*)(SK + hf * 16384 + row * 128 + c * 8);
      }
      __syncthreads();
      {
        f32x4 acc[8];
#pragma unroll
        for (int i = 0; i < 8; ++i) acc[i] = (f32x4){0.f, 0.f, 0.f, 0.f};
        const u16* qrow = QP + (row0 + w * 16 + l15) * 2048 + hd * 256 + hf * 128;
#pragma unroll
        for (int ks = 0; ks < 4; ++ks) {
          const bf16x8 af = *(const bf16x8*)(qrow + ks * 32 + q * 8);
#pragma unroll
          for (int nt = 0; nt < 8; ++nt) {
            const bf16x8 bk = *(const bf16x8*)(kh + (nt * 16 + l15) * KST + ks * 32 + q * 8);
            acc[nt] = MFMA16(af, bk, acc[nt]);
          }
        }
#pragma unroll
        for (int nt = 0; nt < 8; ++nt)
#pragma unroll
          for (int r = 0; r < 4; ++r) sc[(w * 16 + 4 * q + r) * SST + nt * 16 + l15] = acc[nt][r];
      }
      __syncthreads();
      {
        const int tok = tid >> 2, qr = tid & 3;
        u32 v[16];
#pragma unroll
        for (int i = 0; i < 16; ++i) v[i] = 0u;
#pragma unroll 4
        for (int j = 0; j < 32; ++j) {
          const int key = qr + 4 * j;
          const u32 pk = (orderable(sc[tok * SST + key]) & ~127u) | (u32)(127 - key);
          INS16(v, pk);
        }
#pragma unroll
        for (int i = 0; i < 4; ++i) *(uint4*)(lst + (tok * 4 + qr) * 16 + i * 4) = make_uint4(v[i * 4], v[i * 4 + 1], v[i * 4 + 2], v[i * 4 + 3]);
      }
      __syncthreads();
      if (tid < 64) {
        u32 v[16];
#pragma unroll
        for (int i = 0; i < 4; ++i) { uint4 t = *(const uint4*)(lst + (tid * 4) * 16 + i * 4); v[i * 4] = t.x; v[i * 4 + 1] = t.y; v[i * 4 + 2] = t.z; v[i * 4 + 3] = t.w; }
#pragma unroll 4
        for (int j = 16; j < 64; ++j) { const u32 pk = lst[tid * 64 + j]; INS16(v, pk); }
#pragma unroll
        for (int k = 0; k < 16; ++k) {
          const int key = 127 - (int)(v[k] & 127u);
          fin_t[tid * 32 + hf * 16 + k] = sc[tid * SST + key];
          fin_i[tid * 32 + hf * 16 + k] = (unsigned char)key;
        }
      }
      __syncthreads();
    }
    if (tid < 64) {
      float t1[16], t2[16];
#pragma unroll
      for (int k = 0; k < 16; ++k) { t1[k] = fin_t[tid * 32 + k]; t2[k] = fin_t[tid * 32 + 16 + k]; }
      u32 v[16];
#pragma unroll
      for (int i = 0; i < 16; ++i) v[i] = 0u;
#define CAND_ROW(a, nb) { _Pragma("unroll") for (int bq = 0; bq < (nb); ++bq) { const u32 pk = (orderable(t1[a] + t2[bq]) & ~255u) | (u32)(255 - ((a) * 16 + bq)); INS16(v, pk); } }
      CAND_ROW(0, 16) CAND_ROW(1, 8) CAND_ROW(2, 5) CAND_ROW(3, 4) CAND_ROW(4, 3) CAND_ROW(5, 2) CAND_ROW(6, 2) CAND_ROW(7, 2)
      CAND_ROW(8, 1) CAND_ROW(9, 1) CAND_ROW(10, 1) CAND_ROW(11, 1) CAND_ROW(12, 1) CAND_ROW(13, 1) CAND_ROW(14, 1) CAND_ROW(15, 1)
      float sm[16]; int ex[16];
      float mx = -1e30f;
#pragma unroll
      for (int k = 0; k < 16; ++k) {
        const int ci = 255 - (int)(v[k] & 255u);
        const int a = ci >> 4, bq = ci & 15;
        sm[k] = fin_t[tid * 32 + a] + fin_t[tid * 32 + 16 + bq];
        ex[k] = (int)fin_i[tid * 32 + a] * 128 + (int)fin_i[tid * 32 + 16 + bq];
        mx = fmaxf(mx, sm[k]);
      }
      float den = 0.f;
#pragma unroll
      for (int k = 0; k < 16; ++k) { sm[k] = __expf(sm[k] - mx); den += sm[k]; }
      const float inv = 1.0f / den;
      int* io = IDX + (row0 + tid) * 128 + hd * 16;
      float* go = GATE + (row0 + tid) * 128 + hd * 16;
#pragma unroll
      for (int k4 = 0; k4 < 4; ++k4) {
        *(int4*)(io + k4 * 4) = make_int4(ex[k4 * 4], ex[k4 * 4 + 1], ex[k4 * 4 + 2], ex[k4 * 4 + 3]);
        *(float4*)(go + k4 * 4) = make_float4(sm[k4 * 4] * inv, sm[k4 * 4 + 1] * inv, sm[k4 * 4 + 2] * inv, sm[k4 * 4 + 3] * inv);
      }
    }
    __syncthreads();
  }
}

DI void phase_p7(const Params& p, int l) {
  char* const WS = opqp(p.ws);
  const int tid = opq(threadIdx.x), lane = tid & 63, w = tid >> 6;
  const u16* H1 = (const u16*)(WS + OFF_QKV);
  u16* HB = (u16*)(WS + OFF_HB);
  const char* TU = WS + OFF_TAB;
  const char* TV = TU + (size_t)16384 * 1024;
  const int* IDX = (const int*)(WS + OFF_IDX);
  const float* GATE = (const float*)(WS + OFF_GATE);
  const bool last = (l == 1);
  const int per_b = last ? SEQ : (SEQ + NMETA);
  const int ntok = NB * per_b;
  for (int ti = blockIdx.x * 4 + w; ti < ntok; ti += gridDim.x * 4) {
    const int b = ti / per_b, pp = (last ? 64 : PADR) + ti % per_b;
    const size_t r = (size_t)b * LP + pp;
    float x[16];
    unpack8(*(const uint4*)(H1 + r * 1024 + lane * 16), x);
    unpack8(*(const uint4*)(H1 + r * 1024 + lane * 16 + 8), x + 8);
    const int id0 = IDX[r * 128 + lane], id1 = IDX[r * 128 + 64 + lane];
    const float g0 = GATE[r * 128 + lane], g1 = GATE[r * 128 + 64 + lane];
    float d0 = 0.f, d1 = 0.f;
    for (int eb = 0; eb < 128; eb += 8) {
      uint4 ud[8];
#pragma unroll
      for (int j = 0; j < 8; ++j) {
        const int e = eb + j;
        const int id = __builtin_amdgcn_readlane((eb < 64) ? id0 : id1, e & 63);
        ud[j] = *(const uint4*)(TU + (size_t)id * 1024 + lane * 16);
      }
#pragma unroll
      for (int j = 0; j < 8; ++j) {
        float f[16]; dec_fp8x16(ud[j], f);
        float s = 0.f;
#pragma unroll
        for (int i = 0; i < 16; ++i) s += x[i] * f[i];
        s = wsum(s);
        const int e = eb + j;
        if (lane == (e & 63)) { if (eb < 64) d0 = s; else d1 = s; }
      }
    }
    float c0, c1;
    { const float a = d0 * TINV; c0 = g0 * 0.5f * a * (1.0f + erf_as(a * 0.7071067811865476f)) * TINV; }
    { const float a = d1 * TINV; c1 = g1 * 0.5f * a * (1.0f + erf_as(a * 0.7071067811865476f)) * TINV; }
    float acc[16];
#pragma unroll
    for (int i = 0; i < 16; ++i) acc[i] = 0.f;
    for (int eb = 0; eb < 128; eb += 8) {
      uint4 vd[8];
#pragma unroll
      for (int j = 0; j < 8; ++j) {
        const int e = eb + j;
        const int id = __builtin_amdgcn_readlane((eb < 64) ? id0 : id1, e & 63);
        vd[j] = *(const uint4*)(TV + (size_t)id * 1024 + lane * 16);
      }
#pragma unroll
      for (int j = 0; j < 8; ++j) {
        const int e = eb + j;
        const float cf = __int_as_float(__builtin_amdgcn_readlane(__float_as_int((eb < 64) ? c0 : c1), e & 63));
        float f[16]; dec_fp8x16(vd[j], f);
#pragma unroll
        for (int i = 0; i < 16; ++i) acc[i] += cf * f[i];
      }
    }
#pragma unroll
    for (int i = 0; i < 16; ++i) acc[i] += ALPHA * x[i];
    ln_row16(acc, p.ln2_g + l * 1024, p.ln2_b + l * 1024, lane);
    if (!last) {
      store_row16_bf16(HB + r * 1024, acc, lane);
    } else {
      float* o = p.out + ((size_t)b * SEQ + (pp - 64)) * 1024 + lane * 16;
#pragma unroll
      for (int i4 = 0; i4 < 4; ++i4) *(float4*)(o + i4 * 4) = make_float4(acc[i4 * 4], acc[i4 * 4 + 1], acc[i4 * 4 + 2], acc[i4 * 4 + 3]);
    }
  }
}

#ifndef DUP_GEMM
#define DUP_GEMM 0
#endif
#ifndef DUP_P7
#define DUP_P7 0
#endif
#ifndef DUP_SCAN
#define DUP_SCAN 0
#endif
#ifndef DUP_MISC
#define DUP_MISC 0
#endif
template <int l>
DI void layer(const Params& p, char* smem, cg::grid_group& grid) {
  for (int rep = 0; rep <= DUP_GEMM; ++rep) { gemm_phase<1>(p, OFF_HB, OFF_WIN + l * SZ_WIN1, NPROJP / 128, smem); grid.sync(); }
  for (int rep = 0; rep <= DUP_MISC; ++rep) { phase_p2(p, l); grid.sync(); }
  for (int rep = 0; rep <= DUP_MISC; ++rep) { phase_p3(p, smem); grid.sync(); }
  for (int rep = 0; rep <= DUP_SCAN; ++rep) { phase_scan(p, l, smem); grid.sync(); }
  phase_p5(p, l); grid.sync();
  for (int rep = 0; rep <= DUP_GEMM; ++rep) { gemm_phase<2>(p, OFF_YB, OFF_WOUT + l * SZ_WOUT1, 8, smem); grid.sync(); }
  for (int rep = 0; rep <= DUP_MISC; ++rep) { phase_ln1(p, l); grid.sync(); }
  convert_tables(p, l);
  for (int rep = 0; rep <= DUP_GEMM; ++rep) { gemm_phase<3>(p, OFF_QKV, OFF_WQ + l * SZ_WQ1, 16, smem); grid.sync(); }
  for (int rep = 0; rep <= DUP_MISC; ++rep) { phase_p6(p, l, smem); grid.sync(); }
  for (int rep = 0; rep <= DUP_P7; ++rep) { phase_p7(p, l); if (rep < DUP_P7) grid.sync(); }
}
__global__ void __launch_bounds__(256, 2) fwd_megakernel(Params p) {
  __shared__ __attribute__((aligned(16))) char smem[81920];
  cg::grid_group grid = cg::this_grid();
  phase_prologue(p, smem);
  grid.sync();
  layer<0>(p, smem, grid);
  grid.sync();
  layer<1>(p, smem, grid);
}

extern "C" void kernel_launch(void* const* d_in, const int* in_sizes, int n_in, void* d_out,
                              int out_size, void* d_ws, size_t ws_size, hipStream_t stream) {
  static int grid_blocks = 0;
  if (!grid_blocks) {
    int dev = 0, cus = 0, per_cu = 0;
    (void)hipGetDevice(&dev);
    (void)hipDeviceGetAttribute(&cus, hipDeviceAttributeMultiprocessorCount, dev);
    (void)hipOccupancyMaxActiveBlocksPerMultiprocessor(&per_cu, fwd_megakernel, 256, 0);
    if (per_cu > 2) per_cu = 2;
    if (per_cu < 1) per_cu = 1;
    grid_blocks = cus * per_cu;
  }
  if (ws_size < WS_NEED) { fprintf(stderr, "workspace too small\n"); return; }
  Params p{};
  p.x = (const float*)d_in[0]; p.meta = (const float*)d_in[1]; p.ln_in_g = (const float*)d_in[2]; p.ln_in_b = (const float*)d_in[3];
  p.w_in = (const float*)d_in[4]; p.conv_w = (const float*)d_in[5]; p.gdn_conv_w = (const float*)d_in[6]; p.a_log = (const float*)d_in[7];
  p.dt_bias = (const float*)d_in[8]; p.gdn_norm_w = (const float*)d_in[9]; p.w_out = (const float*)d_in[10]; p.ln1_g = (const float*)d_in[11];
  p.ln1_b = (const float*)d_in[12]; p.w_q = (const float*)d_in[13]; p.k1 = (const float*)d_in[14]; p.k2 = (const float*)d_in[15];
  p.pu = (const float*)d_in[16]; p.pv = (const float*)d_in[17]; p.ln2_g = (const float*)d_in[18]; p.ln2_b = (const float*)d_in[19];
  p.out = (float*)d_out; p.ws = (char*)d_ws;
  void* args[] = {&p};
  hipError_t e = hipLaunchCooperativeKernel((void*)fwd_megakernel, dim3(grid_blocks), dim3(256), args, 0, stream);
  if (e != hipSuccess) fprintf(stderr, "cooperative launch failed: %s (grid %d)\n", hipGetErrorString(e), grid_blocks);
}
```

```cpp
#include <hip/hip_runtime.h>
#include <hip/hip_cooperative_groups.h>
#include <cstdio>
namespace cg = cooperative_groups;

typedef unsigned short u16;
typedef unsigned int u32;
using bf16x8 = __attribute__((ext_vector_type(8))) short;
using s16x4 = __attribute__((ext_vector_type(4))) short;
using f32x4 = __attribute__((ext_vector_type(4))) float;
using f32x2 = __attribute__((ext_vector_type(2))) float;

#define DI __device__ __forceinline__
#define MFMA16(a, b, c) __builtin_amdgcn_mfma_f32_16x16x32_bf16((a), (b), (c), 0, 0, 0)

constexpr int NB = 4, SEQ = 8192, NMETA = 16, DM = 1024;
constexpr int LP = 8256;
constexpr int PADR = 48;
constexpr int MR = NB * LP;
constexpr int NCH = 129;
constexpr int NPROJ = 3592, NPROJP = 3712;
constexpr float ALPHA = 1.4142135623730951f;
constexpr float LN_EPS = 1e-5f, RMS_EPS = 1e-6f;
constexpr float TSCALE = 64.0f, TINV = 1.0f / 64.0f;

constexpr size_t SZ_HB = (size_t)MR * 1024 * 2;
constexpr size_t OFF_HB = 0;
constexpr size_t OFF_R1 = OFF_HB + SZ_HB;
constexpr size_t SZ_R1 = (size_t)MR * 3072 * 2;
constexpr size_t OFF_ZB = OFF_R1 + SZ_R1;
constexpr size_t SZ_ZB = (size_t)MR * 512 * 2;
constexpr size_t OFF_QKV = OFF_ZB + SZ_ZB;
constexpr size_t SZ_QKV = (size_t)MR * 1536 * 2;
constexpr size_t OFF_TAB = OFF_QKV + SZ_HB;
constexpr size_t OFF_YB = OFF_QKV + SZ_QKV;
constexpr size_t OFF_AB = OFF_YB + SZ_HB;
constexpr size_t SZ_AB = (size_t)MR * 8 * 4;
constexpr size_t OFF_GB = OFF_AB + SZ_AB;
constexpr size_t OFF_WIN = OFF_GB + SZ_AB;
constexpr size_t SZ_WIN1 = (size_t)NPROJP * 1024 * 2;
constexpr size_t OFF_WOUT = OFF_WIN + 2 * SZ_WIN1;
constexpr size_t SZ_WOUT1 = (size_t)1024 * 1024 * 2;
constexpr size_t OFF_WQ = OFF_WOUT + 2 * SZ_WOUT1;
constexpr size_t SZ_WQ1 = (size_t)2048 * 1024 * 2;
constexpr size_t OFF_SK = OFF_WQ + 2 * SZ_WQ1;
constexpr size_t SZ_SK1 = (size_t)2 * 128 * 128 * 2;
constexpr size_t OFF_BAR = OFF_SK + 2 * SZ_SK1;
constexpr size_t WS_NEED = OFF_BAR + 16384;
constexpr size_t REC_BYTES = 58368;
constexpr size_t OFF_IDX = OFF_R1 + (size_t)MR * 2048 * 2;
constexpr size_t OFF_GATE = OFF_IDX + (size_t)MR * 128 * 4;
static_assert((size_t)NB * NCH * 4 * REC_BYTES <= SZ_R1, "rec");
static_assert(OFF_GATE + (size_t)MR * 128 * 4 <= OFF_R1 + SZ_R1, "idx");
static_assert((size_t)2 * 16384 * 1024 <= SZ_QKV - SZ_HB, "tab");
static_assert(WS_NEED <= (size_t)512 * 1024 * 1024, "ws");

struct Params {
  const float* x; const float* meta; const float* ln_in_g; const float* ln_in_b;
  const float* w_in; const float* conv_w; const float* gdn_conv_w; const float* a_log; const float* dt_bias;
  const float* gdn_norm_w; const float* w_out; const float* ln1_g; const float* ln1_b;
  const float* w_q; const float* k1; const float* k2; const float* pu; const float* pv;
  const float* ln2_g; const float* ln2_b;
  float* out; char* ws;
};

DI int opq(int x) { asm volatile("" : "+v"(x)); return x; }
DI char* opqp(char* w) { long z = 0; asm volatile("" : "+s"(z)); return w + z; }
DI int opqs(int x) { asm volatile("" : "+s"(x)); return x; }
#define SCHED_FENCE __builtin_amdgcn_sched_barrier(0)
typedef __bf16 hbf16x2 __attribute__((ext_vector_type(2)));
DI u32 pack2(float a, float b) { f32x2 v = {a, b}; hbf16x2 r = __builtin_convertvector(v, hbf16x2); return __builtin_bit_cast(u32, r); }
DI u16 f2bf(float x) { return (u16)(pack2(x, 0.f) & 0xffffu); }
DI float bf2f(u16 h) { return __uint_as_float(((u32)h) << 16); }
DI float bflo(u32 w) { return __uint_as_float(w << 16); }
DI float bfhi(u32 w) { return __uint_as_float(w & 0xffff0000u); }
DI float wsum(float v) {
#pragma unroll
  for (int o = 32; o > 0; o >>= 1) v += __shfl_xor(v, o);
  return v;
}
DI float erf_as(float x) {
  const float ax = fabsf(x);
  const float t = 1.0f / (1.0f + 0.3275911f * ax);
  const float poly = t * (0.254829592f + t * (-0.284496736f + t * (1.421413741f + t * (-1.453152027f + t * 1.061405429f))));
  const float r = 1.0f - poly * __expf(-ax * ax);
  return x < 0.f ? -r : r;
}
DI float siluf(float x) { return x / (1.0f + __expf(-x)); }
DI void unpack8(const uint4& v, float* f) {
  f[0] = bflo(v.x); f[1] = bfhi(v.x); f[2] = bflo(v.y); f[3] = bfhi(v.y);
  f[4] = bflo(v.z); f[5] = bfhi(v.z); f[6] = bflo(v.w); f[7] = bfhi(v.w);
}
DI uint4 pack8(const float* f) {
  uint4 v; v.x = pack2(f[0], f[1]); v.y = pack2(f[2], f[3]); v.z = pack2(f[4], f[5]); v.w = pack2(f[6], f[7]); return v;
}
DI bf16x8 pack_acc2(const f32x4& a, const f32x4& b) {
  uint4 v; v.x = pack2(a[0], a[1]); v.y = pack2(a[2], a[3]); v.z = pack2(b[0], b[1]); v.w = pack2(b[2], b[3]);
  return __builtin_bit_cast(bf16x8, v);
}
DI bf16x8 read2x4(const u16* p, int c0, int c1) {
  uint2 lo = *(const uint2*)(p + c0);
  uint2 hi = *(const uint2*)(p + c1);
  uint4 v; v.x = lo.x; v.y = lo.y; v.z = hi.x; v.w = hi.y;
  return __builtin_bit_cast(bf16x8, v);
}
DI u32 enc_fp8x4(float a, float b, float c, float d) {
  int v = 0;
  v = __builtin_amdgcn_cvt_pk_fp8_f32(a, b, v, false);
  v = __builtin_amdgcn_cvt_pk_fp8_f32(c, d, v, true);
  return (u32)v;
}
DI void dec_fp8x16(const uint4& v, float* f) {
  f32x2 t;
  t = __builtin_amdgcn_cvt_pk_f32_fp8((int)v.x, false); f[0] = t[0]; f[1] = t[1];
  t = __builtin_amdgcn_cvt_pk_f32_fp8((int)v.x, true);  f[2] = t[0]; f[3] = t[1];
  t = __builtin_amdgcn_cvt_pk_f32_fp8((int)v.y, false); f[4] = t[0]; f[5] = t[1];
  t = __builtin_amdgcn_cvt_pk_f32_fp8((int)v.y, true);  f[6] = t[0]; f[7] = t[1];
  t = __builtin_amdgcn_cvt_pk_f32_fp8((int)v.z, false); f[8] = t[0]; f[9] = t[1];
  t = __builtin_amdgcn_cvt_pk_f32_fp8((int)v.z, true);  f[10] = t[0]; f[11] = t[1];
  t = __builtin_amdgcn_cvt_pk_f32_fp8((int)v.w, false); f[12] = t[0]; f[13] = t[1];
  t = __builtin_amdgcn_cvt_pk_f32_fp8((int)v.w, true);  f[14] = t[0]; f[15] = t[1];
}
DI u32 orderable(float f) { u32 u = __float_as_uint(f); return u ^ ((u >> 31) ? 0xffffffffu : 0x80000000u); }
#define INS16(v, xx) { u32 _x = (xx); _Pragma("unroll") for (int _i = 0; _i < 16; ++_i) { u32 _h = max(v[_i], _x); _x = min(v[_i], _x); v[_i] = _h; } }

DI void ln_row16(float* v, const float* __restrict__ g, const float* __restrict__ b, int lane) {
  float s = 0.f;
#pragma unroll
  for (int i = 0; i < 16; ++i) s += v[i];
  float mu = wsum(s) * (1.0f / 1024.0f);
  float q = 0.f;
#pragma unroll
  for (int i = 0; i < 16; ++i) { float d = v[i] - mu; q += d * d; }
  float var = wsum(q) * (1.0f / 1024.0f);
  float rs = rsqrtf(var + LN_EPS);
#pragma unroll
  for (int i4 = 0; i4 < 4; ++i4) {
    float4 gg = *(const float4*)(g + lane * 16 + i4 * 4);
    float4 bb = *(const float4*)(b + lane * 16 + i4 * 4);
    v[i4 * 4 + 0] = (v[i4 * 4 + 0] - mu) * rs * gg.x + bb.x;
    v[i4 * 4 + 1] = (v[i4 * 4 + 1] - mu) * rs * gg.y + bb.y;
    v[i4 * 4 + 2] = (v[i4 * 4 + 2] - mu) * rs * gg.z + bb.z;
    v[i4 * 4 + 3] = (v[i4 * 4 + 3] - mu) * rs * gg.w + bb.w;
  }
}
DI void store_row16_bf16(u16* dst, const float* v, int lane) {
  *(uint4*)(dst + lane * 16) = pack8(v);
  *(uint4*)(dst + lane * 16 + 8) = pack8(v + 8);
}

DI void transpose_convert(const float* __restrict__ W, int K, int N, int Npad, u16* __restrict__ Wt, char* smem) {
  float* tile = (float*)smem;
  const int tid = opq(threadIdx.x);
  const int ntn = Npad / 64, ntk = K / 64;
  for (int t = blockIdx.x; t < ntn * ntk; t += gridDim.x) {
    const int n0 = (t % ntn) * 64, k0 = (t / ntn) * 64;
#pragma unroll 4
    for (int i = 0; i < 16; ++i) {
      int idx = tid + i * 256; int kk = idx >> 6, nn = idx & 63;
      float val = (n0 + nn < N) ? W[(size_t)(k0 + kk) * N + n0 + nn] : 0.f;
      tile[kk * 65 + nn] = val;
    }
    __syncthreads();
#pragma unroll 4
    for (int i = 0; i < 16; ++i) {
      int idx = tid + i * 256; int nn = idx >> 6, kk = idx & 63;
      Wt[(size_t)(n0 + nn) * K + k0 + kk] = f2bf(tile[kk * 65 + nn]);
    }
    __syncthreads();
  }
}

DI void phase_prologue(const Params& p, char* smem) {
  char* const WS = opqp(p.ws);
  const int tid = opq(threadIdx.x), lane = tid & 63, w = tid >> 6;
  u16* HB = (u16*)(WS + OFF_HB);
  for (int r = blockIdx.x * 4 + w; r < MR; r += gridDim.x * 4) {
    const int b = r / LP, pp = r % LP;
    float v[16];
    if (pp < PADR) {
#pragma unroll
      for (int i = 0; i < 16; ++i) v[i] = 0.f;
    } else {
      const float* src = (pp < 64) ? (p.meta + (size_t)(pp - PADR) * DM) : (p.x + ((size_t)b * SEQ + (pp - 64)) * DM);
#pragma unroll
      for (int i4 = 0; i4 < 4; ++i4) {
        float4 t = *(const float4*)(src + lane * 16 + i4 * 4);
        v[i4 * 4] = t.x; v[i4 * 4 + 1] = t.y; v[i4 * 4 + 2] = t.z; v[i4 * 4 + 3] = t.w;
      }
      ln_row16(v, p.ln_in_g, p.ln_in_b, lane);
    }
    store_row16_bf16(HB + (size_t)r * DM, v, lane);
  }
  for (int l = 0; l < 2; ++l) {
    transpose_convert(p.w_in + (size_t)l * 1024 * NPROJ, 1024, NPROJ, NPROJP, (u16*)(WS + OFF_WIN + l * SZ_WIN1), smem);
    transpose_convert(p.w_out + (size_t)l * 1024 * 1024, 1024, 1024, 1024, (u16*)(WS + OFF_WOUT + l * SZ_WOUT1), smem);
    transpose_convert(p.w_q + (size_t)l * 1024 * 2048, 1024, 2048, 2048, (u16*)(WS + OFF_WQ + l * SZ_WQ1), smem);
  }
  u16* SK = (u16*)(WS + OFF_SK);
  for (int i = blockIdx.x * 256 + tid; i < 2 * 2 * 16384; i += gridDim.x * 256) {
    int l = i >> 15, rem = i & 32767, hf = rem >> 14, e = rem & 16383;
    const float* src = (hf ? p.k2 : p.k1) + (size_t)l * 16384;
    SK[i] = f2bf(src[e]);
  }
}

DI void convert_tables(const Params& p, int l) {
  char* const WS = opqp(p.ws);
  u32* TAB = (u32*)(WS + OFF_TAB);
  const size_t n16 = (size_t)2 * 16384 * 1024 / 16;
  for (size_t i = (size_t)(opqs(blockIdx.x) * 256 + opq(threadIdx.x)); i < n16; i += (size_t)gridDim.x * 256) {
    const size_t e0 = i * 16;
    const int which = (int)(e0 >> 24);
    const size_t off = e0 & (((size_t)1 << 24) - 1);
    const float* src = (which ? p.pv : p.pu) + (size_t)l * 16384 * 1024 + off;
    uint4 o;
    float4 a = *(const float4*)(src), b = *(const float4*)(src + 4), c = *(const float4*)(src + 8), d = *(const float4*)(src + 12);
    o.x = enc_fp8x4(a.x * TSCALE, a.y * TSCALE, a.z * TSCALE, a.w * TSCALE);
    o.y = enc_fp8x4(b.x * TSCALE, b.y * TSCALE, b.z * TSCALE, b.w * TSCALE);
    o.z = enc_fp8x4(c.x * TSCALE, c.y * TSCALE, c.z * TSCALE, c.w * TSCALE);
    o.w = enc_fp8x4(d.x * TSCALE, d.y * TSCALE, d.z * TSCALE, d.w * TSCALE);
    *(uint4*)(TAB + i * 4) = o;
  }
}

template <int EPI>
DI void gemm_phase(const Params& p, size_t offA, size_t offB, int ntn, char* smem) {
  char* const WS = opqp(p.ws);
  const u16* __restrict__ A = (const u16*)(WS + offA);
  const u16* __restrict__ Bt = (const u16*)(WS + offB);
  constexpr int K = 1024, LDS_ST = 72;
  u16* As = (u16*)smem;
  u16* Bs = As + 2 * 128 * LDS_ST;
  const int tid = opq(threadIdx.x), lane = tid & 63, w = tid >> 6, wm = w >> 1, wn = w & 1;
  const int l15 = lane & 15, q = lane >> 4;
  const int ntm = MR / 128;
  for (int tile = blockIdx.x; tile < ntm * ntn; tile += gridDim.x) {
    const int tm = tile / ntn, tn = tile % ntn;
    const u16* Ag = A + (size_t)(tm * 128) * K;
    const u16* Bg = Bt + (size_t)(tn * 128) * K;
    f32x4 acc[4][4];
#pragma unroll
    for (int i = 0; i < 4; ++i)
#pragma unroll
      for (int j = 0; j < 4; ++j) acc[i][j] = (f32x4){0.f, 0.f, 0.f, 0.f};
    uint4 ra[4], rb[4];
#pragma unroll
    for (int i = 0; i < 4; ++i) {
      int idx = tid + i * 256; int row = idx >> 3, c = idx & 7;
      ra[i] = *(const uint4*)(Ag + (size_t)row * K + c * 8);
      rb[i] = *(const uint4*)(Bg + (size_t)row * K + c * 8);
    }
#pragma unroll
    for (int i = 0; i < 4; ++i) {
      int idx = tid + i * 256; int row = idx >> 3, c = idx & 7;
      *(uint4*)(As + row * LDS_ST + c * 8) = ra[i];
      *(uint4*)(Bs + row * LDS_ST + c * 8) = rb[i];
    }
    __syncthreads();
    constexpr int nk = K / 64;
    for (int kt = 0; kt < nk; ++kt) {
      const int cur = kt & 1;
      if (kt + 1 < nk) {
        const int k0 = (kt + 1) * 64;
#pragma unroll
        for (int i = 0; i < 4; ++i) {
          int idx = tid + i * 256; int row = idx >> 3, c = idx & 7;
          ra[i] = *(const uint4*)(Ag + (size_t)row * K + k0 + c * 8);
          rb[i] = *(const uint4*)(Bg + (size_t)row * K + k0 + c * 8);
        }
      }
      const u16* Ac = As + cur * 128 * LDS_ST;
      const u16* Bc = Bs + cur * 128 * LDS_ST;
#pragma unroll
      for (int kk = 0; kk < 2; ++kk) {
        bf16x8 af[4], bfr[4];
#pragma unroll
        for (int mt = 0; mt < 4; ++mt) af[mt] = *(const bf16x8*)(Ac + (wm * 64 + mt * 16 + l15) * LDS_ST + kk * 32 + q * 8);
#pragma unroll
        for (int nt = 0; nt < 4; ++nt) bfr[nt] = *(const bf16x8*)(Bc + (wn * 64 + nt * 16 + l15) * LDS_ST + kk * 32 + q * 8);
#pragma unroll
        for (int mt = 0; mt < 4; ++mt)
#pragma unroll
          for (int nt = 0; nt < 4; ++nt) acc[mt][nt] = MFMA16(bfr[nt], af[mt], acc[mt][nt]);
      }
      if (kt + 1 < nk) {
        u16* An = As + (cur ^ 1) * 128 * LDS_ST;
        u16* Bn = Bs + (cur ^ 1) * 128 * LDS_ST;
#pragma unroll
        for (int i = 0; i < 4; ++i) {
          int idx = tid + i * 256; int row = idx >> 3, c = idx & 7;
          *(uint4*)(An + row * LDS_ST + c * 8) = ra[i];
          *(uint4*)(Bn + row * LDS_ST + c * 8) = rb[i];
        }
      }
      __syncthreads();
    }
#pragma unroll
    for (int mt = 0; mt < 4; ++mt) {
      const size_t m = (size_t)tm * 128 + wm * 64 + mt * 16 + l15;
#pragma unroll
      for (int nt = 0; nt < 4; ++nt) {
        const int n = tn * 128 + wn * 64 + nt * 16 + q * 4;
        const f32x4 a = acc[mt][nt];
        if (EPI == 1) {
          if (tn < 24) {
            uint2 o; o.x = pack2(a[0], a[1]); o.y = pack2(a[2], a[3]);
            *(uint2*)((u16*)(WS + OFF_R1) + m * 3072 + n) = o;
          } else if (tn < 28) {
            uint2 o; o.x = pack2(a[0], a[1]); o.y = pack2(a[2], a[3]);
            *(uint2*)((u16*)(WS + OFF_ZB) + m * 512 + (n - 3072)) = o;
          } else {
            if (n - 3584 < 8) *(float4*)((float*)(WS + OFF_AB) + m * 8 + (n - 3584)) = make_float4(a[0], a[1], a[2], a[3]);
          }
        } else if (EPI == 2) {
          *(float4*)((float*)(WS + OFF_R1) + m * 1024 + n) = make_float4(a[0], a[1], a[2], a[3]);
        } else {
          uint2 o; o.x = pack2(a[0], a[1]); o.y = pack2(a[2], a[3]);
          *(uint2*)((u16*)(WS + OFF_R1) + m * 2048 + n) = o;
        }
      }
    }
  }
}

DI void phase_p2(const Params& p, int l) {
  char* const WS = opqp(p.ws);
  const int tid = opq(threadIdx.x), lane = tid & 63, w = tid >> 6;
  const u16* R1 = (const u16*)(WS + OFF_R1);
  u16* QKV = (u16*)(WS + OFF_QKV);
  u16* YB = (u16*)(WS + OFF_YB);
  const float* AB = (const float*)(WS + OFF_AB);
  float* GB = (float*)(WS + OFF_GB);
  const float* cw = p.conv_w + (size_t)l * 3 * 512;
  const float* gw = p.gdn_conv_w + (size_t)l * 4 * 1536;
  for (int r = blockIdx.x * 4 + w; r < MR; r += gridDim.x * 4) {
    const int pp = r % LP;
    if (pp < PADR) {
      const uint4 z4 = make_uint4(0, 0, 0, 0);
#pragma unroll
      for (int i = 0; i < 3; ++i) *(uint4*)(QKV + (size_t)r * 1536 + i * 512 + lane * 8) = z4;
      *(uint4*)(YB + (size_t)r * 1024 + lane * 8) = z4;
      *(uint4*)(YB + (size_t)r * 1024 + 512 + lane * 8) = z4;
      if (lane < 8) GB[(size_t)r * 8 + lane] = 0.f;
      continue;
    }
    const int c0 = lane * 8;
    {
      float cb[8], acc[8];
      unpack8(*(const uint4*)(R1 + (size_t)r * 3072 + c0), cb);
#pragma unroll
      for (int i = 0; i < 8; ++i) acc[i] = 0.f;
#pragma unroll
      for (int j = 0; j < 3; ++j) {
        const size_t rr = (size_t)(r - 2 + j);
        float cc[8], ch[8];
        unpack8(*(const uint4*)(R1 + rr * 3072 + 512 + c0), cc);
        unpack8(*(const uint4*)(R1 + rr * 3072 + 1024 + c0), ch);
        float4 w0 = *(const float4*)(cw + j * 512 + c0), w1 = *(const float4*)(cw + j * 512 + c0 + 4);
        const float ww[8] = {w0.x, w0.y, w0.z, w0.w, w1.x, w1.y, w1.z, w1.w};
#pragma unroll
        for (int i = 0; i < 8; ++i) acc[i] += ww[i] * (cc[i] * ch[i]);
      }
#pragma unroll
      for (int i = 0; i < 8; ++i) acc[i] *= cb[i];
      *(uint4*)(YB + (size_t)r * 1024 + c0) = pack8(acc);
    }
#pragma unroll
    for (int part = 0; part < 3; ++part) {
      const int c = part * 512 + c0;
      float acc[8];
#pragma unroll
      for (int i = 0; i < 8; ++i) acc[i] = 0.f;
#pragma unroll
      for (int j = 0; j < 4; ++j) {
        const size_t rr = (size_t)(r - 3 + j);
        float xv[8];
        unpack8(*(const uint4*)(R1 + rr * 3072 + 1536 + c), xv);
        float4 w0 = *(const float4*)(gw + j * 1536 + c), w1 = *(const float4*)(gw + j * 1536 + c + 4);
        const float ww[8] = {w0.x, w0.y, w0.z, w0.w, w1.x, w1.y, w1.z, w1.w};
#pragma unroll
        for (int i = 0; i < 8; ++i) acc[i] += ww[i] * xv[i];
      }
      float ss = 0.f;
#pragma unroll
      for (int i = 0; i < 8; ++i) { acc[i] = siluf(acc[i]); ss += acc[i] * acc[i]; }
      if (part < 2) {
        ss += __shfl_xor(ss, 1); ss += __shfl_xor(ss, 2); ss += __shfl_xor(ss, 4); ss += __shfl_xor(ss, 8);
        float sc = rsqrtf(ss + RMS_EPS);
        if (part == 0) sc *= 0.08838834764831845f;
#pragma unroll
        for (int i = 0; i < 8; ++i) acc[i] *= sc;
      }
      *(uint4*)(QKV + (size_t)r * 1536 + c) = pack8(acc);
    }
    if (lane < 4) {
      const float a = AB[(size_t)r * 8 + lane], bb = AB[(size_t)r * 8 + 4 + lane];
      const float xx = a + p.dt_bias[l * 4 + lane];
      const float tt = __expf(-fabsf(xx));
      const float l1p = (tt < 0.01f) ? tt * (1.0f - tt * (0.5f - tt * 0.33333333f)) : __logf(1.0f + tt);
      const float sp = fmaxf(xx, 0.f) + l1p;
      GB[(size_t)r * 8 + lane] = -__expf(p.a_log[l * 4 + lane]) * sp;
      GB[(size_t)r * 8 + 4 + lane] = 1.0f / (1.0f + __expf(-bb));
    }
  }
}

DI void phase_p3(const Params& p, char* smem) {
  char* const WS = opqp(p.ws);
  constexpr int ST = 136, AST = 68;
  u16* kb = (u16*)smem;
  u16* qb = kb + 64 * ST;
  u16* kbb = qb + 64 * ST;
  float* As = (float*)(kbb + 64 * ST);
  float* s_gc = As + 64 * AST;
  float* s_bt = s_gc + 64;
  const int tid = opq(threadIdx.x), lane = tid & 63, w = tid >> 6, l15 = lane & 15, q = lane >> 4;
  const u16* QKV = (const u16*)(WS + OFF_QKV);
  const float* GB = (const float*)(WS + OFF_GB);
  for (int task = blockIdx.x; task < NB * NCH * 4; task += gridDim.x) {
    const int h = task & 3, bn = task >> 2, b = bn / NCH, n = bn % NCH;
    const size_t row0 = (size_t)b * LP + (size_t)n * 64;
    char* rec = WS + OFF_R1 + (size_t)task * REC_BYTES;
    u16* rec_u = (u16*)rec; u16* rec_w = rec_u + 8192; u16* rec_kT = rec_w + 8192; u16* rec_at = rec_kT + 8192;
    float* rec_eg = (float*)(rec + 57344); float* rec_egl = rec_eg + 64; float* rec_gl = rec_egl + 64;
    const int npad = (n == 0) ? PADR : 0;
    if (tid < 64) {
      const bool pad = tid < npad;
      float g = pad ? 0.f : GB[(row0 + tid) * 8 + h];
      float bt = pad ? 0.f : GB[(row0 + tid) * 8 + 4 + h];
#pragma unroll
      for (int o = 1; o < 64; o <<= 1) { float t = __shfl_up(g, o); if (lane >= o) g += t; }
      s_gc[tid] = g; s_bt[tid] = bt;
      const float gl = __shfl(g, 63);
      rec_eg[tid] = __expf(g);
      rec_egl[tid] = __expf(gl - g);
      if (tid == 0) rec_gl[0] = __expf(gl);
    }
    __syncthreads();
#pragma unroll
    for (int i = 0; i < 4; ++i) {
      int idx = tid + i * 256; int row = idx >> 4, c = idx & 15;
      uint4 kv = make_uint4(0, 0, 0, 0), qv = make_uint4(0, 0, 0, 0);
      if (row >= npad) {
        kv = *(const uint4*)(QKV + (row0 + row) * 1536 + 512 + h * 128 + c * 8);
        qv = *(const uint4*)(QKV + (row0 + row) * 1536 + h * 128 + c * 8);
      }
      *(uint4*)(kb + row * ST + c * 8) = kv;
      *(uint4*)(qb + row * ST + c * 8) = qv;
      float kf[8]; unpack8(kv, kf);
      const float bt = s_bt[row];
#pragma unroll
      for (int j = 0; j < 8; ++j) kf[j] *= bt;
      *(uint4*)(kbb + row * ST + c * 8) = pack8(kf);
    }
    __syncthreads();
#pragma unroll
    for (int it = 0; it < 4; ++it) {
      int idx = tid + it * 256; int d = idx >> 3, i8 = idx & 7;
      u32 t[4];
#pragma unroll
      for (int jj = 0; jj < 4; ++jj) t[jj] = (u32)kb[(i8 * 8 + 2 * jj) * ST + d] | ((u32)kb[(i8 * 8 + 2 * jj + 1) * ST + d] << 16);
      *(uint4*)(rec_kT + d * 64 + i8 * 8) = make_uint4(t[0], t[1], t[2], t[3]);
    }
    {
      const int mat = w >> 1;
      const u16* src = mat ? qb : kbb;
      f32x4 acc[2][4];
#pragma unroll
      for (int i = 0; i < 2; ++i)
#pragma unroll
        for (int j = 0; j < 4; ++j) acc[i][j] = (f32x4){0.f, 0.f, 0.f, 0.f};
#pragma unroll
      for (int ks = 0; ks < 4; ++ks) {
        bf16x8 a[2], bb[4];
#pragma unroll
        for (int mi = 0; mi < 2; ++mi) a[mi] = *(const bf16x8*)(src + (((w & 1) * 2 + mi) * 16 + l15) * ST + ks * 32 + q * 8);
#pragma unroll
        for (int nt = 0; nt < 4; ++nt) bb[nt] = *(const bf16x8*)(kb + (nt * 16 + l15) * ST + ks * 32 + q * 8);
#pragma unroll
        for (int mi = 0; mi < 2; ++mi)
#pragma unroll
          for (int nt = 0; nt < 4; ++nt) acc[mi][nt] = MFMA16(a[mi], bb[nt], acc[mi][nt]);
      }
#pragma unroll
      for (int mi = 0; mi < 2; ++mi)
#pragma unroll
        for (int nt = 0; nt < 4; ++nt)
#pragma unroll
          for (int r = 0; r < 4; ++r) {
            const int i = ((w & 1) * 2 + mi) * 16 + q * 4 + r, j = nt * 16 + l15;
            const float dec = __expf(s_gc[i] - s_gc[j]);
            if (mat == 0) As[i * AST + j] = (i > j) ? acc[mi][nt][r] * dec : 0.f;
            else rec_at[i * 64 + j] = f2bf((i >= j) ? acc[mi][nt][r] * dec : 0.f);
          }
    }
    __syncthreads();
    {
      const int mat = tid >> 7, c = tid & 127;
      float x[64];
      if (mat == 0) {
#pragma unroll
        for (int i = 0; i < 64; ++i) {
          const float vv = (i >= npad) ? bf2f(QKV[(row0 + i) * 1536 + 1024 + h * 128 + c]) : 0.f;
          x[i] = vv * s_bt[i];
        }
      } else {
#pragma unroll
        for (int i = 0; i < 64; ++i) x[i] = bf2f(kb[i * ST + c]) * s_bt[i] * __expf(s_gc[i]);
      }
#pragma unroll
      for (int i = 1; i < 64; ++i) {
        float s = x[i];
#pragma unroll
        for (int j4 = 0; j4 < (i + 3) / 4; ++j4) {
          const float4 a = *(const float4*)(As + i * AST + j4 * 4);
          s -= a.x * x[j4 * 4 + 0];
          if (j4 * 4 + 1 < i) s -= a.y * x[j4 * 4 + 1];
          if (j4 * 4 + 2 < i) s -= a.z * x[j4 * 4 + 2];
          if (j4 * 4 + 3 < i) s -= a.w * x[j4 * 4 + 3];
        }
        x[i] = s;
        if ((i & 3) == 3) SCHED_FENCE;
      }
      if (mat) {
#pragma unroll
        for (int i = 0; i < 64; ++i) rec_w[i * 128 + c] = f2bf(x[i]);
      } else {
        const int ug = c >> 4, ul = c & 15;
#pragma unroll
        for (int mt = 0; mt < 4; ++mt)
#pragma unroll
          for (int qq = 0; qq < 4; ++qq) {
            const int i0 = mt * 16 + qq * 4;
            uint2 o; o.x = pack2(x[i0], x[i0 + 1]); o.y = pack2(x[i0 + 2], x[i0 + 3]);
            *(uint2*)(rec_u + ((ug * 64 + qq * 16 + ul) * 16 + mt * 4)) = o;
          }
      }
    }
    __syncthreads();
  }
}

DI void phase_scan(const Params& p, int l, char* smem) {
  char* const WS = opqp(p.ws);
  if (blockIdx.x >= 32) return;
  constexpr int ST = 136, ST2 = 72;
  u16* ws_ = (u16*)smem;
  u16* qs_ = ws_ + 64 * ST;
  u16* kts = qs_ + 64 * ST;
  u16* ats = kts + 128 * ST2;
  float* scl = (float*)(ats + 64 * ST2);
  const int tid = opq(threadIdx.x), lane = tid & 63, w = tid >> 6, l15 = lane & 15, q = lane >> 4;
  const int b = blockIdx.x >> 3, h = (blockIdx.x >> 1) & 3, half = blockIdx.x & 1;
  const u16* QKV = (const u16*)(WS + OFF_QKV);
  u16* YB = (u16*)(WS + OFF_YB);
  const int uoff = ((half * 4 + w) * 64 + lane) * 16;
  f32x4 S[8];
#pragma unroll
  for (int i = 0; i < 8; ++i) S[i] = (f32x4){0.f, 0.f, 0.f, 0.f};
  uint4 uc0, uc1;
  {
    const int task = ((b * NCH) << 2) + h;
    const size_t row0 = (size_t)b * LP;
    const char* rec = WS + OFF_R1 + (size_t)task * REC_BYTES;
    const u16* rec_u = (const u16*)rec; const u16* rec_w = rec_u + 8192; const u16* rec_kT = rec_w + 8192; const u16* rec_at = rec_kT + 8192;
    const float* rec_eg = (const float*)(rec + 57344);
#pragma unroll
    for (int i = 0; i < 4; ++i) {
      int idx = tid + i * 256; int row = idx >> 4, c = idx & 15;
      *(uint4*)(ws_ + row * ST + c * 8) = *(const uint4*)(rec_w + row * 128 + c * 8);
      *(uint4*)(qs_ + row * ST + c * 8) = *(const uint4*)(QKV + (row0 + row) * 1536 + h * 128 + c * 8);
      int rk = idx >> 3, ck = idx & 7;
      *(uint4*)(kts + rk * ST2 + ck * 8) = *(const uint4*)(rec_kT + rk * 64 + ck * 8);
    }
#pragma unroll
    for (int i = 0; i < 2; ++i) { int idx = tid + i * 256; int row = idx >> 3, c = idx & 7; *(uint4*)(ats + row * ST2 + c * 8) = *(const uint4*)(rec_at + row * 64 + c * 8); }
    if (tid < 129) scl[tid] = rec_eg[tid];
    uc0 = *(const uint4*)(rec_u + uoff); uc1 = *(const uint4*)(rec_u + uoff + 8);
  }
  __syncthreads();
  for (int n = 0; n < NCH; ++n) {
    const int cur = n & 1;
    const bool has_next = (n + 1 < NCH);
    const size_t row0 = (size_t)b * LP + (size_t)n * 64;
    const int taskn = ((b * NCH + (has_next ? n + 1 : n)) << 2) + h;
    const char* recn = WS + OFF_R1 + (size_t)taskn * REC_BYTES;
    const u16* recn_u = (const u16*)recn; const u16* recn_w = recn_u + 8192; const u16* recn_kT = recn_w + 8192; const u16* recn_at = recn_kT + 8192;
    const float* recn_eg = (const float*)(recn + 57344);
    const size_t row0n = has_next ? row0 + 64 : row0;
    const float* egs = scl + cur * 132;
    const float* egls = egs + 64;
    uint4 ra0, ra1, ra2, ra3, ra4, ra5, ra6, ra7;
    {
      const int tl = opq(threadIdx.x);
#define LD_A(i, RW, RQ) { const int idx = tl + (i) * 256; const int row = idx >> 4, c = idx & 15; \
        RW = *(const uint4*)(recn_w + row * 128 + c * 8); RQ = *(const uint4*)(QKV + (row0n + row) * 1536 + h * 128 + c * 8); }
      LD_A(0, ra0, ra4) LD_A(1, ra1, ra5) LD_A(2, ra2, ra6) LD_A(3, ra3, ra7)
    }
    f32x4 P[4], O[4];
#pragma unroll
    for (int i = 0; i < 4; ++i) { P[i] = O[i] = (f32x4){0.f, 0.f, 0.f, 0.f}; }
#pragma unroll
    for (int ks = 0; ks < 4; ++ks) {
      const bf16x8 sb0 = pack_acc2(S[2 * ks], S[2 * ks + 1]);
#pragma unroll
      for (int mt = 0; mt < 4; ++mt) {
        const bf16x8 aw = read2x4(ws_ + (mt * 16 + l15) * ST, ks * 32 + 4 * q, ks * 32 + 16 + 4 * q);
        const bf16x8 aq = read2x4(qs_ + (mt * 16 + l15) * ST, ks * 32 + 4 * q, ks * 32 + 16 + 4 * q);
        P[mt] = MFMA16(aw, sb0, P[mt]);
        O[mt] = MFMA16(aq, sb0, O[mt]);
      }
    }
    {
      const u32 uw_[8] = {uc0.x, uc0.y, uc0.z, uc0.w, uc1.x, uc1.y, uc1.z, uc1.w};
#pragma unroll
      for (int mt = 0; mt < 4; ++mt)
#pragma unroll
        for (int r = 0; r < 4; ++r) {
          const int i = mt * 16 + 4 * q + r;
          const int ui = mt * 4 + r;
          const float uv = (ui & 1) ? bfhi(uw_[ui >> 1]) : bflo(uw_[ui >> 1]);
          P[mt][r] = uv - P[mt][r];
          O[mt][r] *= egs[i];
        }
    }
    SCHED_FENCE;
    __syncthreads();
    uint4 rb0, rb1, rb2, rb3, rb4, rb5, un0, un1;
    float e_next = 0.f;
    {
      const int tl = opq(threadIdx.x);
#define ST_A(i, RW, RQ) { const int idx = tl + (i) * 256; const int row = idx >> 4, c = idx & 15; \
        *(uint4*)(ws_ + row * ST + c * 8) = RW; *(uint4*)(qs_ + row * ST + c * 8) = RQ; }
      ST_A(0, ra0, ra4) ST_A(1, ra1, ra5) ST_A(2, ra2, ra6) ST_A(3, ra3, ra7)
#define LD_K(i, R) { const int idx = tl + (i) * 256; const int rk = idx >> 3, ck = idx & 7; R = *(const uint4*)(recn_kT + rk * 64 + ck * 8); }
      LD_K(0, rb0) LD_K(1, rb1) LD_K(2, rb2) LD_K(3, rb3)
#define LD_T(i, R) { const int idx = tl + (i) * 256; const int row = idx >> 3, c = idx & 7; R = *(const uint4*)(recn_at + row * 64 + c * 8); }
      LD_T(0, rb4) LD_T(1, rb5)
      un0 = *(const uint4*)(recn_u + uoff);
      un1 = *(const uint4*)(recn_u + uoff + 8);
      if (tl < 129) e_next = recn_eg[tl];
    }
    {
      bf16x8 vb[2];
#pragma unroll
      for (int k2 = 0; k2 < 2; ++k2) vb[k2] = pack_acc2(P[2 * k2], P[2 * k2 + 1]);
#pragma unroll
      for (int k2 = 0; k2 < 2; ++k2)
#pragma unroll
        for (int mt = 0; mt < 4; ++mt) {
          const bf16x8 aa = read2x4(ats + (mt * 16 + l15) * ST2, k2 * 32 + 4 * q, k2 * 32 + 16 + 4 * q);
          O[mt] = MFMA16(aa, vb[k2], O[mt]);
        }
    }
    {
      const int npad = (n == 0) ? PADR : 0;
      u16* yp = YB + (row0 + 4 * q) * 1024 + 512 + h * 128 + half * 64 + w * 16 + l15;
#pragma unroll
      for (int mt = 0; mt < 4; ++mt)
#pragma unroll
        for (int r = 0; r < 4; ++r)
          if (mt * 16 + 4 * q + r >= npad) yp[(mt * 16 + r) * 1024] = f2bf(O[mt][r]);
    }
    {
#pragma unroll
      for (int mt = 0; mt < 4; ++mt)
#pragma unroll
        for (int r = 0; r < 4; ++r) P[mt][r] *= egls[mt * 16 + 4 * q + r];
      bf16x8 vb[2];
#pragma unroll
      for (int k2 = 0; k2 < 2; ++k2) vb[k2] = pack_acc2(P[2 * k2], P[2 * k2 + 1]);
      const float egl = egs[128];
#pragma unroll
      for (int dt = 0; dt < 8; ++dt) S[dt] *= egl;
#pragma unroll
      for (int k2 = 0; k2 < 2; ++k2)
#pragma unroll
        for (int dt = 0; dt < 8; ++dt) {
          const bf16x8 ak = read2x4(kts + (dt * 16 + l15) * ST2, k2 * 32 + 4 * q, k2 * 32 + 16 + 4 * q);
          S[dt] = MFMA16(ak, vb[k2], S[dt]);
        }
    }
    SCHED_FENCE;
    __syncthreads();
    {
      const int tl = opq(threadIdx.x);
#define ST_K(i, R) { const int idx = tl + (i) * 256; const int rk = idx >> 3, ck = idx & 7; *(uint4*)(kts + rk * ST2 + ck * 8) = R; }
      ST_K(0, rb0) ST_K(1, rb1) ST_K(2, rb2) ST_K(3, rb3)
#define ST_T(i, R) { const int idx = tl + (i) * 256; const int row = idx >> 3, c = idx & 7; *(uint4*)(ats + row * ST2 + c * 8) = R; }
      ST_T(0, rb4) ST_T(1, rb5)
      if (tl < 129) scl[(cur ^ 1) * 132 + tl] = e_next;
    }
    uc0 = un0; uc1 = un1;
    __syncthreads();
  }
}

DI void phase_p5(const Params& p, int l) {
  char* const WS = opqp(p.ws);
  const int tid = opq(threadIdx.x), lane = tid & 63, w = tid >> 6;
  const u16* ZB = (const u16*)(WS + OFF_ZB);
  u16* YB = (u16*)(WS + OFF_YB);
  const float* nw = p.gdn_norm_w + l * 128;
  const int c0 = (lane & 15) * 8;
  const float4 n0 = *(const float4*)(nw + c0), n1 = *(const float4*)(nw + c0 + 4);
  const float nn[8] = {n0.x, n0.y, n0.z, n0.w, n1.x, n1.y, n1.z, n1.w};
  for (int ti = blockIdx.x * 4 + w; ti < NB * (SEQ + NMETA); ti += gridDim.x * 4) {
    const int b = ti / (SEQ + NMETA), pp = PADR + ti % (SEQ + NMETA);
    const size_t r = (size_t)b * LP + pp;
    float ov[8], zf[8], yv[8];
    unpack8(*(const uint4*)(YB + r * 1024 + 512 + lane * 8), ov);
    unpack8(*(const uint4*)(ZB + r * 512 + lane * 8), zf);
    float ss = 0.f;
#pragma unroll
    for (int j = 0; j < 8; ++j) ss += ov[j] * ov[j];
    ss += __shfl_xor(ss, 1); ss += __shfl_xor(ss, 2); ss += __shfl_xor(ss, 4); ss += __shfl_xor(ss, 8);
    const float rs = rsqrtf(ss * (1.0f / 128.0f) + RMS_EPS);
#pragma unroll
    for (int j = 0; j < 8; ++j) yv[j] = ov[j] * rs * nn[j] * siluf(zf[j]);
    *(uint4*)(YB + r * 1024 + 512 + lane * 8) = pack8(yv);
  }
}

DI void phase_ln1(const Params& p, int l) {
  char* const WS = opqp(p.ws);
  const int tid = opq(threadIdx.x), lane = tid & 63, w = tid >> 6;
  const u16* HB = (const u16*)(WS + OFF_HB);
  const float* MIX = (const float*)(WS + OFF_R1);
  u16* H1 = (u16*)(WS + OFF_QKV);
  for (int r = blockIdx.x * 4 + w; r < MR; r += gridDim.x * 4) {
    const int pp = r % LP;
    float v[16];
    if (pp < PADR) {
#pragma unroll
      for (int i = 0; i < 16; ++i) v[i] = 0.f;
    } else {
      float hv[16];
      unpack8(*(const uint4*)(HB + (size_t)r * 1024 + lane * 16), hv);
      unpack8(*(const uint4*)(HB + (size_t)r * 1024 + lane * 16 + 8), hv + 8);
#pragma unroll
      for (int i4 = 0; i4 < 4; ++i4) {
        float4 t = *(const float4*)(MIX + (size_t)r * 1024 + lane * 16 + i4 * 4);
        v[i4 * 4] = ALPHA * hv[i4 * 4] + t.x; v[i4 * 4 + 1] = ALPHA * hv[i4 * 4 + 1] + t.y;
        v[i4 * 4 + 2] = ALPHA * hv[i4 * 4 + 2] + t.z; v[i4 * 4 + 3] = ALPHA * hv[i4 * 4 + 3] + t.w;
      }
      ln_row16(v, p.ln1_g + l * 1024, p.ln1_b + l * 1024, lane);
    }
    store_row16_bf16(H1 + (size_t)r * 1024, v, lane);
  }
}

DI void phase_p6(const Params& p, int l, char* smem) {
  char* const WS = opqp(p.ws);
  constexpr int KST = 136, SST = 132;
  u16* kh = (u16*)smem;
  u32* lst = (u32*)smem;
  float* sc = (float*)(smem + 128 * KST * 2);
  float* fin_t = sc + 64 * SST;
  unsigned char* fin_i = (unsigned char*)(fin_t + 64 * 32);
  const int tid = opq(threadIdx.x), lane = tid & 63, w = tid >> 6, l15 = lane & 15, q = lane >> 4;
  const u16* QP = (const u16*)(WS + OFF_R1);
  const u16* SK = (const u16*)(WS + OFF_SK) + (size_t)l * 2 * 16384;
  int* IDX = (int*)(WS + OFF_IDX);
  float* GATE = (float*)(WS + OFF_GATE);
  for (int task = blockIdx.x; task < (MR / 64) * 8; task += gridDim.x) {
    const int tt = task >> 3, hd = task & 7;
    const size_t row0 = (size_t)tt * 64;
    for (int hf = 0; hf < 2; ++hf) {
#pragma unroll
      for (int i = 0; i < 8; ++i) {
        int idx = tid + i * 256; int row = idx >> 4, c = idx & 15;
        *(uint4*)(kh + row * KST + c * 8) = *(const uint4*)(SK + hf * 16384 + row * 128 + c * 8);
      }
      __syncthreads();
      {
        f32x4 acc[8];
#pragma unroll
        for (int i = 0; i < 8; ++i) acc[i] = (f32x4){0.f, 0.f, 0.f, 0.f};
        const u16* qrow = QP + (row0 + w * 16 + l15) * 2048 + hd * 256 + hf * 128;
#pragma unroll
        for (int ks = 0; ks < 4; ++ks) {
          const bf16x8 af = *(const bf16x8*)(qrow + ks * 32 + q * 8);
#pragma unroll
          for (int nt = 0; nt < 8; ++nt) {
            const bf16x8 bk = *(const bf16x8*)(kh + (nt * 16 + l15) * KST + ks * 32 + q * 8);
            acc[nt] = MFMA16(af, bk, acc[nt]);
          }
        }
#pragma unroll
        for (int nt = 0; nt < 8; ++nt)
#pragma unroll
          for (int r = 0; r < 4; ++r) sc[(w * 16 + 4 * q + r) * SST + nt * 16 + l15] = acc[nt][r];
      }
      __syncthreads();
      {
        const int tok = tid >> 2, qr = tid & 3;
        u32 v[16];
#pragma unroll
        for (int i = 0; i < 16; ++i) v[i] = 0u;
#pragma unroll 4
        for (int j = 0; j < 32; ++j) {
          const int key = qr + 4 * j;
          const u32 pk = (orderable(sc[tok * SST + key]) & ~127u) | (u32)(127 - key);
          INS16(v, pk);
        }
#pragma unroll
        for (int i = 0; i < 4; ++i) *(uint4*)(lst + (tok * 4 + qr) * 16 + i * 4) = make_uint4(v[i * 4], v[i * 4 + 1], v[i * 4 + 2], v[i * 4 + 3]);
      }
      __syncthreads();
      if (tid < 64) {
        u32 v[16];
#pragma unroll
        for (int i = 0; i < 4; ++i) { uint4 t = *(const uint4*)(lst + (tid * 4) * 16 + i * 4); v[i * 4] = t.x; v[i * 4 + 1] = t.y; v[i * 4 + 2] = t.z; v[i * 4 + 3] = t.w; }
#pragma unroll 4
        for (int j = 16; j < 64; ++j) { const u32 pk = lst[tid * 64 + j]; INS16(v, pk); }
#pragma unroll
        for (int k = 0; k < 16; ++k) {
          const int key = 127 - (int)(v[k] & 127u);
          fin_t[tid * 32 + hf * 16 + k] = sc[tid * SST + key];
          fin_i[tid * 32 + hf * 16 + k] = (unsigned char)key;
        }
      }
      __syncthreads();
    }
    if (tid < 64) {
      float t1[16], t2[16];
#pragma unroll
      for (int k = 0; k < 16; ++k) { t1[k] = fin_t[tid * 32 + k]; t2[k] = fin_t[tid * 32 + 16 + k]; }
      u32 v[16];
#pragma unroll
      for (int i = 0; i < 16; ++i) v[i] = 0u;
#define CAND_ROW(a, nb) { _Pragma("unroll") for (int bq = 0; bq < (nb); ++bq) { const u32 pk = (orderable(t1[a] + t2[bq]) & ~255u) | (u32)(255 - ((a) * 16 + bq)); INS16(v, pk); } }
      CAND_ROW(0, 16) CAND_ROW(1, 8) CAND_ROW(2, 5) CAND_ROW(3, 4) CAND_ROW(4, 3) CAND_ROW(5, 2) CAND_ROW(6, 2) CAND_ROW(7, 2)
      CAND_ROW(8, 1) CAND_ROW(9, 1) CAND_ROW(10, 1) CAND_ROW(11, 1) CAND_ROW(12, 1) CAND_ROW(13, 1) CAND_ROW(14, 1) CAND_ROW(15, 1)
      float sm[16]; int ex[16];
      float mx = -1e30f;
#pragma unroll
      for (int k = 0; k < 16; ++k) {
        const int ci = 255 - (int)(v[k] & 255u);
        const int a = ci >> 4, bq = ci & 15;
        sm[k] = fin_t[tid * 32 + a] + fin_t[tid * 32 + 16 + bq];
        ex[k] = (int)fin_i[tid * 32 + a] * 128 + (int)fin_i[tid * 32 + 16 + bq];
        mx = fmaxf(mx, sm[k]);
      }
      float den = 0.f;
#pragma unroll
      for (int k = 0; k < 16; ++k) { sm[k] = __expf(sm[k] - mx); den += sm[k]; }
      const float inv = 1.0f / den;
      int* io = IDX + (row0 + tid) * 128 + hd * 16;
      float* go = GATE + (row0 + tid) * 128 + hd * 16;
#pragma unroll
      for (int k4 = 0; k4 < 4; ++k4) {
        *(int4*)(io + k4 * 4) = make_int4(ex[k4 * 4], ex[k4 * 4 + 1], ex[k4 * 4 + 2], ex[k4 * 4 + 3]);
        *(float4*)(go + k4 * 4) = make_float4(sm[k4 * 4] * inv, sm[k4 * 4 + 1] * inv, sm[k4 * 4 + 2] * inv, sm[k4 * 4 + 3] * inv);
      }
    }
    __syncthreads();
  }
}

DI void phase_p7(const Params& p, int l) {
  char* const WS = opqp(p.ws);
  const int tid = opq(threadIdx.x), lane = tid & 63, w = tid >> 6;
  const u16* H1 = (const u16*)(WS + OFF_QKV);
  u16* HB = (u16*)(WS + OFF_HB);
  const char* TU = WS + OFF_TAB;
  const char* TV = TU + (size_t)16384 * 1024;
  const int* IDX = (const int*)(WS + OFF_IDX);
  const float* GATE = (const float*)(WS + OFF_GATE);
  const bool last = (l == 1);
  const int per_b = last ? SEQ : (SEQ + NMETA);
  const int ntok = NB * per_b;
  for (int ti = blockIdx.x * 4 + w; ti < ntok; ti += gridDim.x * 4) {
    const int b = ti / per_b, pp = (last ? 64 : PADR) + ti % per_b;
    const size_t r = (size_t)b * LP + pp;
    float x[16];
    unpack8(*(const uint4*)(H1 + r * 1024 + lane * 16), x);
    unpack8(*(const uint4*)(H1 + r * 1024 + lane * 16 + 8), x + 8);
    const int id0 = IDX[r * 128 + lane], id1 = IDX[r * 128 + 64 + lane];
    const float g0 = GATE[r * 128 + lane], g1 = GATE[r * 128 + 64 + lane];
    float d0 = 0.f, d1 = 0.f;
    for (int eb = 0; eb < 128; eb += 8) {
      uint4 ud[8];
#pragma unroll
      for (int j = 0; j < 8; ++j) {
        const int e = eb + j;
        const int id = __builtin_amdgcn_readlane((eb < 64) ? id0 : id1, e & 63);
        ud[j] = *(const uint4*)(TU + (size_t)id * 1024 + lane * 16);
      }
#pragma unroll
      for (int j = 0; j < 8; ++j) {
        float f[16]; dec_fp8x16(ud[j], f);
        float s = 0.f;
#pragma unroll
        for (int i = 0; i < 16; ++i) s += x[i] * f[i];
        s = wsum(s);
        const int e = eb + j;
        if (lane == (e & 63)) { if (eb < 64) d0 = s; else d1 = s; }
      }
    }
    float c0, c1;
    { const float a = d0 * TINV; c0 = g0 * 0.5f * a * (1.0f + erf_as(a * 0.7071067811865476f)) * TINV; }
    { const float a = d1 * TINV; c1 = g1 * 0.5f * a * (1.0f + erf_as(a * 0.7071067811865476f)) * TINV; }
    float acc[16];
#pragma unroll
    for (int i = 0; i < 16; ++i) acc[i] = 0.f;
    for (int eb = 0; eb < 128; eb += 8) {
      uint4 vd[8];
#pragma unroll
      for (int j = 0; j < 8; ++j) {
        const int e = eb + j;
        const int id = __builtin_amdgcn_readlane((eb < 64) ? id0 : id1, e & 63);
        vd[j] = *(const uint4*)(TV + (size_t)id * 1024 + lane * 16);
      }
#pragma unroll
      for (int j = 0; j < 8; ++j) {
        const int e = eb + j;
        const float cf = __int_as_float(__builtin_amdgcn_readlane(__float_as_int((eb < 64) ? c0 : c1), e & 63));
        float f[16]; dec_fp8x16(vd[j], f);
#pragma unroll
        for (int i = 0; i < 16; ++i) acc[i] += cf * f[i];
      }
    }
#pragma unroll
    for (int i = 0; i < 16; ++i) acc[i] += ALPHA * x[i];
    ln_row16(acc, p.ln2_g + l * 1024, p.ln2_b + l * 1024, lane);
    if (!last) {
      store_row16_bf16(HB + r * 1024, acc, lane);
    } else {
      float* o = p.out + ((size_t)b * SEQ + (pp - 64)) * 1024 + lane * 16;
#pragma unroll
      for (int i4 = 0; i4 < 4; ++i4) *(float4*)(o + i4 * 4) = make_float4(acc[i4 * 4], acc[i4 * 4 + 1], acc[i4 * 4 + 2], acc[i4 * 4 + 3]);
    }
  }
}

#define XB_TMO      128
#define XB_XCNT(j)  (256  + 64 * (j))
#define XB_XSUB(j)  (1280 + 64 * (j))
#define XB_XGEN(j)  (2304 + 64 * (j))
#define XB_TOP      3328
#define XB_TOPGEN   3392
#define XCD_BAR_WORDS 3456
#define XB_SPIN_CAP (1u << 22)
#define LAS __attribute__((address_space(3)))
DI unsigned xb_ld(unsigned* p)              { return __hip_atomic_load(p, __ATOMIC_RELAXED, __HIP_MEMORY_SCOPE_AGENT); }
DI unsigned xb_add(unsigned* p, unsigned v) { return __hip_atomic_fetch_add(p, v, __ATOMIC_RELAXED, __HIP_MEMORY_SCOPE_AGENT); }
DI unsigned xb_xcc_id() { return (unsigned)__builtin_amdgcn_s_getreg((3 << 11) | 20) & 0xFu; }
#define XB_SPIN(cond, bar) do { unsigned _sp = 0; while (cond) { __builtin_amdgcn_s_sleep(1); \
    if ((++_sp & 255u) == 0u) { if (xb_ld(&(bar)[XB_TMO])) break; if (_sp > XB_SPIN_CAP) { atomicAdd(&(bar)[XB_TMO], 1u); break; } } } } while (0)
struct XcdBarrier { unsigned* bar; unsigned x; volatile LAS unsigned* st; };
DI XcdBarrier xcd_barrier_post(unsigned* bar, volatile LAS unsigned* st) {
  XcdBarrier b; b.bar = bar; b.x = xb_xcc_id(); b.st = st;
  if (threadIdx.x == 0) (void)xb_add(&bar[XB_XCNT(b.x)], 1u);
  return b;
}
DI void xcd_barrier_complete(unsigned* bar, unsigned x, unsigned& nloc, unsigned& nx) {
  const unsigned G = gridDim.x * gridDim.y * gridDim.z;
  unsigned sum, cnt, mine, sp = 0u;
  for (;;) {
    sum = 0u; cnt = 0u; mine = 0u;
#pragma unroll
    for (unsigned j = 0; j < 16; ++j) { const unsigned c = xb_ld(&bar[XB_XCNT(j)]); sum += c; cnt += (c > 0u) ? 1u : 0u; mine = (j == x) ? c : mine; }
    if (sum == G) break;
    __builtin_amdgcn_s_sleep(1);
    if ((++sp & 255u) == 0u) { if (xb_ld(&bar[XB_TMO])) break; if (sp > XB_SPIN_CAP) { atomicAdd(&bar[XB_TMO], 1u); break; } }
  }
  nloc = mine > 0u ? mine : 1u; nx = cnt > 0u ? cnt : 1u;
}
DI void xcd_barrier(const XcdBarrier& b) {
  asm volatile("s_waitcnt vmcnt(0)" ::: "memory");
  __syncthreads();
  if (threadIdx.x == 0) {
    unsigned* bar = b.bar;
    __builtin_amdgcn_s_waitcnt(0);
    unsigned nloc = b.st[0], nx = b.st[1];
    if (nloc == 0u) { xcd_barrier_complete(bar, b.x, nloc, nx); b.st[0] = nloc; b.st[1] = nx; }
    const unsigned old = xb_add(&bar[XB_XSUB(b.x)], 1u);
    const unsigned gen = old / nloc;
    if (old + 1u == (gen + 1u) * nloc) {
      __builtin_amdgcn_fence(__ATOMIC_RELEASE, "agent");
      asm volatile("s_waitcnt vmcnt(0)" ::: "memory");
      const unsigned og = xb_add(&bar[XB_TOP], 1u);
      const unsigned tg = og / nx;
      if (og + 1u == (tg + 1u) * nx) xb_add(&bar[XB_TOPGEN], 1u);
      else XB_SPIN(xb_ld(&bar[XB_TOPGEN]) == tg, bar);
      __builtin_amdgcn_fence(__ATOMIC_ACQUIRE, "agent");
      xb_add(&bar[XB_XGEN(b.x)], 1u);
      asm volatile("s_waitcnt vmcnt(0)" ::: "memory");
    } else {
      XB_SPIN(xb_ld(&bar[XB_XGEN(b.x)]) == gen, bar);
      __builtin_amdgcn_fence(__ATOMIC_ACQUIRE, "agent");
      asm volatile("s_waitcnt vmcnt(0)" ::: "memory");
    }
  }
  __syncthreads();
}

#ifndef DUP_GEMM
#define DUP_GEMM 0
#endif
#ifndef DUP_P7
#define DUP_P7 0
#endif
#ifndef DUP_SCAN
#define DUP_SCAN 0
#endif
#ifndef DUP_MISC
#define DUP_MISC 0
#endif
template <int l>
DI void layer(const Params& p, char* smem, const XcdBarrier& xb) {
  for (int rep = 0; rep <= DUP_GEMM; ++rep) { gemm_phase<1>(p, OFF_HB, OFF_WIN + l * SZ_WIN1, NPROJP / 128, smem); xcd_barrier(xb); }
  for (int rep = 0; rep <= DUP_MISC; ++rep) { phase_p2(p, l); xcd_barrier(xb); }
  for (int rep = 0; rep <= DUP_MISC; ++rep) { phase_p3(p, smem); xcd_barrier(xb); }
  for (int rep = 0; rep <= DUP_SCAN; ++rep) { phase_scan(p, l, smem); xcd_barrier(xb); }
  phase_p5(p, l); xcd_barrier(xb);
  for (int rep = 0; rep <= DUP_GEMM; ++rep) { gemm_phase<2>(p, OFF_YB, OFF_WOUT + l * SZ_WOUT1, 8, smem); xcd_barrier(xb); }
  for (int rep = 0; rep <= DUP_MISC; ++rep) { phase_ln1(p, l); xcd_barrier(xb); }
  convert_tables(p, l);
  for (int rep = 0; rep <= DUP_GEMM; ++rep) { gemm_phase<3>(p, OFF_QKV, OFF_WQ + l * SZ_WQ1, 16, smem); xcd_barrier(xb); }
  for (int rep = 0; rep <= DUP_MISC; ++rep) { phase_p6(p, l, smem); xcd_barrier(xb); }
  for (int rep = 0; rep <= DUP_P7; ++rep) { phase_p7(p, l); if (rep < DUP_P7) xcd_barrier(xb); }
}
__global__ void __launch_bounds__(256, 2) fwd_megakernel(Params p) {
  __shared__ __attribute__((aligned(16))) char smem[81920];
  cg::grid_group grid = cg::this_grid();
  if (threadIdx.x == 0) *(uint4*)(smem + 81904) = make_uint4(0u, 0u, 0u, 0u);
  __syncthreads();
  const XcdBarrier xb = xcd_barrier_post((unsigned*)(p.ws + OFF_BAR), (volatile LAS unsigned*)(smem + 81904));
  phase_prologue(p, smem);
  grid.sync();
  layer<0>(p, smem, xb);
  xcd_barrier(xb);
  layer<1>(p, smem, xb);
}

extern "C" void kernel_launch(void* const* d_in, const int* in_sizes, int n_in, void* d_out,
                              int out_size, void* d_ws, size_t ws_size, hipStream_t stream) {
  static int grid_blocks = 0;
  if (!grid_blocks) {
    int dev = 0, cus = 0, per_cu = 0;
    (void)hipGetDevice(&dev);
    (void)hipDeviceGetAttribute(&cus, hipDeviceAttributeMultiprocessorCount, dev);
    (void)hipOccupancyMaxActiveBlocksPerMultiprocessor(&per_cu, fwd_megakernel, 256, 0);
    if (per_cu > 2) per_cu = 2;
    if (per_cu < 1) per_cu = 1;
    grid_blocks = cus * per_cu;
  }
  if (ws_size < WS_NEED) { fprintf(stderr, "workspace too small\n"); return; }
  Params p{};
  p.x = (const float*)d_in[0]; p.meta = (const float*)d_in[1]; p.ln_in_g = (const float*)d_in[2]; p.ln_in_b = (const float*)d_in[3];
  p.w_in = (const float*)d_in[4]; p.conv_w = (const float*)d_in[5]; p.gdn_conv_w = (const float*)d_in[6]; p.a_log = (const float*)d_in[7];
  p.dt_bias = (const float*)d_in[8]; p.gdn_norm_w = (const float*)d_in[9]; p.w_out = (const float*)d_in[10]; p.ln1_g = (const float*)d_in[11];
  p.ln1_b = (const float*)d_in[12]; p.w_q = (const float*)d_in[13]; p.k1 = (const float*)d_in[14]; p.k2 = (const float*)d_in[15];
  p.pu = (const float*)d_in[16]; p.pv = (const float*)d_in[17]; p.ln2_g = (const float*)d_in[18]; p.ln2_b = (const float*)d_in[19];
  p.out = (float*)d_out; p.ws = (char*)d_ws;
  (void)hipMemsetAsync((char*)d_ws + OFF_BAR, 0, 16384, stream);
  void* args[] = {&p};
  hipError_t e = hipLaunchCooperativeKernel((void*)fwd_megakernel, dim3(grid_blocks), dim3(256), args, 0, stream);
  if (e != hipSuccess) fprintf(stderr, "cooperative launch failed: %s (grid %d)\n", hipGetErrorString(e), grid_blocks);
}
```

```cpp
#include <hip/hip_runtime.h>
#include <hip/hip_cooperative_groups.h>
#include <cstdio>
namespace cg = cooperative_groups;

typedef unsigned short u16;
typedef unsigned int u32;
using bf16x8 = __attribute__((ext_vector_type(8))) short;
using s16x4 = __attribute__((ext_vector_type(4))) short;
using f32x4 = __attribute__((ext_vector_type(4))) float;
using f32x2 = __attribute__((ext_vector_type(2))) float;

#define DI __device__ __forceinline__
#define MFMA16(a, b, c) __builtin_amdgcn_mfma_f32_16x16x32_bf16((a), (b), (c), 0, 0, 0)

constexpr int NB = 4, SEQ = 8192, NMETA = 16, DM = 1024;
constexpr int LP = 8256;
constexpr int PADR = 48;
constexpr int MR = NB * LP;
constexpr int NCH = 129;
constexpr int NPROJ = 3592, NPROJP = 3712;
constexpr float ALPHA = 1.4142135623730951f;
constexpr float LN_EPS = 1e-5f, RMS_EPS = 1e-6f;
constexpr float TSCALE = 64.0f, TINV = 1.0f / 64.0f;

constexpr size_t SZ_HB = (size_t)MR * 1024 * 2;
constexpr size_t OFF_HB = 0;
constexpr size_t OFF_R1 = OFF_HB + SZ_HB;
constexpr size_t SZ_R1 = (size_t)MR * 3072 * 2;
constexpr size_t OFF_ZB = OFF_R1 + SZ_R1;
constexpr size_t SZ_ZB = (size_t)MR * 512 * 2;
constexpr size_t OFF_QKV = OFF_ZB + SZ_ZB;
constexpr size_t SZ_QKV = (size_t)MR * 1536 * 2;
constexpr size_t OFF_YB = OFF_QKV + SZ_QKV;
constexpr size_t OFF_AB = OFF_YB + SZ_HB;
constexpr size_t SZ_AB = (size_t)MR * 8 * 4;
constexpr size_t OFF_GB = OFF_AB + SZ_AB;
constexpr size_t OFF_WIN = OFF_GB + SZ_AB;
constexpr size_t SZ_WIN1 = (size_t)NPROJP * 1024 * 2;
constexpr size_t OFF_WOUT = OFF_WIN + 2 * SZ_WIN1;
constexpr size_t SZ_WOUT1 = (size_t)1024 * 1024 * 2;
constexpr size_t OFF_WQ = OFF_WOUT + 2 * SZ_WOUT1;
constexpr size_t SZ_WQ1 = (size_t)2048 * 1024 * 2;
constexpr size_t OFF_SK = OFF_WQ + 2 * SZ_WQ1;
constexpr size_t SZ_SK1 = (size_t)2 * 128 * 128 * 2;
constexpr size_t OFF_BAR = OFF_SK + 2 * SZ_SK1;
constexpr size_t WS_NEED = OFF_BAR + 16384;
constexpr size_t REC_BYTES = 58368;
constexpr size_t OFF_IDX = OFF_R1 + (size_t)MR * 2048 * 2;
constexpr size_t OFF_GATE = OFF_IDX + (size_t)MR * 128 * 4;
constexpr size_t OFF_TAB = OFF_GATE + (size_t)MR * 128 * 4;
static_assert((size_t)NB * NCH * 4 * REC_BYTES <= SZ_R1, "rec");
static_assert(OFF_GATE + (size_t)MR * 128 * 4 <= OFF_R1 + SZ_R1, "idx");
static_assert(OFF_TAB + (size_t)2 * 16384 * 1024 <= OFF_R1 + SZ_R1, "tab");
static_assert(WS_NEED <= (size_t)512 * 1024 * 1024, "ws");

struct Params {
  const float* x; const float* meta; const float* ln_in_g; const float* ln_in_b;
  const float* w_in; const float* conv_w; const float* gdn_conv_w; const float* a_log; const float* dt_bias;
  const float* gdn_norm_w; const float* w_out; const float* ln1_g; const float* ln1_b;
  const float* w_q; const float* k1; const float* k2; const float* pu; const float* pv;
  const float* ln2_g; const float* ln2_b;
  float* out; char* ws;
};

DI int opq(int x) { asm volatile("" : "+v"(x)); return x; }
DI char* opqp(char* w) { long z = 0; asm volatile("" : "+s"(z)); return w + z; }
DI int opqs(int x) { asm volatile("" : "+s"(x)); return x; }
#define SCHED_FENCE __builtin_amdgcn_sched_barrier(0)
typedef __bf16 hbf16x2 __attribute__((ext_vector_type(2)));
DI u32 pack2(float a, float b) { f32x2 v = {a, b}; hbf16x2 r = __builtin_convertvector(v, hbf16x2); return __builtin_bit_cast(u32, r); }
DI u16 f2bf(float x) { return (u16)(pack2(x, 0.f) & 0xffffu); }
DI float bf2f(u16 h) { return __uint_as_float(((u32)h) << 16); }
DI float bflo(u32 w) { return __uint_as_float(w << 16); }
DI float bfhi(u32 w) { return __uint_as_float(w & 0xffff0000u); }
DI float wsum(float v) {
#pragma unroll
  for (int o = 32; o > 0; o >>= 1) v += __shfl_xor(v, o);
  return v;
}
DI float erf_as(float x) {
  const float ax = fabsf(x);
  const float t = 1.0f / (1.0f + 0.3275911f * ax);
  const float poly = t * (0.254829592f + t * (-0.284496736f + t * (1.421413741f + t * (-1.453152027f + t * 1.061405429f))));
  const float r = 1.0f - poly * __expf(-ax * ax);
  return x < 0.f ? -r : r;
}
DI float siluf(float x) { return x / (1.0f + __expf(-x)); }
DI void unpack8(const uint4& v, float* f) {
  f[0] = bflo(v.x); f[1] = bfhi(v.x); f[2] = bflo(v.y); f[3] = bfhi(v.y);
  f[4] = bflo(v.z); f[5] = bfhi(v.z); f[6] = bflo(v.w); f[7] = bfhi(v.w);
}
DI uint4 pack8(const float* f) {
  uint4 v; v.x = pack2(f[0], f[1]); v.y = pack2(f[2], f[3]); v.z = pack2(f[4], f[5]); v.w = pack2(f[6], f[7]); return v;
}
DI bf16x8 pack_acc2(const f32x4& a, const f32x4& b) {
  uint4 v; v.x = pack2(a[0], a[1]); v.y = pack2(a[2], a[3]); v.z = pack2(b[0], b[1]); v.w = pack2(b[2], b[3]);
  return __builtin_bit_cast(bf16x8, v);
}
DI bf16x8 read2x4(const u16* p, int c0, int c1) {
  uint2 lo = *(const uint2*)(p + c0);
  uint2 hi = *(const uint2*)(p + c1);
  uint4 v; v.x = lo.x; v.y = lo.y; v.z = hi.x; v.w = hi.y;
  return __builtin_bit_cast(bf16x8, v);
}
DI u32 enc_fp8x4(float a, float b, float c, float d) {
  int v = 0;
  v = __builtin_amdgcn_cvt_pk_fp8_f32(a, b, v, false);
  v = __builtin_amdgcn_cvt_pk_fp8_f32(c, d, v, true);
  return (u32)v;
}
DI void dec_fp8x16(const uint4& v, float* f) {
  f32x2 t;
  t = __builtin_amdgcn_cvt_pk_f32_fp8((int)v.x, false); f[0] = t[0]; f[1] = t[1];
  t = __builtin_amdgcn_cvt_pk_f32_fp8((int)v.x, true);  f[2] = t[0]; f[3] = t[1];
  t = __builtin_amdgcn_cvt_pk_f32_fp8((int)v.y, false); f[4] = t[0]; f[5] = t[1];
  t = __builtin_amdgcn_cvt_pk_f32_fp8((int)v.y, true);  f[6] = t[0]; f[7] = t[1];
  t = __builtin_amdgcn_cvt_pk_f32_fp8((int)v.z, false); f[8] = t[0]; f[9] = t[1];
  t = __builtin_amdgcn_cvt_pk_f32_fp8((int)v.z, true);  f[10] = t[0]; f[11] = t[1];
  t = __builtin_amdgcn_cvt_pk_f32_fp8((int)v.w, false); f[12] = t[0]; f[13] = t[1];
  t = __builtin_amdgcn_cvt_pk_f32_fp8((int)v.w, true);  f[14] = t[0]; f[15] = t[1];
}
DI void dec_fp8x16_v2(const uint4& v, f32x2* f) {
  f[0] = __builtin_amdgcn_cvt_pk_f32_fp8((int)v.x, false); f[1] = __builtin_amdgcn_cvt_pk_f32_fp8((int)v.x, true);
  f[2] = __builtin_amdgcn_cvt_pk_f32_fp8((int)v.y, false); f[3] = __builtin_amdgcn_cvt_pk_f32_fp8((int)v.y, true);
  f[4] = __builtin_amdgcn_cvt_pk_f32_fp8((int)v.z, false); f[5] = __builtin_amdgcn_cvt_pk_f32_fp8((int)v.z, true);
  f[6] = __builtin_amdgcn_cvt_pk_f32_fp8((int)v.w, false); f[7] = __builtin_amdgcn_cvt_pk_f32_fp8((int)v.w, true);
}
DI u32 orderable(float f) { u32 u = __float_as_uint(f); return u ^ ((u >> 31) ? 0xffffffffu : 0x80000000u); }
#define INS16(v, xx) { u32 _x = (xx); _Pragma("unroll") for (int _i = 0; _i < 16; ++_i) { u32 _h = max(v[_i], _x); _x = min(v[_i], _x); v[_i] = _h; } }

DI void ln_row16(float* v, const float* __restrict__ g, const float* __restrict__ b, int lane) {
  float s = 0.f;
#pragma unroll
  for (int i = 0; i < 16; ++i) s += v[i];
  float mu = wsum(s) * (1.0f / 1024.0f);
  float q = 0.f;
#pragma unroll
  for (int i = 0; i < 16; ++i) { float d = v[i] - mu; q += d * d; }
  float var = wsum(q) * (1.0f / 1024.0f);
  float rs = rsqrtf(var + LN_EPS);
#pragma unroll
  for (int i4 = 0; i4 < 4; ++i4) {
    float4 gg = *(const float4*)(g + lane * 16 + i4 * 4);
    float4 bb = *(const float4*)(b + lane * 16 + i4 * 4);
    v[i4 * 4 + 0] = (v[i4 * 4 + 0] - mu) * rs * gg.x + bb.x;
    v[i4 * 4 + 1] = (v[i4 * 4 + 1] - mu) * rs * gg.y + bb.y;
    v[i4 * 4 + 2] = (v[i4 * 4 + 2] - mu) * rs * gg.z + bb.z;
    v[i4 * 4 + 3] = (v[i4 * 4 + 3] - mu) * rs * gg.w + bb.w;
  }
}
DI void load_gb16(float* g, float* b, const float* __restrict__ gp, const float* __restrict__ bp, int lane) {
#pragma unroll
  for (int i4 = 0; i4 < 4; ++i4) {
    float4 gg = *(const float4*)(gp + lane * 16 + i4 * 4);
    float4 bb = *(const float4*)(bp + lane * 16 + i4 * 4);
    g[i4 * 4] = gg.x; g[i4 * 4 + 1] = gg.y; g[i4 * 4 + 2] = gg.z; g[i4 * 4 + 3] = gg.w;
    b[i4 * 4] = bb.x; b[i4 * 4 + 1] = bb.y; b[i4 * 4 + 2] = bb.z; b[i4 * 4 + 3] = bb.w;
  }
}
DI void ln_row16_reg(float* v, const float* g, const float* b) {
  float s = 0.f;
#pragma unroll
  for (int i = 0; i < 16; ++i) s += v[i];
  const float mu = wsum(s) * (1.0f / 1024.0f);
  float q = 0.f;
#pragma unroll
  for (int i = 0; i < 16; ++i) { const float d = v[i] - mu; q += d * d; }
  const float var = wsum(q) * (1.0f / 1024.0f);
  const float rs = rsqrtf(var + LN_EPS);
#pragma unroll
  for (int i = 0; i < 16; ++i) v[i] = (v[i] - mu) * rs * g[i] + b[i];
}
DI void store_row16_bf16(u16* dst, const float* v, int lane) {
  *(uint4*)(dst + lane * 16) = pack8(v);
  *(uint4*)(dst + lane * 16 + 8) = pack8(v + 8);
}

DI void transpose_convert(const float* __restrict__ W, int K, int N, int Npad, u16* __restrict__ Wt, char* smem) {
  float* tile = (float*)smem;
  const int tid = opq(threadIdx.x);
  const int ntn = Npad / 64, ntk = K / 64;
  for (int t = blockIdx.x; t < ntn * ntk; t += gridDim.x) {
    const int n0 = (t % ntn) * 64, k0 = (t / ntn) * 64;
#pragma unroll 4
    for (int i = 0; i < 16; ++i) {
      int idx = tid + i * 256; int kk = idx >> 6, nn = idx & 63;
      float val = (n0 + nn < N) ? W[(size_t)(k0 + kk) * N + n0 + nn] : 0.f;
      tile[kk * 65 + nn] = val;
    }
    __syncthreads();
#pragma unroll 4
    for (int i = 0; i < 16; ++i) {
      int idx = tid + i * 256; int nn = idx >> 6, kk = idx & 63;
      Wt[(size_t)(n0 + nn) * K + k0 + kk] = f2bf(tile[kk * 65 + nn]);
    }
    __syncthreads();
  }
}

DI void phase_prologue(const Params& p, char* smem) {
  char* const WS = opqp(p.ws);
  const int tid = opq(threadIdx.x), lane = tid & 63, w = tid >> 6;
  u16* HB = (u16*)(WS + OFF_HB);
  float lg[16], lb[16];
  load_gb16(lg, lb, p.ln_in_g, p.ln_in_b, lane);
  for (int r = blockIdx.x * 4 + w; r < MR; r += gridDim.x * 4) {
    const int b = r / LP, pp = r % LP;
    float v[16];
    if (pp < PADR) {
#pragma unroll
      for (int i = 0; i < 16; ++i) v[i] = 0.f;
    } else {
      const float* src = (pp < 64) ? (p.meta + (size_t)(pp - PADR) * DM) : (p.x + ((size_t)b * SEQ + (pp - 64)) * DM);
#pragma unroll
      for (int i4 = 0; i4 < 4; ++i4) {
        float4 t = *(const float4*)(src + lane * 16 + i4 * 4);
        v[i4 * 4] = t.x; v[i4 * 4 + 1] = t.y; v[i4 * 4 + 2] = t.z; v[i4 * 4 + 3] = t.w;
      }
      ln_row16_reg(v, lg, lb);
    }
    store_row16_bf16(HB + (size_t)r * DM, v, lane);
  }
  for (int l = 0; l < 2; ++l) {
    transpose_convert(p.w_in + (size_t)l * 1024 * NPROJ, 1024, NPROJ, NPROJP, (u16*)(WS + OFF_WIN + l * SZ_WIN1), smem);
    transpose_convert(p.w_out + (size_t)l * 1024 * 1024, 1024, 1024, 1024, (u16*)(WS + OFF_WOUT + l * SZ_WOUT1), smem);
    transpose_convert(p.w_q + (size_t)l * 1024 * 2048, 1024, 2048, 2048, (u16*)(WS + OFF_WQ + l * SZ_WQ1), smem);
  }
  u16* SK = (u16*)(WS + OFF_SK);
  for (int i = blockIdx.x * 256 + tid; i < 2 * 2 * 16384; i += gridDim.x * 256) {
    int l = i >> 15, rem = i & 32767, hf = rem >> 14, e = rem & 16383;
    const float* src = (hf ? p.k2 : p.k1) + (size_t)l * 16384;
    SK[i] = f2bf(src[e]);
  }
}

DI void convert_tables(const Params& p, int l, int first_block) {
  char* const WS = opqp(p.ws);
  u32* TAB = (u32*)(WS + OFF_TAB);
  const size_t n16 = (size_t)2 * 16384 * 1024 / 16;
  for (size_t i = (size_t)((opqs(blockIdx.x) - first_block) * 256 + opq(threadIdx.x)); i < n16; i += (size_t)(gridDim.x - first_block) * 256) {
    const size_t e0 = i * 16;
    const int which = (int)(e0 >> 24);
    const size_t off = e0 & (((size_t)1 << 24) - 1);
    const float* src = (which ? p.pv : p.pu) + (size_t)l * 16384 * 1024 + off;
    uint4 o;
    float4 a = *(const float4*)(src), b = *(const float4*)(src + 4), c = *(const float4*)(src + 8), d = *(const float4*)(src + 12);
    o.x = enc_fp8x4(a.x * TSCALE, a.y * TSCALE, a.z * TSCALE, a.w * TSCALE);
    o.y = enc_fp8x4(b.x * TSCALE, b.y * TSCALE, b.z * TSCALE, b.w * TSCALE);
    o.z = enc_fp8x4(c.x * TSCALE, c.y * TSCALE, c.z * TSCALE, c.w * TSCALE);
    o.w = enc_fp8x4(d.x * TSCALE, d.y * TSCALE, d.z * TSCALE, d.w * TSCALE);
    *(uint4*)(TAB + i * 4) = o;
  }
}

template <int EPI>
DI void gemm_phase(const Params& p, size_t offA, size_t offB, int ntn, char* smem) {
  char* const WS = opqp(p.ws);
  const u16* __restrict__ A = (const u16*)(WS + offA);
  const u16* __restrict__ Bt = (const u16*)(WS + offB);
  constexpr int K = 1024, LDS_ST = 64;
  u16* As = (u16*)smem;
  u16* Bs = As + 2 * 128 * LDS_ST;
  const int tid = opq(threadIdx.x), lane = tid & 63, w = tid >> 6, wm = w >> 1, wn = w & 1;
  const int l15 = lane & 15, q = lane >> 4;
  const int ntm = MR / 128;
  for (int tile = blockIdx.x; tile < ntm * ntn; tile += gridDim.x) {
    const int tm = tile / ntn, tn = tile % ntn;
    const u16* Ag = A + (size_t)(tm * 128) * K;
    const u16* Bg = Bt + (size_t)(tn * 128) * K;
    f32x4 acc[4][4];
#pragma unroll
    for (int i = 0; i < 4; ++i)
#pragma unroll
      for (int j = 0; j < 4; ++j) acc[i][j] = (f32x4){0.f, 0.f, 0.f, 0.f};
    uint4 a0_0, a0_1, a0_2, a0_3, b0_0, b0_1, b0_2, b0_3, a1_0, a1_1, a1_2, a1_3, b1_0, b1_1, b1_2, b1_3;
    const int lrow = tid >> 3, lc = (tid & 7) * 8;
    const int lcs = ((tid & 7) ^ ((lrow >> 1) & 7)) * 8;
    const int rsw = (l15 >> 1) & 7;
    const u16* Agl = Ag + (size_t)lrow * K + lc;
    const u16* Bgl = Bg + (size_t)lrow * K + lc;
#define G_LD(S, k0) { S##a##_0 = *(const uint4*)(Agl + (k0)); S##a##_1 = *(const uint4*)(Agl + (size_t)32 * K + (k0)); \
      S##a##_2 = *(const uint4*)(Agl + (size_t)64 * K + (k0)); S##a##_3 = *(const uint4*)(Agl + (size_t)96 * K + (k0)); \
      S##b##_0 = *(const uint4*)(Bgl + (k0)); S##b##_1 = *(const uint4*)(Bgl + (size_t)32 * K + (k0)); \
      S##b##_2 = *(const uint4*)(Bgl + (size_t)64 * K + (k0)); S##b##_3 = *(const uint4*)(Bgl + (size_t)96 * K + (k0)); }
#define G_LD0(k0) { a0_0 = *(const uint4*)(Agl + (k0)); a0_1 = *(const uint4*)(Agl + (size_t)32 * K + (k0)); \
      a0_2 = *(const uint4*)(Agl + (size_t)64 * K + (k0)); a0_3 = *(const uint4*)(Agl + (size_t)96 * K + (k0)); \
      b0_0 = *(const uint4*)(Bgl + (k0)); b0_1 = *(const uint4*)(Bgl + (size_t)32 * K + (k0)); \
      b0_2 = *(const uint4*)(Bgl + (size_t)64 * K + (k0)); b0_3 = *(const uint4*)(Bgl + (size_t)96 * K + (k0)); }
#define G_LD1(k0) { a1_0 = *(const uint4*)(Agl + (k0)); a1_1 = *(const uint4*)(Agl + (size_t)32 * K + (k0)); \
      a1_2 = *(const uint4*)(Agl + (size_t)64 * K + (k0)); a1_3 = *(const uint4*)(Agl + (size_t)96 * K + (k0)); \
      b1_0 = *(const uint4*)(Bgl + (k0)); b1_1 = *(const uint4*)(Bgl + (size_t)32 * K + (k0)); \
      b1_2 = *(const uint4*)(Bgl + (size_t)64 * K + (k0)); b1_3 = *(const uint4*)(Bgl + (size_t)96 * K + (k0)); }
#define L_ST0(buf) { u16* An_ = As + (buf) * 128 * LDS_ST + lrow * LDS_ST + lcs; u16* Bn_ = Bs + (buf) * 128 * LDS_ST + lrow * LDS_ST + lcs; \
      *(uint4*)(An_) = a0_0; *(uint4*)(An_ + 32 * LDS_ST) = a0_1; *(uint4*)(An_ + 64 * LDS_ST) = a0_2; *(uint4*)(An_ + 96 * LDS_ST) = a0_3; \
      *(uint4*)(Bn_) = b0_0; *(uint4*)(Bn_ + 32 * LDS_ST) = b0_1; *(uint4*)(Bn_ + 64 * LDS_ST) = b0_2; *(uint4*)(Bn_ + 96 * LDS_ST) = b0_3; }
#define L_ST1(buf) { u16* An_ = As + (buf) * 128 * LDS_ST + lrow * LDS_ST + lcs; u16* Bn_ = Bs + (buf) * 128 * LDS_ST + lrow * LDS_ST + lcs; \
      *(uint4*)(An_) = a1_0; *(uint4*)(An_ + 32 * LDS_ST) = a1_1; *(uint4*)(An_ + 64 * LDS_ST) = a1_2; *(uint4*)(An_ + 96 * LDS_ST) = a1_3; \
      *(uint4*)(Bn_) = b1_0; *(uint4*)(Bn_ + 32 * LDS_ST) = b1_1; *(uint4*)(Bn_ + 64 * LDS_ST) = b1_2; *(uint4*)(Bn_ + 96 * LDS_ST) = b1_3; }
#define G_COMPUTE(buf) { const u16* Ac = As + (buf) * 128 * LDS_ST; const u16* Bc = Bs + (buf) * 128 * LDS_ST; \
      _Pragma("unroll") for (int kk = 0; kk < 2; ++kk) { \
        bf16x8 af[4], bfr[4]; \
        _Pragma("unroll") for (int mt = 0; mt < 4; ++mt) af[mt] = *(const bf16x8*)(Ac + (wm * 64 + mt * 16 + l15) * LDS_ST + (((kk * 4 + q) ^ rsw) * 8)); \
        _Pragma("unroll") for (int nt = 0; nt < 4; ++nt) bfr[nt] = *(const bf16x8*)(Bc + (wn * 64 + nt * 16 + l15) * LDS_ST + (((kk * 4 + q) ^ rsw) * 8)); \
        _Pragma("unroll") for (int mt = 0; mt < 4; ++mt) \
          _Pragma("unroll") for (int nt = 0; nt < 4; ++nt) acc[mt][nt] = MFMA16(bfr[nt], af[mt], acc[mt][nt]); } }
    constexpr int nk = K / 64;
    G_LD0(0)
    L_ST0(0)
    G_LD0(64)
    __syncthreads();
    for (int kt = 0; kt < nk; kt += 2) {
      L_ST0(1)
      if (kt + 2 < nk) G_LD1((kt + 2) * 64)
      G_COMPUTE(0)
      __syncthreads();
      if (kt + 2 < nk) L_ST1(0)
      if (kt + 3 < nk) G_LD0((kt + 3) * 64)
      G_COMPUTE(1)
      __syncthreads();
    }
#pragma unroll
    for (int mt = 0; mt < 4; ++mt) {
      const size_t m = (size_t)tm * 128 + wm * 64 + mt * 16 + l15;
#pragma unroll
      for (int nt = 0; nt < 4; ++nt) {
        const int n = tn * 128 + wn * 64 + nt * 16 + q * 4;
        const f32x4 a = acc[mt][nt];
        if (EPI == 1) {
          if (tn < 24) {
            uint2 o; o.x = pack2(a[0], a[1]); o.y = pack2(a[2], a[3]);
            *(uint2*)((u16*)(WS + OFF_R1) + m * 3072 + n) = o;
          } else if (tn < 28) {
            uint2 o; o.x = pack2(a[0], a[1]); o.y = pack2(a[2], a[3]);
            *(uint2*)((u16*)(WS + OFF_ZB) + m * 512 + (n - 3072)) = o;
          } else {
            if (n - 3584 < 8) *(float4*)((float*)(WS + OFF_AB) + m * 8 + (n - 3584)) = make_float4(a[0], a[1], a[2], a[3]);
          }
        } else if (EPI == 2) {
          uint2 o; o.x = pack2(a[0], a[1]); o.y = pack2(a[2], a[3]);
          *(uint2*)((u16*)(WS + OFF_R1) + m * 1024 + n) = o;
        } else {
          uint2 o; o.x = pack2(a[0], a[1]); o.y = pack2(a[2], a[3]);
          *(uint2*)((u16*)(WS + OFF_R1) + m * 2048 + n) = o;
        }
      }
    }
  }
}

DI void phase_p2(const Params& p, int l, char* smem) {
  char* const WS = opqp(p.ws);
  const int tid = opq(threadIdx.x), lane = tid & 63, w = tid >> 6;
  float* cw = (float*)smem;
  float* gw = cw + 3 * 512;
  {
    const float* cwg = p.conv_w + (size_t)l * 3 * 512;
    const float* gwg = p.gdn_conv_w + (size_t)l * 4 * 1536;
    for (int i = tid; i < 3 * 512 / 4; i += 256) *(float4*)(cw + i * 4) = *(const float4*)(cwg + i * 4);
    for (int i = tid; i < 4 * 1536 / 4; i += 256) *(float4*)(gw + i * 4) = *(const float4*)(gwg + i * 4);
  }
  __syncthreads();
  const u16* R1 = (const u16*)(WS + OFF_R1);
  u16* QKV = (u16*)(WS + OFF_QKV);
  u16* YB = (u16*)(WS + OFF_YB);
  const float* AB = (const float*)(WS + OFF_AB);
  float* GB = (float*)(WS + OFF_GB);
  const int gwv = blockIdx.x * 4 + w, nwv = gridDim.x * 4;
  const int rchunk = (int)(((unsigned)MR + (unsigned)nwv - 1u) / (unsigned)nwv);
  const int r_beg = min(MR, gwv * rchunk), r_end = min(MR, r_beg + rchunk);
  for (int r = r_beg; r < r_end; ++r) {
    const int pp = r % LP;
    if (pp < PADR) {
      const uint4 z4 = make_uint4(0, 0, 0, 0);
#pragma unroll
      for (int i = 0; i < 3; ++i) *(uint4*)(QKV + (size_t)r * 1536 + i * 512 + lane * 8) = z4;
      *(uint4*)(YB + (size_t)r * 1024 + lane * 8) = z4;
      *(uint4*)(YB + (size_t)r * 1024 + 512 + lane * 8) = z4;
      if (lane < 8) GB[(size_t)r * 8 + lane] = 0.f;
      continue;
    }
    const int c0 = lane * 8;
    {
      float cb[8], acc[8];
      unpack8(*(const uint4*)(R1 + (size_t)r * 3072 + c0), cb);
#pragma unroll
      for (int i = 0; i < 8; ++i) acc[i] = 0.f;
#pragma unroll
      for (int j = 0; j < 3; ++j) {
        const size_t rr = (size_t)(r - 2 + j);
        float cc[8], ch[8];
        unpack8(*(const uint4*)(R1 + rr * 3072 + 512 + c0), cc);
        unpack8(*(const uint4*)(R1 + rr * 3072 + 1024 + c0), ch);
        float4 w0 = *(const float4*)(cw + j * 512 + c0), w1 = *(const float4*)(cw + j * 512 + c0 + 4);
        const float ww[8] = {w0.x, w0.y, w0.z, w0.w, w1.x, w1.y, w1.z, w1.w};
#pragma unroll
        for (int i = 0; i < 8; ++i) acc[i] += ww[i] * (cc[i] * ch[i]);
      }
#pragma unroll
      for (int i = 0; i < 8; ++i) acc[i] *= cb[i];
      *(uint4*)(YB + (size_t)r * 1024 + c0) = pack8(acc);
    }
#pragma unroll
    for (int part = 0; part < 3; ++part) {
      const int c = part * 512 + c0;
      float acc[8];
#pragma unroll
      for (int i = 0; i < 8; ++i) acc[i] = 0.f;
#pragma unroll
      for (int j = 0; j < 4; ++j) {
        const size_t rr = (size_t)(r - 3 + j);
        float xv[8];
        unpack8(*(const uint4*)(R1 + rr * 3072 + 1536 + c), xv);
        float4 w0 = *(const float4*)(gw + j * 1536 + c), w1 = *(const float4*)(gw + j * 1536 + c + 4);
        const float ww[8] = {w0.x, w0.y, w0.z, w0.w, w1.x, w1.y, w1.z, w1.w};
#pragma unroll
        for (int i = 0; i < 8; ++i) acc[i] += ww[i] * xv[i];
      }
      float ss = 0.f;
#pragma unroll
      for (int i = 0; i < 8; ++i) { acc[i] = siluf(acc[i]); ss += acc[i] * acc[i]; }
      if (part < 2) {
        ss += __shfl_xor(ss, 1); ss += __shfl_xor(ss, 2); ss += __shfl_xor(ss, 4); ss += __shfl_xor(ss, 8);
        float sc = rsqrtf(ss + RMS_EPS);
        if (part == 0) sc *= 0.08838834764831845f;
#pragma unroll
        for (int i = 0; i < 8; ++i) acc[i] *= sc;
      }
      *(uint4*)(QKV + (size_t)r * 1536 + c) = pack8(acc);
    }
    if (lane < 4) {
      const float a = AB[(size_t)r * 8 + lane], bb = AB[(size_t)r * 8 + 4 + lane];
      const float xx = a + p.dt_bias[l * 4 + lane];
      const float tt = __expf(-fabsf(xx));
      const float l1p = (tt < 0.01f) ? tt * (1.0f - tt * (0.5f - tt * 0.33333333f)) : __logf(1.0f + tt);
      const float sp = fmaxf(xx, 0.f) + l1p;
      GB[(size_t)r * 8 + lane] = -__expf(p.a_log[l * 4 + lane]) * sp;
      GB[(size_t)r * 8 + 4 + lane] = 1.0f / (1.0f + __expf(-bb));
    }
  }
}

DI void phase_p3(const Params& p, char* smem) {
  char* const WS = opqp(p.ws);
  constexpr int ST = 136, AST = 68;
  u16* kb = (u16*)smem;
  u16* qb = kb + 64 * ST;
  u16* kbb = qb + 64 * ST;
  float* As = (float*)(kbb + 64 * ST);
  float* s_gc = As + 64 * AST;
  float* s_bt = s_gc + 64;
  const int tid = opq(threadIdx.x), lane = tid & 63, w = tid >> 6, l15 = lane & 15, q = lane >> 4;
  const u16* QKV = (const u16*)(WS + OFF_QKV);
  const float* GB = (const float*)(WS + OFF_GB);
  for (int task = blockIdx.x; task < NB * NCH * 4; task += gridDim.x) {
    const int h = task & 3, bn = task >> 2, b = bn / NCH, n = bn % NCH;
    const size_t row0 = (size_t)b * LP + (size_t)n * 64;
    char* rec = WS + OFF_R1 + (size_t)task * REC_BYTES;
    u16* rec_u = (u16*)rec; u16* rec_w = rec_u + 8192; u16* rec_kT = rec_w + 8192; u16* rec_at = rec_kT + 8192;
    float* rec_eg = (float*)(rec + 57344); float* rec_egl = rec_eg + 64; float* rec_gl = rec_egl + 64;
    const int npad = (n == 0) ? PADR : 0;
    if (tid < 64) {
      const bool pad = tid < npad;
      float g = pad ? 0.f : GB[(row0 + tid) * 8 + h];
      float bt = pad ? 0.f : GB[(row0 + tid) * 8 + 4 + h];
#pragma unroll
      for (int o = 1; o < 64; o <<= 1) { float t = __shfl_up(g, o); if (lane >= o) g += t; }
      s_gc[tid] = g; s_bt[tid] = bt;
      const float gl = __shfl(g, 63);
      rec_eg[tid] = __expf(g);
      rec_egl[tid] = __expf(gl - g);
      if (tid == 0) rec_gl[0] = __expf(gl);
    }
    __syncthreads();
#pragma unroll
    for (int i = 0; i < 4; ++i) {
      int idx = tid + i * 256; int row = idx >> 4, c = idx & 15;
      uint4 kv = make_uint4(0, 0, 0, 0), qv = make_uint4(0, 0, 0, 0);
      if (row >= npad) {
        kv = *(const uint4*)(QKV + (row0 + row) * 1536 + 512 + h * 128 + c * 8);
        qv = *(const uint4*)(QKV + (row0 + row) * 1536 + h * 128 + c * 8);
      }
      *(uint4*)(kb + row * ST + c * 8) = kv;
      *(uint4*)(qb + row * ST + c * 8) = qv;
      float kf[8]; unpack8(kv, kf);
      const float bt = s_bt[row];
#pragma unroll
      for (int j = 0; j < 8; ++j) kf[j] *= bt;
      *(uint4*)(kbb + row * ST + c * 8) = pack8(kf);
    }
    __syncthreads();
#pragma unroll
    for (int it = 0; it < 4; ++it) {
      int idx = tid + it * 256; int d = idx >> 3, i8 = idx & 7;
      u32 t[4];
#pragma unroll
      for (int jj = 0; jj < 4; ++jj) t[jj] = (u32)kb[(i8 * 8 + 2 * jj) * ST + d] | ((u32)kb[(i8 * 8 + 2 * jj + 1) * ST + d] << 16);
      *(uint4*)(rec_kT + d * 64 + i8 * 8) = make_uint4(t[0], t[1], t[2], t[3]);
    }
    {
      const int mat = w >> 1;
      const u16* src = mat ? qb : kbb;
      f32x4 acc[2][4];
#pragma unroll
      for (int i = 0; i < 2; ++i)
#pragma unroll
        for (int j = 0; j < 4; ++j) acc[i][j] = (f32x4){0.f, 0.f, 0.f, 0.f};
#pragma unroll
      for (int ks = 0; ks < 4; ++ks) {
        bf16x8 a[2], bb[4];
#pragma unroll
        for (int mi = 0; mi < 2; ++mi) a[mi] = *(const bf16x8*)(src + (((w & 1) * 2 + mi) * 16 + l15) * ST + ks * 32 + q * 8);
#pragma unroll
        for (int nt = 0; nt < 4; ++nt) bb[nt] = *(const bf16x8*)(kb + (nt * 16 + l15) * ST + ks * 32 + q * 8);
#pragma unroll
        for (int mi = 0; mi < 2; ++mi)
#pragma unroll
          for (int nt = 0; nt < 4; ++nt) acc[mi][nt] = MFMA16(a[mi], bb[nt], acc[mi][nt]);
      }
#pragma unroll
      for (int mi = 0; mi < 2; ++mi)
#pragma unroll
        for (int nt = 0; nt < 4; ++nt)
#pragma unroll
          for (int r = 0; r < 4; ++r) {
            const int i = ((w & 1) * 2 + mi) * 16 + q * 4 + r, j = nt * 16 + l15;
            const float dec = __expf(s_gc[i] - s_gc[j]);
            if (mat == 0) As[i * AST + j] = (i > j) ? acc[mi][nt][r] * dec : 0.f;
            else rec_at[i * 64 + j] = f2bf((i >= j) ? acc[mi][nt][r] * dec : 0.f);
          }
    }
    __syncthreads();
    {
      const int mat = tid >> 7, c = tid & 127;
      float x[64];
      if (mat == 0) {
#pragma unroll
        for (int i = 0; i < 64; ++i) {
          const float vv = (i >= npad) ? bf2f(QKV[(row0 + i) * 1536 + 1024 + h * 128 + c]) : 0.f;
          x[i] = vv * s_bt[i];
        }
      } else {
#pragma unroll
        for (int i = 0; i < 64; ++i) x[i] = bf2f(kb[i * ST + c]) * s_bt[i] * __expf(s_gc[i]);
      }
#pragma unroll
      for (int i = 1; i < 64; ++i) {
        float s = x[i];
#pragma unroll
        for (int j4 = 0; j4 < (i + 3) / 4; ++j4) {
          const float4 a = *(const float4*)(As + i * AST + j4 * 4);
          s -= a.x * x[j4 * 4 + 0];
          if (j4 * 4 + 1 < i) s -= a.y * x[j4 * 4 + 1];
          if (j4 * 4 + 2 < i) s -= a.z * x[j4 * 4 + 2];
          if (j4 * 4 + 3 < i) s -= a.w * x[j4 * 4 + 3];
        }
        x[i] = s;
        if ((i & 3) == 3) SCHED_FENCE;
      }
      if (mat) {
#pragma unroll
        for (int i = 0; i < 64; ++i) rec_w[i * 128 + c] = f2bf(x[i]);
      } else {
        const int ug = c >> 4, ul = c & 15;
#pragma unroll
        for (int mt = 0; mt < 4; ++mt)
#pragma unroll
          for (int qq = 0; qq < 4; ++qq) {
            const int i0 = mt * 16 + qq * 4;
            uint2 o; o.x = pack2(x[i0], x[i0 + 1]); o.y = pack2(x[i0 + 2], x[i0 + 3]);
            *(uint2*)(rec_u + ((ug * 64 + qq * 16 + ul) * 16 + mt * 4)) = o;
          }
      }
    }
    __syncthreads();
  }
}

DI void phase_scan(const Params& p, int l, char* smem) {
  char* const WS = opqp(p.ws);
  if (blockIdx.x >= 32) { convert_tables(p, l, 32); return; }
  constexpr int ST = 136, ST2 = 72;
  u16* ws_ = (u16*)smem;
  u16* qs_ = ws_ + 64 * ST;
  u16* kts = qs_ + 64 * ST;
  u16* ats = kts + 128 * ST2;
  float* scl = (float*)(ats + 64 * ST2);
  const int tid = opq(threadIdx.x), lane = tid & 63, w = tid >> 6, l15 = lane & 15, q = lane >> 4;
  const int b = blockIdx.x >> 3, h = (blockIdx.x >> 1) & 3, half = blockIdx.x & 1;
  const u16* QKV = (const u16*)(WS + OFF_QKV);
  u16* YB = (u16*)(WS + OFF_YB);
  const int uoff = ((half * 4 + w) * 64 + lane) * 16;
  f32x4 S[8];
#pragma unroll
  for (int i = 0; i < 8; ++i) S[i] = (f32x4){0.f, 0.f, 0.f, 0.f};
  uint4 uc0, uc1;
  {
    const int task = ((b * NCH) << 2) + h;
    const size_t row0 = (size_t)b * LP;
    const char* rec = WS + OFF_R1 + (size_t)task * REC_BYTES;
    const u16* rec_u = (const u16*)rec; const u16* rec_w = rec_u + 8192; const u16* rec_kT = rec_w + 8192; const u16* rec_at = rec_kT + 8192;
    const float* rec_eg = (const float*)(rec + 57344);
#pragma unroll
    for (int i = 0; i < 4; ++i) {
      int idx = tid + i * 256; int row = idx >> 4, c = idx & 15;
      *(uint4*)(ws_ + row * ST + c * 8) = *(const uint4*)(rec_w + row * 128 + c * 8);
      *(uint4*)(qs_ + row * ST + c * 8) = *(const uint4*)(QKV + (row0 + row) * 1536 + h * 128 + c * 8);
      int rk = idx >> 3, ck = idx & 7;
      *(uint4*)(kts + rk * ST2 + ck * 8) = *(const uint4*)(rec_kT + rk * 64 + ck * 8);
    }
#pragma unroll
    for (int i = 0; i < 2; ++i) { int idx = tid + i * 256; int row = idx >> 3, c = idx & 7; *(uint4*)(ats + row * ST2 + c * 8) = *(const uint4*)(rec_at + row * 64 + c * 8); }
    if (tid < 129) scl[tid] = rec_eg[tid];
    uc0 = *(const uint4*)(rec_u + uoff); uc1 = *(const uint4*)(rec_u + uoff + 8);
  }
  __syncthreads();
  for (int n = 0; n < NCH; ++n) {
    const int cur = n & 1;
    const bool has_next = (n + 1 < NCH);
    const size_t row0 = (size_t)b * LP + (size_t)n * 64;
    const int taskn = ((b * NCH + (has_next ? n + 1 : n)) << 2) + h;
    const char* recn = WS + OFF_R1 + (size_t)taskn * REC_BYTES;
    const u16* recn_u = (const u16*)recn; const u16* recn_w = recn_u + 8192; const u16* recn_kT = recn_w + 8192; const u16* recn_at = recn_kT + 8192;
    const float* recn_eg = (const float*)(recn + 57344);
    const size_t row0n = has_next ? row0 + 64 : row0;
    const float* egs = scl + cur * 132;
    const float* egls = egs + 64;
    uint4 ra0, ra1, ra2, ra3, ra4, ra5, ra6, ra7;
    {
      const int tl = opq(threadIdx.x);
#define LD_A(i, RW, RQ) { const int idx = tl + (i) * 256; const int row = idx >> 4, c = idx & 15; \
        RW = *(const uint4*)(recn_w + row * 128 + c * 8); RQ = *(const uint4*)(QKV + (row0n + row) * 1536 + h * 128 + c * 8); }
      LD_A(0, ra0, ra4) LD_A(1, ra1, ra5) LD_A(2, ra2, ra6) LD_A(3, ra3, ra7)
    }
    f32x4 P[4], O[4];
#pragma unroll
    for (int i = 0; i < 4; ++i) { P[i] = O[i] = (f32x4){0.f, 0.f, 0.f, 0.f}; }
#pragma unroll
    for (int ks = 0; ks < 4; ++ks) {
      const bf16x8 sb0 = pack_acc2(S[2 * ks], S[2 * ks + 1]);
#pragma unroll
      for (int mt = 0; mt < 4; ++mt) {
        const bf16x8 aw = read2x4(ws_ + (mt * 16 + l15) * ST, ks * 32 + 4 * q, ks * 32 + 16 + 4 * q);
        const bf16x8 aq = read2x4(qs_ + (mt * 16 + l15) * ST, ks * 32 + 4 * q, ks * 32 + 16 + 4 * q);
        P[mt] = MFMA16(aw, sb0, P[mt]);
        O[mt] = MFMA16(aq, sb0, O[mt]);
      }
    }
    {
      const u32 uw_[8] = {uc0.x, uc0.y, uc0.z, uc0.w, uc1.x, uc1.y, uc1.z, uc1.w};
#pragma unroll
      for (int mt = 0; mt < 4; ++mt)
#pragma unroll
        for (int r = 0; r < 4; ++r) {
          const int i = mt * 16 + 4 * q + r;
          const int ui = mt * 4 + r;
          const float uv = (ui & 1) ? bfhi(uw_[ui >> 1]) : bflo(uw_[ui >> 1]);
          P[mt][r] = uv - P[mt][r];
          O[mt][r] *= egs[i];
        }
    }
    SCHED_FENCE;
    __syncthreads();
    uint4 rb0, rb1, rb2, rb3, rb4, rb5, un0, un1;
    float e_next = 0.f;
    {
      const int tl = opq(threadIdx.x);
#define ST_A(i, RW, RQ) { const int idx = tl + (i) * 256; const int row = idx >> 4, c = idx & 15; \
        *(uint4*)(ws_ + row * ST + c * 8) = RW; *(uint4*)(qs_ + row * ST + c * 8) = RQ; }
      ST_A(0, ra0, ra4) ST_A(1, ra1, ra5) ST_A(2, ra2, ra6) ST_A(3, ra3, ra7)
#define LD_K(i, R) { const int idx = tl + (i) * 256; const int rk = idx >> 3, ck = idx & 7; R = *(const uint4*)(recn_kT + rk * 64 + ck * 8); }
      LD_K(0, rb0) LD_K(1, rb1) LD_K(2, rb2) LD_K(3, rb3)
#define LD_T(i, R) { const int idx = tl + (i) * 256; const int row = idx >> 3, c = idx & 7; R = *(const uint4*)(recn_at + row * 64 + c * 8); }
      LD_T(0, rb4) LD_T(1, rb5)
      un0 = *(const uint4*)(recn_u + uoff);
      un1 = *(const uint4*)(recn_u + uoff + 8);
      if (tl < 129) e_next = recn_eg[tl];
    }
    {
      bf16x8 vb[2];
#pragma unroll
      for (int k2 = 0; k2 < 2; ++k2) vb[k2] = pack_acc2(P[2 * k2], P[2 * k2 + 1]);
#pragma unroll
      for (int k2 = 0; k2 < 2; ++k2)
#pragma unroll
        for (int mt = 0; mt < 4; ++mt) {
          const bf16x8 aa = read2x4(ats + (mt * 16 + l15) * ST2, k2 * 32 + 4 * q, k2 * 32 + 16 + 4 * q);
          O[mt] = MFMA16(aa, vb[k2], O[mt]);
        }
    }
    {
      const int npad = (n == 0) ? PADR : 0;
      u16* yp = YB + (row0 + 4 * q) * 1024 + 512 + h * 128 + half * 64 + w * 16 + l15;
#pragma unroll
      for (int mt = 0; mt < 4; ++mt)
#pragma unroll
        for (int r = 0; r < 4; ++r)
          if (mt * 16 + 4 * q + r >= npad) yp[(mt * 16 + r) * 1024] = f2bf(O[mt][r]);
    }
    {
#pragma unroll
      for (int mt = 0; mt < 4; ++mt)
#pragma unroll
        for (int r = 0; r < 4; ++r) P[mt][r] *= egls[mt * 16 + 4 * q + r];
      bf16x8 vb[2];
#pragma unroll
      for (int k2 = 0; k2 < 2; ++k2) vb[k2] = pack_acc2(P[2 * k2], P[2 * k2 + 1]);
      const float egl = egs[128];
#pragma unroll
      for (int dt = 0; dt < 8; ++dt) S[dt] *= egl;
#pragma unroll
      for (int k2 = 0; k2 < 2; ++k2)
#pragma unroll
        for (int dt = 0; dt < 8; ++dt) {
          const bf16x8 ak = read2x4(kts + (dt * 16 + l15) * ST2, k2 * 32 + 4 * q, k2 * 32 + 16 + 4 * q);
          S[dt] = MFMA16(ak, vb[k2], S[dt]);
        }
    }
    SCHED_FENCE;
    __syncthreads();
    {
      const int tl = opq(threadIdx.x);
#define ST_K(i, R) { const int idx = tl + (i) * 256; const int rk = idx >> 3, ck = idx & 7; *(uint4*)(kts + rk * ST2 + ck * 8) = R; }
      ST_K(0, rb0) ST_K(1, rb1) ST_K(2, rb2) ST_K(3, rb3)
#define ST_T(i, R) { const int idx = tl + (i) * 256; const int row = idx >> 3, c = idx & 7; *(uint4*)(ats + row * ST2 + c * 8) = R; }
      ST_T(0, rb4) ST_T(1, rb5)
      if (tl < 129) scl[(cur ^ 1) * 132 + tl] = e_next;
    }
    uc0 = un0; uc1 = un1;
    __syncthreads();
  }
}

DI void phase_p5(const Params& p, int l) {
  char* const WS = opqp(p.ws);
  const int tid = opq(threadIdx.x), lane = tid & 63, w = tid >> 6;
  const u16* ZB = (const u16*)(WS + OFF_ZB);
  u16* YB = (u16*)(WS + OFF_YB);
  const float* nw = p.gdn_norm_w + l * 128;
  const int c0 = (lane & 15) * 8;
  const float4 n0 = *(const float4*)(nw + c0), n1 = *(const float4*)(nw + c0 + 4);
  const float nn[8] = {n0.x, n0.y, n0.z, n0.w, n1.x, n1.y, n1.z, n1.w};
  for (int ti = blockIdx.x * 4 + w; ti < NB * (SEQ + NMETA); ti += gridDim.x * 4) {
    const int b = ti / (SEQ + NMETA), pp = PADR + ti % (SEQ + NMETA);
    const size_t r = (size_t)b * LP + pp;
    float ov[8], zf[8], yv[8];
    unpack8(*(const uint4*)(YB + r * 1024 + 512 + lane * 8), ov);
    unpack8(*(const uint4*)(ZB + r * 512 + lane * 8), zf);
    float ss = 0.f;
#pragma unroll
    for (int j = 0; j < 8; ++j) ss += ov[j] * ov[j];
    ss += __shfl_xor(ss, 1); ss += __shfl_xor(ss, 2); ss += __shfl_xor(ss, 4); ss += __shfl_xor(ss, 8);
    const float rs = rsqrtf(ss * (1.0f / 128.0f) + RMS_EPS);
#pragma unroll
    for (int j = 0; j < 8; ++j) yv[j] = ov[j] * rs * nn[j] * siluf(zf[j]);
    *(uint4*)(YB + r * 1024 + 512 + lane * 8) = pack8(yv);
  }
}

DI void phase_ln1(const Params& p, int l) {
  char* const WS = opqp(p.ws);
  const int tid = opq(threadIdx.x), lane = tid & 63, w = tid >> 6;
  const u16* HB = (const u16*)(WS + OFF_HB);
  const u16* MIX = (const u16*)(WS + OFF_R1);
  u16* H1 = (u16*)(WS + OFF_QKV);
  float lg[16], lb[16];
  load_gb16(lg, lb, p.ln1_g + l * 1024, p.ln1_b + l * 1024, lane);
  const int gwv = blockIdx.x * 4 + w, nwv = gridDim.x * 4;
  const int rchunk = (int)(((unsigned)MR + (unsigned)nwv - 1u) / (unsigned)nwv);
  const int r_beg = min(MR, gwv * rchunk), r_end = min(MR, r_beg + rchunk);
  for (int r = r_beg; r < r_end; ++r) {
    const int pp = r % LP;
    float v[16];
    if (pp < PADR) {
#pragma unroll
      for (int i = 0; i < 16; ++i) v[i] = 0.f;
    } else {
      float hv[16];
      unpack8(*(const uint4*)(HB + (size_t)r * 1024 + lane * 16), hv);
      unpack8(*(const uint4*)(HB + (size_t)r * 1024 + lane * 16 + 8), hv + 8);
      float mv[16];
      unpack8(*(const uint4*)(MIX + (size_t)r * 1024 + lane * 16), mv);
      unpack8(*(const uint4*)(MIX + (size_t)r * 1024 + lane * 16 + 8), mv + 8);
#pragma unroll
      for (int i = 0; i < 16; ++i) v[i] = ALPHA * hv[i] + mv[i];
      ln_row16_reg(v, lg, lb);
    }
    store_row16_bf16(H1 + (size_t)r * 1024, v, lane);
  }
}

#define CE_DESC(x, y) { const u32 _hi = max(x, y); const u32 _lo = min(x, y); x = _hi; y = _lo; }
#define CE_ASC(x, y)  { const u32 _hi = max(x, y); const u32 _lo = min(x, y); x = _lo; y = _hi; }
DI void bitonic_sort16(u32* v) {
#pragma unroll
  for (int k = 2; k <= 16; k <<= 1)
#pragma unroll
    for (int j = k >> 1; j > 0; j >>= 1)
#pragma unroll
      for (int i = 0; i < 16; ++i) {
        const int l = i ^ j;
        if (l > i) { if ((i & k) == 0) CE_DESC(v[i], v[l]) else CE_ASC(v[i], v[l]) }
      }
}
DI void bitonic_merge16(u32* v) {
#pragma unroll
  for (int j = 8; j > 0; j >>= 1)
#pragma unroll
    for (int i = 0; i < 16; ++i) { const int l = i ^ j; if (l > i) CE_DESC(v[i], v[l]) }
}
DI void merge_top16(u32* a, const u32* b) {
#pragma unroll
  for (int i = 0; i < 16; ++i) a[i] = max(a[i], b[15 - i]);
  bitonic_merge16(a);
}
DI void xmerge_top16(u32* v, int mask) {
  u32 t[16];
#pragma unroll
  for (int i = 0; i < 16; ++i) t[i] = (u32)__shfl_xor((int)v[15 - i], mask);
#pragma unroll
  for (int i = 0; i < 16; ++i) v[i] = max(v[i], t[i]);
  bitonic_merge16(v);
}
DI float unorder(u32 u) { return __uint_as_float(u ^ ((u >> 31) ? 0x80000000u : 0xffffffffu)); }
__device__ __attribute__((aligned(16))) const unsigned char P6_CAND[64] = {
  0, 1, 2, 3, 4, 5, 6, 7, 8, 9, 10, 11, 12, 13, 14, 15,
  16, 17, 18, 19, 20, 21, 22, 23, 64, 65, 66, 80, 81, 128, 144, 160,
  32, 33, 34, 35, 36, 48, 49, 50, 51, 96, 97, 112, 113, 176, 192, 208,
  224, 240, 255, 255, 255, 255, 255, 255, 255, 255, 255, 255, 255, 255, 255, 255};

DI void phase_p6(const Params& p, int l, char* smem) {
  char* const WS = opqp(p.ws);
  constexpr int KST = 136;
  u16* kh = (u16*)smem;
  u32* lists = (u32*)(smem + 2 * 128 * KST * 2);
  const int tid = opq(threadIdx.x), lane = tid & 63, w = tid >> 6, l15 = lane & 15, q = lane >> 4;
  const u16* QP = (const u16*)(WS + OFF_R1);
  const u16* SK = (const u16*)(WS + OFF_SK) + (size_t)l * 2 * 16384;
  int* IDX = (int*)(WS + OFF_IDX);
  float* GATE = (float*)(WS + OFF_GATE);
  for (int idx = tid; idx < 2 * 128 * 16; idx += 256) {
    const int row = idx >> 4, c = idx & 15;
    *(uint4*)(kh + row * KST + c * 8) = *(const uint4*)(SK + row * 128 + c * 8);
  }
  __syncthreads();
  u32* mylist = lists + (w * 16 + l15) * 32;
  const uint4 cw = *(const uint4*)(P6_CAND + q * 16);
  const u32 cwv[4] = {cw.x, cw.y, cw.z, cw.w};
  const int gw = blockIdx.x * 4 + w, nw_ = gridDim.x * 4;
  for (int task = gw; task < (MR / 16) * 8; task += nw_) {
    const int tt = task >> 3, hd = task & 7;
    const size_t row = (size_t)tt * 16 + l15;
#pragma unroll
    for (int hf = 0; hf < 2; ++hf) {
      f32x4 acc[8];
#pragma unroll
      for (int i = 0; i < 8; ++i) acc[i] = (f32x4){0.f, 0.f, 0.f, 0.f};
      const u16* qrow = QP + row * 2048 + hd * 256 + hf * 128;
      const u16* khh = kh + hf * 128 * KST;
#pragma unroll
      for (int ks = 0; ks < 4; ++ks) {
        const bf16x8 aq = *(const bf16x8*)(qrow + ks * 32 + q * 8);
#pragma unroll
        for (int nt = 0; nt < 8; ++nt) {
          const bf16x8 bk = *(const bf16x8*)(khh + (nt * 16 + l15) * KST + ks * 32 + q * 8);
          acc[nt] = MFMA16(bk, aq, acc[nt]);
        }
      }
      u32 va[16], vb2[16];
#pragma unroll
      for (int nt = 0; nt < 4; ++nt)
#pragma unroll
        for (int r = 0; r < 4; ++r) {
          va[nt * 4 + r] = (orderable(acc[nt][r]) & ~127u) | (u32)(127 - (nt * 16 + 4 * q + r));
          vb2[nt * 4 + r] = (orderable(acc[nt + 4][r]) & ~127u) | (u32)(127 - ((nt + 4) * 16 + 4 * q + r));
        }
      bitonic_sort16(va);
      bitonic_sort16(vb2);
      merge_top16(va, vb2);
      xmerge_top16(va, 16);
      xmerge_top16(va, 32);
      if (q == 0) {
#pragma unroll
        for (int i = 0; i < 4; ++i) *(uint4*)(mylist + hf * 16 + i * 4) = make_uint4(va[i * 4], va[i * 4 + 1], va[i * 4 + 2], va[i * 4 + 3]);
      }
    }
    u32 vc[16];
#pragma unroll
    for (int s_ = 0; s_ < 16; ++s_) {
      const u32 ci = (cwv[s_ >> 2] >> ((s_ & 3) * 8)) & 255u;
      const bool ok = (ci != 255u);
      const u32 a_ = ok ? (ci >> 4) : 0u, b_ = ok ? (ci & 15u) : 0u;
      const float sum = unorder(mylist[a_] & ~127u) + unorder(mylist[16 + b_] & ~127u);
      vc[s_] = ok ? ((orderable(sum) & ~255u) | (255u - ci)) : 0u;
    }
    bitonic_sort16(vc);
    xmerge_top16(vc, 16);
    xmerge_top16(vc, 32);
    const float mx = unorder(vc[0] & ~255u);
    float den = 0.f;
#pragma unroll
    for (int k = 0; k < 16; ++k) den += __expf(unorder(vc[k] & ~255u) - mx);
    const float inv = 1.0f / den;
    int ex[4]; float gt[4];
#pragma unroll
    for (int j = 0; j < 4; ++j) {
      const u32 pk = (q == 0) ? vc[j] : ((q == 1) ? vc[4 + j] : ((q == 2) ? vc[8 + j] : vc[12 + j]));
      const u32 ci = 255u - (pk & 255u);
      const u32 p1 = mylist[ci >> 4], p2 = mylist[16 + (ci & 15u)];
      ex[j] = (int)((127u - (p1 & 127u)) * 128u + (127u - (p2 & 127u)));
      gt[j] = __expf(unorder(p1 & ~127u) + unorder(p2 & ~127u) - mx) * inv;
    }
    *(int4*)(IDX + row * 128 + hd * 16 + q * 4) = make_int4(ex[0], ex[1], ex[2], ex[3]);
    *(float4*)(GATE + row * 128 + hd * 16 + q * 4) = make_float4(gt[0], gt[1], gt[2], gt[3]);
  }
}

DI void phase_p7(const Params& p, int l) {
  char* const WS = opqp(p.ws);
  const int tid = opq(threadIdx.x), lane = tid & 63, w = tid >> 6;
  const u16* H1 = (const u16*)(WS + OFF_QKV);
  u16* HB = (u16*)(WS + OFF_HB);
  const char* TU = WS + OFF_TAB;
  const char* TV = TU + (size_t)16384 * 1024;
  const int* IDX = (const int*)(WS + OFF_IDX);
  const float* GATE = (const float*)(WS + OFF_GATE);
  const bool last = (l == 1);
  const int per_b = last ? SEQ : (SEQ + NMETA);
  const int ntok = NB * per_b;
  float lg[16], lb[16];
  load_gb16(lg, lb, p.ln2_g + l * 1024, p.ln2_b + l * 1024, lane);
  for (int ti = blockIdx.x * 4 + w; ti < ntok; ti += gridDim.x * 4) {
    const int b = ti / per_b, pp = (last ? 64 : PADR) + ti % per_b;
    const size_t r = (size_t)b * LP + pp;
    float x[16];
    unpack8(*(const uint4*)(H1 + r * 1024 + lane * 16), x);
    unpack8(*(const uint4*)(H1 + r * 1024 + lane * 16 + 8), x + 8);
    const int id0 = IDX[r * 128 + lane], id1 = IDX[r * 128 + 64 + lane];
    const float g0 = GATE[r * 128 + lane], g1 = GATE[r * 128 + 64 + lane];
    float d0 = 0.f, d1 = 0.f;
    for (int eb = 0; eb < 128; eb += 8) {
      uint4 ud[8];
#pragma unroll
      for (int j = 0; j < 8; ++j) {
        const int e = eb + j;
        const int id = __builtin_amdgcn_readlane((eb < 64) ? id0 : id1, e & 63);
        ud[j] = *(const uint4*)(TU + (size_t)id * 1024 + lane * 16);
      }
#pragma unroll
      for (int j = 0; j < 8; ++j) {
        float f[16]; dec_fp8x16(ud[j], f);
        float s = 0.f;
#pragma unroll
        for (int i = 0; i < 16; ++i) s += x[i] * f[i];
        s = wsum(s);
        const int e = eb + j;
        if (lane == (e & 63)) { if (eb < 64) d0 = s; else d1 = s; }
      }
    }
    float c0, c1;
    { const float a = d0 * TINV; c0 = g0 * 0.5f * a * (1.0f + erf_as(a * 0.7071067811865476f)) * TINV; }
    { const float a = d1 * TINV; c1 = g1 * 0.5f * a * (1.0f + erf_as(a * 0.7071067811865476f)) * TINV; }
    float acc[16];
#pragma unroll
    for (int i = 0; i < 16; ++i) acc[i] = 0.f;
    for (int eb = 0; eb < 128; eb += 8) {
      uint4 vd[8];
#pragma unroll
      for (int j = 0; j < 8; ++j) {
        const int e = eb + j;
        const int id = __builtin_amdgcn_readlane((eb < 64) ? id0 : id1, e & 63);
        vd[j] = *(const uint4*)(TV + (size_t)id * 1024 + lane * 16);
      }
#pragma unroll
      for (int j = 0; j < 8; ++j) {
        const int e = eb + j;
        const float cf = __int_as_float(__builtin_amdgcn_readlane(__float_as_int((eb < 64) ? c0 : c1), e & 63));
        float f[16]; dec_fp8x16(vd[j], f);
#pragma unroll
        for (int i = 0; i < 16; ++i) acc[i] += cf * f[i];
      }
    }
#pragma unroll
    for (int i = 0; i < 16; ++i) acc[i] += ALPHA * x[i];
    ln_row16_reg(acc, lg, lb);
    if (!last) {
      store_row16_bf16(HB + r * 1024, acc, lane);
    } else {
      float* o = p.out + ((size_t)b * SEQ + (pp - 64)) * 1024 + lane * 16;
#pragma unroll
      for (int i4 = 0; i4 < 4; ++i4) *(float4*)(o + i4 * 4) = make_float4(acc[i4 * 4], acc[i4 * 4 + 1], acc[i4 * 4 + 2], acc[i4 * 4 + 3]);
    }
  }
}

constexpr size_t OFF_PD = OFF_R1;
DI void p7_token(int ti, bool last, int& b, int& pp, size_t& r) {
  const int per_b = last ? SEQ : (SEQ + NMETA);
  b = ti / per_b; pp = (last ? 64 : PADR) + ti % per_b; r = (size_t)b * LP + pp;
}
DI void phase_p7a(const Params& p, int l) {
  char* const WS = opqp(p.ws);
  const int tid = opq(threadIdx.x), lane = tid & 63, w = tid >> 6;
  const int j = blockIdx.x & 7, wr = (blockIdx.x >> 3) * 4 + w, nwv = (gridDim.x >> 3) * 4;
  const u16* H1 = (const u16*)(WS + OFF_QKV);
  const char* TU = WS + OFF_TAB + j * 128 + (lane & 7) * 16;
  const int* IDX = (const int*)(WS + OFF_IDX);
  float* PD = (float*)(WS + OFF_PD) + (size_t)j * MR * 128;
  const bool last = (l == 1);
  const int ntok = NB * (last ? SEQ : (SEQ + NMETA));
  const int l7 = lane & 7, lg = lane >> 3;
#define P7A_LOADI(t, I0, I1, X0, X1, R) { int b_, pp_; p7_token(min((t), ntok - 1), last, b_, pp_, R); \
    I0 = IDX[R * 128 + lane]; I1 = IDX[R * 128 + 64 + lane]; \
    X0 = *(const uint4*)(H1 + R * 1024 + j * 128 + l7 * 16); X1 = *(const uint4*)(H1 + R * 1024 + j * 128 + l7 * 16 + 8); }
#define P7_GATHER(TAB, I0, I1, DST) { _Pragma("unroll") for (int i = 0; i < 16; ++i) { \
    const int id_ = __shfl((i < 8) ? I0 : I1, (i & 7) * 8 + lg); DST[i] = *(const uint4*)(TAB + (size_t)id_ * 1024); } }
  int idN0, idN1; uint4 xN0, xN1; size_t rN;
  uint4 ud[16]; uint4 xc0, xc1; size_t rc;
  P7A_LOADI(wr, idN0, idN1, xN0, xN1, rN)
  P7_GATHER(TU, idN0, idN1, ud)
  xc0 = xN0; xc1 = xN1; rc = rN;
  P7A_LOADI(wr + nwv, idN0, idN1, xN0, xN1, rN)
  for (int ti = wr; ti < ntok; ti += nwv) {
    uint4 udn[16];
    P7_GATHER(TU, idN0, idN1, udn)
    int idM0, idM1; uint4 xM0, xM1; size_t rM;
    P7A_LOADI(ti + 2 * nwv, idM0, idM1, xM0, xM1, rM)
    float xs[16];
    unpack8(xc0, xs); unpack8(xc1, xs + 8);
    float sel0 = 0.f, sel1 = 0.f;
#pragma unroll
    for (int i = 0; i < 16; ++i) {
      f32x2 f[8]; dec_fp8x16_v2(ud[i], f);
      f32x2 s2 = {0.f, 0.f};
#pragma unroll
      for (int c = 0; c < 8; ++c) { const f32x2 xv = {xs[2 * c], xs[2 * c + 1]}; s2 = __builtin_elementwise_fma(xv, f[c], s2); }
      float sacc = s2[0] + s2[1];
      sacc += __shfl_xor(sacc, 1); sacc += __shfl_xor(sacc, 2); sacc += __shfl_xor(sacc, 4);
      if ((i & 7) == l7) { if (i < 8) sel0 = sacc; else sel1 = sacc; }
    }
    PD[rc * 128 + 8 * l7 + lg] = sel0;
    PD[rc * 128 + 64 + 8 * l7 + lg] = sel1;
#pragma unroll
    for (int i = 0; i < 16; ++i) ud[i] = udn[i];
    xc0 = xN0; xc1 = xN1; rc = rN;
    idN0 = idM0; idN1 = idM1; xN0 = xM0; xN1 = xM1; rN = rM;
  }
}
DI void phase_p7b(const Params& p, int l) {
  char* const WS = opqp(p.ws);
  const int tid = opq(threadIdx.x), lane = tid & 63, w = tid >> 6;
  const int j = blockIdx.x & 7, wr = (blockIdx.x >> 3) * 4 + w, nwv = (gridDim.x >> 3) * 4;
  const char* TV = WS + OFF_TAB + (size_t)16384 * 1024 + j * 128 + (lane & 7) * 16;
  const int* IDX = (const int*)(WS + OFF_IDX);
  const float* GATE = (const float*)(WS + OFF_GATE);
  const float* PD = (const float*)(WS + OFF_PD);
  u16* OUTB = (u16*)(WS + OFF_YB);
  const bool last = (l == 1);
  const int ntok = NB * (last ? SEQ : (SEQ + NMETA));
  const int l7 = lane & 7, lg = lane >> 3;
#define P7B_LOADI(t, I0, I1, G0, G1, PDV, R) { int b_, pp_; p7_token(min((t), ntok - 1), last, b_, pp_, R); \
    I0 = IDX[R * 128 + lane]; I1 = IDX[R * 128 + 64 + lane]; G0 = GATE[R * 128 + lane]; G1 = GATE[R * 128 + 64 + lane]; \
    _Pragma("unroll") for (int k = 0; k < 8; ++k) { PDV[k] = PD[((size_t)k * MR + R) * 128 + lane]; PDV[8 + k] = PD[((size_t)k * MR + R) * 128 + 64 + lane]; } }
#define P7B_STAGE2(I0, I1, G0, G1, PDV, VD, CF) { \
    float d0_ = 0.f, d1_ = 0.f; _Pragma("unroll") for (int k = 0; k < 8; ++k) { d0_ += PDV[k]; d1_ += PDV[8 + k]; } \
    const float a0_ = d0_ * TINV, a1_ = d1_ * TINV; \
    const float c0_ = G0 * 0.5f * a0_ * (1.0f + erf_as(a0_ * 0.7071067811865476f)) * TINV; \
    const float c1_ = G1 * 0.5f * a1_ * (1.0f + erf_as(a1_ * 0.7071067811865476f)) * TINV; \
    _Pragma("unroll") for (int i = 0; i < 16; ++i) { const int src_ = (i & 7) * 8 + lg; \
      const int id_ = __shfl((i < 8) ? I0 : I1, src_); CF[i] = __shfl((i < 8) ? c0_ : c1_, src_); \
      VD[i] = *(const uint4*)(TV + (size_t)id_ * 1024); } }
  int idN0, idN1; float gN0, gN1; float pdN[16]; size_t rN;
  uint4 vd[16]; float cf[16]; size_t rc;
  P7B_LOADI(wr, idN0, idN1, gN0, gN1, pdN, rN)
  P7B_STAGE2(idN0, idN1, gN0, gN1, pdN, vd, cf)
  rc = rN;
  P7B_LOADI(wr + nwv, idN0, idN1, gN0, gN1, pdN, rN)
  for (int ti = wr; ti < ntok; ti += nwv) {
    uint4 vdn[16]; float cfn[16];
    P7B_STAGE2(idN0, idN1, gN0, gN1, pdN, vdn, cfn)
    int idM0, idM1; float gM0, gM1; float pdM[16]; size_t rM;
    P7B_LOADI(ti + 2 * nwv, idM0, idM1, gM0, gM1, pdM, rM)
    f32x2 acc2[8];
#pragma unroll
    for (int c = 0; c < 8; ++c) acc2[c] = (f32x2){0.f, 0.f};
#pragma unroll
    for (int i = 0; i < 16; ++i) {
      f32x2 f[8]; dec_fp8x16_v2(vd[i], f);
      const f32x2 cv = {cf[i], cf[i]};
#pragma unroll
      for (int c = 0; c < 8; ++c) acc2[c] = __builtin_elementwise_fma(cv, f[c], acc2[c]);
    }
    float acc[16];
#pragma unroll
    for (int c = 0; c < 8; ++c) { acc[2 * c] = acc2[c][0]; acc[2 * c + 1] = acc2[c][1]; }
#pragma unroll
    for (int c = 0; c < 16; ++c) { acc[c] += __shfl_xor(acc[c], 8); acc[c] += __shfl_xor(acc[c], 16); acc[c] += __shfl_xor(acc[c], 32); }
    if (lg == 0) {
      *(uint4*)(OUTB + rc * 1024 + j * 128 + l7 * 16) = pack8(acc);
      *(uint4*)(OUTB + rc * 1024 + j * 128 + l7 * 16 + 8) = pack8(acc + 8);
    }
#pragma unroll
    for (int i = 0; i < 16; ++i) { vd[i] = vdn[i]; cf[i] = cfn[i]; pdN[i] = pdM[i]; }
    rc = rN;
    idN0 = idM0; idN1 = idM1; gN0 = gM0; gN1 = gM1; rN = rM;
  }
}
DI void phase_p7c(const Params& p, int l) {
  char* const WS = opqp(p.ws);
  const int tid = opq(threadIdx.x), lane = tid & 63, w = tid >> 6;
  const u16* H1 = (const u16*)(WS + OFF_QKV);
  const u16* OUTB = (const u16*)(WS + OFF_YB);
  u16* HB = (u16*)(WS + OFF_HB);
  const bool last = (l == 1);
  const int ntok = NB * (last ? SEQ : (SEQ + NMETA));
  float lg_[16], lb_[16];
  load_gb16(lg_, lb_, p.ln2_g + l * 1024, p.ln2_b + l * 1024, lane);
  for (int ti = blockIdx.x * 4 + w; ti < ntok; ti += gridDim.x * 4) {
    int b, pp; size_t r; p7_token(ti, last, b, pp, r);
    float x[16], f[16];
    unpack8(*(const uint4*)(H1 + r * 1024 + lane * 16), x);
    unpack8(*(const uint4*)(H1 + r * 1024 + lane * 16 + 8), x + 8);
    unpack8(*(const uint4*)(OUTB + r * 1024 + lane * 16), f);
    unpack8(*(const uint4*)(OUTB + r * 1024 + lane * 16 + 8), f + 8);
#pragma unroll
    for (int i = 0; i < 16; ++i) f[i] += ALPHA * x[i];
    ln_row16_reg(f, lg_, lb_);
    if (!last) {
      store_row16_bf16(HB + r * 1024, f, lane);
    } else {
      float* o = p.out + ((size_t)b * SEQ + (pp - 64)) * 1024 + lane * 16;
#pragma unroll
      for (int i4 = 0; i4 < 4; ++i4) *(float4*)(o + i4 * 4) = make_float4(f[i4 * 4], f[i4 * 4 + 1], f[i4 * 4 + 2], f[i4 * 4 + 3]);
    }
  }
}

#define XB_TMO      128
#define XB_XCNT(j)  (256  + 64 * (j))
#define XB_XSUB(j)  (1280 + 64 * (j))
#define XB_XGEN(j)  (2304 + 64 * (j))
#define XB_TOP      3328
#define XB_TOPGEN   3392
#define XCD_BAR_WORDS 3456
#define XB_SPIN_CAP (1u << 22)
#define LAS __attribute__((address_space(3)))
DI unsigned xb_ld(unsigned* p)              { return __hip_atomic_load(p, __ATOMIC_RELAXED, __HIP_MEMORY_SCOPE_AGENT); }
DI unsigned xb_add(unsigned* p, unsigned v) { return __hip_atomic_fetch_add(p, v, __ATOMIC_RELAXED, __HIP_MEMORY_SCOPE_AGENT); }
DI unsigned xb_xcc_id() { return (unsigned)__builtin_amdgcn_s_getreg((3 << 11) | 20) & 0xFu; }
#define XB_SPIN(cond, bar) do { unsigned _sp = 0; while (cond) { __builtin_amdgcn_s_sleep(1); \
    if ((++_sp & 255u) == 0u) { if (xb_ld(&(bar)[XB_TMO])) break; if (_sp > XB_SPIN_CAP) { atomicAdd(&(bar)[XB_TMO], 1u); break; } } } } while (0)
struct XcdBarrier { unsigned* bar; unsigned x; volatile LAS unsigned* st; };
DI XcdBarrier xcd_barrier_post(unsigned* bar, volatile LAS unsigned* st) {
  XcdBarrier b; b.bar = bar; b.x = xb_xcc_id(); b.st = st;
  if (threadIdx.x == 0) (void)xb_add(&bar[XB_XCNT(b.x)], 1u);
  return b;
}
DI void xcd_barrier_complete(unsigned* bar, unsigned x, unsigned& nloc, unsigned& nx) {
  const unsigned G = gridDim.x * gridDim.y * gridDim.z;
  unsigned sum, cnt, mine, sp = 0u;
  for (;;) {
    sum = 0u; cnt = 0u; mine = 0u;
#pragma unroll
    for (unsigned j = 0; j < 16; ++j) { const unsigned c = xb_ld(&bar[XB_XCNT(j)]); sum += c; cnt += (c > 0u) ? 1u : 0u; mine = (j == x) ? c : mine; }
    if (sum == G) break;
    __builtin_amdgcn_s_sleep(1);
    if ((++sp & 255u) == 0u) { if (xb_ld(&bar[XB_TMO])) break; if (sp > XB_SPIN_CAP) { atomicAdd(&bar[XB_TMO], 1u); break; } }
  }
  nloc = mine > 0u ? mine : 1u; nx = cnt > 0u ? cnt : 1u;
}
DI void xcd_barrier(const XcdBarrier& b) {
  asm volatile("s_waitcnt vmcnt(0)" ::: "memory");
  __syncthreads();
  if (threadIdx.x == 0) {
    unsigned* bar = b.bar;
    __builtin_amdgcn_s_waitcnt(0);
    unsigned nloc = b.st[0], nx = b.st[1];
    if (nloc == 0u) { xcd_barrier_complete(bar, b.x, nloc, nx); b.st[0] = nloc; b.st[1] = nx; }
    const unsigned old = xb_add(&bar[XB_XSUB(b.x)], 1u);
    const unsigned gen = old / nloc;
    if (old + 1u == (gen + 1u) * nloc) {
      __builtin_amdgcn_fence(__ATOMIC_RELEASE, "agent");
      asm volatile("s_waitcnt vmcnt(0)" ::: "memory");
      const unsigned og = xb_add(&bar[XB_TOP], 1u);
      const unsigned tg = og / nx;
      if (og + 1u == (tg + 1u) * nx) xb_add(&bar[XB_TOPGEN], 1u);
      else XB_SPIN(xb_ld(&bar[XB_TOPGEN]) == tg, bar);
      __builtin_amdgcn_fence(__ATOMIC_ACQUIRE, "agent");
      xb_add(&bar[XB_XGEN(b.x)], 1u);
      asm volatile("s_waitcnt vmcnt(0)" ::: "memory");
    } else {
      XB_SPIN(xb_ld(&bar[XB_XGEN(b.x)]) == gen, bar);
      __builtin_amdgcn_fence(__ATOMIC_ACQUIRE, "agent");
      asm volatile("s_waitcnt vmcnt(0)" ::: "memory");
    }
  }
  __syncthreads();
}

#ifndef DUP_GEMM
#define DUP_GEMM 0
#endif
#ifndef DUP_P7
#define DUP_P7 0
#endif
#ifndef DUP_SCAN
#define DUP_SCAN 0
#endif
#ifndef DUP_P3
#define DUP_P3 0
#endif
#ifndef DUP_P6
#define DUP_P6 0
#endif
#ifndef DUP_MISC
#define DUP_MISC 0
#endif
template <int l>
DI void layer(const Params& p, char* smem, const XcdBarrier& xb) {
  for (int rep = 0; rep <= DUP_GEMM; ++rep) { gemm_phase<1>(p, OFF_HB, OFF_WIN + l * SZ_WIN1, NPROJP / 128, smem); xcd_barrier(xb); }
  for (int rep = 0; rep <= DUP_MISC; ++rep) { phase_p2(p, l, smem); xcd_barrier(xb); }
  for (int rep = 0; rep <= DUP_P3; ++rep) { phase_p3(p, smem); xcd_barrier(xb); }
  for (int rep = 0; rep <= DUP_SCAN; ++rep) { phase_scan(p, l, smem); xcd_barrier(xb); }
  phase_p5(p, l); xcd_barrier(xb);
  for (int rep = 0; rep <= DUP_GEMM; ++rep) { gemm_phase<2>(p, OFF_YB, OFF_WOUT + l * SZ_WOUT1, 8, smem); xcd_barrier(xb); }
  for (int rep = 0; rep <= DUP_MISC; ++rep) { phase_ln1(p, l); xcd_barrier(xb); }
  for (int rep = 0; rep <= DUP_GEMM; ++rep) { gemm_phase<3>(p, OFF_QKV, OFF_WQ + l * SZ_WQ1, 16, smem); xcd_barrier(xb); }
  for (int rep = 0; rep <= DUP_P6; ++rep) { phase_p6(p, l, smem); xcd_barrier(xb); }
#ifdef P7_GATHER_IC
  for (int rep = 0; rep <= DUP_P7; ++rep) { phase_p7(p, l); if (rep < DUP_P7) xcd_barrier(xb); }
#else
  phase_p7a(p, l); xcd_barrier(xb);
  phase_p7b(p, l); xcd_barrier(xb);
  phase_p7c(p, l);
#endif
}
__global__ void __launch_bounds__(256, 2) fwd_megakernel(Params p) {
  __shared__ __attribute__((aligned(16))) char smem[78848];
  cg::grid_group grid = cg::this_grid();
  if (threadIdx.x == 0) *(uint4*)(smem + 78832) = make_uint4(0u, 0u, 0u, 0u);
  __syncthreads();
  const XcdBarrier xb = xcd_barrier_post((unsigned*)(p.ws + OFF_BAR), (volatile LAS unsigned*)(smem + 78832));
  phase_prologue(p, smem);
  grid.sync();
  layer<0>(p, smem, xb);
  xcd_barrier(xb);
  layer<1>(p, smem, xb);
}

extern "C" void kernel_launch(void* const* d_in, const int* in_sizes, int n_in, void* d_out,
                              int out_size, void* d_ws, size_t ws_size, hipStream_t stream) {
  static int grid_blocks = 0;
  if (!grid_blocks) {
    int dev = 0, cus = 0, per_cu = 0;
    (void)hipGetDevice(&dev);
    (void)hipDeviceGetAttribute(&cus, hipDeviceAttributeMultiprocessorCount, dev);
    (void)hipOccupancyMaxActiveBlocksPerMultiprocessor(&per_cu, fwd_megakernel, 256, 0);
    if (per_cu > 2) per_cu = 2;
    if (per_cu < 1) per_cu = 1;
    grid_blocks = cus * per_cu;
  }
  if (ws_size < WS_NEED) { fprintf(stderr, "workspace too small\n"); return; }
  Params p{};
  p.x = (const float*)d_in[0]; p.meta = (const float*)d_in[1]; p.ln_in_g = (const float*)d_in[2]; p.ln_in_b = (const float*)d_in[3];
  p.w_in = (const float*)d_in[4]; p.conv_w = (const float*)d_in[5]; p.gdn_conv_w = (const float*)d_in[6]; p.a_log = (const float*)d_in[7];
  p.dt_bias = (const float*)d_in[8]; p.gdn_norm_w = (const float*)d_in[9]; p.w_out = (const float*)d_in[10]; p.ln1_g = (const float*)d_in[11];
  p.ln1_b = (const float*)d_in[12]; p.w_q = (const float*)d_in[13]; p.k1 = (const float*)d_in[14]; p.k2 = (const float*)d_in[15];
  p.pu = (const float*)d_in[16]; p.pv = (const float*)d_in[17]; p.ln2_g = (const float*)d_in[18]; p.ln2_b = (const float*)d_in[19];
  p.out = (float*)d_out; p.ws = (char*)d_ws;
  (void)hipMemsetAsync((char*)d_ws + OFF_BAR, 0, 16384, stream);
  void* args[] = {&p};
  hipError_t e = hipLaunchCooperativeKernel((void*)fwd_megakernel, dim3(grid_blocks), dim3(256), args, 0, stream);
  if (e != hipSuccess) fprintf(stderr, "cooperative launch failed: %s (grid %d)\n", hipGetErrorString(e), grid_blocks);
}
```

```cpp
#include <hip/hip_runtime.h>
#include <hip/hip_cooperative_groups.h>
#include <cstdio>
namespace cg = cooperative_groups;

typedef unsigned short u16;
typedef unsigned int u32;
using bf16x8 = __attribute__((ext_vector_type(8))) short;
using s16x4 = __attribute__((ext_vector_type(4))) short;
using f32x4 = __attribute__((ext_vector_type(4))) float;
using f32x2 = __attribute__((ext_vector_type(2))) float;

#define DI __device__ __forceinline__
#define MFMA16(a, b, c) __builtin_amdgcn_mfma_f32_16x16x32_bf16((a), (b), (c), 0, 0, 0)

constexpr int NB = 4, SEQ = 8192, NMETA = 16, DM = 1024;
constexpr int LP = 8256;
constexpr int PADR = 48;
constexpr int MR = NB * LP;
constexpr int NCH = 129;
constexpr int NPROJ = 3592, NPROJP = 3712;
constexpr float ALPHA = 1.4142135623730951f;
constexpr float LN_EPS = 1e-5f, RMS_EPS = 1e-6f;
constexpr float TSCALE = 64.0f, TINV = 1.0f / 64.0f;

constexpr size_t SZ_HB = (size_t)MR * 1024 * 2;
constexpr size_t OFF_HB = 0;
constexpr size_t OFF_R1 = OFF_HB + SZ_HB;
constexpr size_t SZ_R1 = (size_t)MR * 3072 * 2;
constexpr size_t OFF_ZB = OFF_R1 + SZ_R1;
constexpr size_t SZ_ZB = (size_t)MR * 512 * 2;
constexpr size_t OFF_QKV = OFF_ZB + SZ_ZB;
constexpr size_t SZ_QKV = (size_t)MR * 1536 * 2;
constexpr size_t OFF_YB = OFF_QKV + SZ_QKV;
constexpr size_t OFF_AB = OFF_YB + SZ_HB;
constexpr size_t SZ_AB = (size_t)MR * 8 * 4;
constexpr size_t OFF_GB = OFF_AB + SZ_AB;
constexpr size_t OFF_WIN = OFF_GB + SZ_AB;
constexpr size_t SZ_WIN1 = (size_t)NPROJP * 1024 * 2;
constexpr size_t OFF_WOUT = OFF_WIN + 2 * SZ_WIN1;
constexpr size_t SZ_WOUT1 = (size_t)1024 * 1024 * 2;
constexpr size_t OFF_WQ = OFF_WOUT + 2 * SZ_WOUT1;
constexpr size_t SZ_WQ1 = (size_t)2048 * 1024 * 2;
constexpr size_t OFF_SK = OFF_WQ + 2 * SZ_WQ1;
constexpr size_t SZ_SK1 = (size_t)2 * 128 * 128 * 2;
constexpr size_t OFF_BAR = OFF_SK + 2 * SZ_SK1;
constexpr size_t WS_NEED = OFF_BAR + 16384;
constexpr size_t REC_BYTES = 58368;
constexpr size_t OFF_IDX = OFF_R1 + (size_t)MR * 2048 * 2;
constexpr size_t OFF_GATE = OFF_IDX + (size_t)MR * 128 * 4;
constexpr size_t OFF_TAB = OFF_GATE + (size_t)MR * 128 * 4;
static_assert((size_t)NB * NCH * 4 * REC_BYTES <= SZ_R1, "rec");
static_assert(OFF_GATE + (size_t)MR * 128 * 4 <= OFF_R1 + SZ_R1, "idx");
static_assert(OFF_TAB + (size_t)2 * 16384 * 1024 <= OFF_R1 + SZ_R1, "tab");
static_assert(WS_NEED <= (size_t)512 * 1024 * 1024, "ws");

struct Params {
  const float* x; const float* meta; const float* ln_in_g; const float* ln_in_b;
  const float* w_in; const float* conv_w; const float* gdn_conv_w; const float* a_log; const float* dt_bias;
  const float* gdn_norm_w; const float* w_out; const float* ln1_g; const float* ln1_b;
  const float* w_q; const float* k1; const float* k2; const float* pu; const float* pv;
  const float* ln2_g; const float* ln2_b;
  float* out; char* ws;
};

DI int opq(int x) { asm volatile("" : "+v"(x)); return x; }
DI char* opqp(char* w) { long z = 0; asm volatile("" : "+s"(z)); return w + z; }
DI int opqs(int x) { asm volatile("" : "+s"(x)); return x; }
#define SCHED_FENCE __builtin_amdgcn_sched_barrier(0)
typedef __bf16 hbf16x2 __attribute__((ext_vector_type(2)));
DI u32 pack2(float a, float b) { f32x2 v = {a, b}; hbf16x2 r = __builtin_convertvector(v, hbf16x2); return __builtin_bit_cast(u32, r); }
DI u16 f2bf(float x) { return (u16)(pack2(x, 0.f) & 0xffffu); }
DI float bf2f(u16 h) { return __uint_as_float(((u32)h) << 16); }
DI float bflo(u32 w) { return __uint_as_float(w << 16); }
DI float bfhi(u32 w) { return __uint_as_float(w & 0xffff0000u); }
DI float wsum(float v) {
#pragma unroll
  for (int o = 32; o > 0; o >>= 1) v += __shfl_xor(v, o);
  return v;
}
DI float erf_as(float x) {
  const float ax = fabsf(x);
  const float t = 1.0f / (1.0f + 0.3275911f * ax);
  const float poly = t * (0.254829592f + t * (-0.284496736f + t * (1.421413741f + t * (-1.453152027f + t * 1.061405429f))));
  const float r = 1.0f - poly * __expf(-ax * ax);
  return x < 0.f ? -r : r;
}
template <int CTRL>
DI float dpp_get(float v) { return __int_as_float(__builtin_amdgcn_update_dpp(0, __float_as_int(v), CTRL, 0xF, 0xF, false)); }
DI float red8(float v) { v += dpp_get<0xB1>(v); v += dpp_get<0x4E>(v); v += dpp_get<0x141>(v); return v; }
DI int p7_pos(int s_) { return (s_ & 7) * 16 + ((s_ >> 3) & 7) + ((s_ >> 6) << 3); }
DI float siluf(float x) { return x / (1.0f + __expf(-x)); }
DI void unpack8(const uint4& v, float* f) {
  f[0] = bflo(v.x); f[1] = bfhi(v.x); f[2] = bflo(v.y); f[3] = bfhi(v.y);
  f[4] = bflo(v.z); f[5] = bfhi(v.z); f[6] = bflo(v.w); f[7] = bfhi(v.w);
}
DI uint4 pack8(const float* f) {
  uint4 v; v.x = pack2(f[0], f[1]); v.y = pack2(f[2], f[3]); v.z = pack2(f[4], f[5]); v.w = pack2(f[6], f[7]); return v;
}
DI bf16x8 pack_acc2(const f32x4& a, const f32x4& b) {
  uint4 v; v.x = pack2(a[0], a[1]); v.y = pack2(a[2], a[3]); v.z = pack2(b[0], b[1]); v.w = pack2(b[2], b[3]);
  return __builtin_bit_cast(bf16x8, v);
}
DI bf16x8 read2x4(const u16* p, int c0, int c1) {
  uint2 lo = *(const uint2*)(p + c0);
  uint2 hi = *(const uint2*)(p + c1);
  uint4 v; v.x = lo.x; v.y = lo.y; v.z = hi.x; v.w = hi.y;
  return __builtin_bit_cast(bf16x8, v);
}
DI u32 enc_fp8x4(float a, float b, float c, float d) {
  int v = 0;
  v = __builtin_amdgcn_cvt_pk_fp8_f32(a, b, v, false);
  v = __builtin_amdgcn_cvt_pk_fp8_f32(c, d, v, true);
  return (u32)v;
}
DI void dec_fp8x16(const uint4& v, float* f) {
  f32x2 t;
  t = __builtin_amdgcn_cvt_pk_f32_fp8((int)v.x, false); f[0] = t[0]; f[1] = t[1];
  t = __builtin_amdgcn_cvt_pk_f32_fp8((int)v.x, true);  f[2] = t[0]; f[3] = t[1];
  t = __builtin_amdgcn_cvt_pk_f32_fp8((int)v.y, false); f[4] = t[0]; f[5] = t[1];
  t = __builtin_amdgcn_cvt_pk_f32_fp8((int)v.y, true);  f[6] = t[0]; f[7] = t[1];
  t = __builtin_amdgcn_cvt_pk_f32_fp8((int)v.z, false); f[8] = t[0]; f[9] = t[1];
  t = __builtin_amdgcn_cvt_pk_f32_fp8((int)v.z, true);  f[10] = t[0]; f[11] = t[1];
  t = __builtin_amdgcn_cvt_pk_f32_fp8((int)v.w, false); f[12] = t[0]; f[13] = t[1];
  t = __builtin_amdgcn_cvt_pk_f32_fp8((int)v.w, true);  f[14] = t[0]; f[15] = t[1];
}
DI void dec_fp8x16_v2(const uint4& v, f32x2* f) {
  f[0] = __builtin_amdgcn_cvt_pk_f32_fp8((int)v.x, false); f[1] = __builtin_amdgcn_cvt_pk_f32_fp8((int)v.x, true);
  f[2] = __builtin_amdgcn_cvt_pk_f32_fp8((int)v.y, false); f[3] = __builtin_amdgcn_cvt_pk_f32_fp8((int)v.y, true);
  f[4] = __builtin_amdgcn_cvt_pk_f32_fp8((int)v.z, false); f[5] = __builtin_amdgcn_cvt_pk_f32_fp8((int)v.z, true);
  f[6] = __builtin_amdgcn_cvt_pk_f32_fp8((int)v.w, false); f[7] = __builtin_amdgcn_cvt_pk_f32_fp8((int)v.w, true);
}
DI u32 orderable(float f) { u32 u = __float_as_uint(f); return u ^ ((u >> 31) ? 0xffffffffu : 0x80000000u); }
#define INS16(v, xx) { u32 _x = (xx); _Pragma("unroll") for (int _i = 0; _i < 16; ++_i) { u32 _h = max(v[_i], _x); _x = min(v[_i], _x); v[_i] = _h; } }

DI void ln_row16(float* v, const float* __restrict__ g, const float* __restrict__ b, int lane) {
  float s = 0.f;
#pragma unroll
  for (int i = 0; i < 16; ++i) s += v[i];
  float mu = wsum(s) * (1.0f / 1024.0f);
  float q = 0.f;
#pragma unroll
  for (int i = 0; i < 16; ++i) { float d = v[i] - mu; q += d * d; }
  float var = wsum(q) * (1.0f / 1024.0f);
  float rs = rsqrtf(var + LN_EPS);
#pragma unroll
  for (int i4 = 0; i4 < 4; ++i4) {
    float4 gg = *(const float4*)(g + lane * 16 + i4 * 4);
    float4 bb = *(const float4*)(b + lane * 16 + i4 * 4);
    v[i4 * 4 + 0] = (v[i4 * 4 + 0] - mu) * rs * gg.x + bb.x;
    v[i4 * 4 + 1] = (v[i4 * 4 + 1] - mu) * rs * gg.y + bb.y;
    v[i4 * 4 + 2] = (v[i4 * 4 + 2] - mu) * rs * gg.z + bb.z;
    v[i4 * 4 + 3] = (v[i4 * 4 + 3] - mu) * rs * gg.w + bb.w;
  }
}
DI void load_gb16(float* g, float* b, const float* __restrict__ gp, const float* __restrict__ bp, int lane) {
#pragma unroll
  for (int i4 = 0; i4 < 4; ++i4) {
    float4 gg = *(const float4*)(gp + lane * 16 + i4 * 4);
    float4 bb = *(const float4*)(bp + lane * 16 + i4 * 4);
    g[i4 * 4] = gg.x; g[i4 * 4 + 1] = gg.y; g[i4 * 4 + 2] = gg.z; g[i4 * 4 + 3] = gg.w;
    b[i4 * 4] = bb.x; b[i4 * 4 + 1] = bb.y; b[i4 * 4 + 2] = bb.z; b[i4 * 4 + 3] = bb.w;
  }
}
DI void ln_row16_reg(float* v, const float* g, const float* b) {
  float s = 0.f;
#pragma unroll
  for (int i = 0; i < 16; ++i) s += v[i];
  const float mu = wsum(s) * (1.0f / 1024.0f);
  float q = 0.f;
#pragma unroll
  for (int i = 0; i < 16; ++i) { const float d = v[i] - mu; q += d * d; }
  const float var = wsum(q) * (1.0f / 1024.0f);
  const float rs = rsqrtf(var + LN_EPS);
#pragma unroll
  for (int i = 0; i < 16; ++i) v[i] = (v[i] - mu) * rs * g[i] + b[i];
}
DI void store_row16_bf16(u16* dst, const float* v, int lane) {
  *(uint4*)(dst + lane * 16) = pack8(v);
  *(uint4*)(dst + lane * 16 + 8) = pack8(v + 8);
}

DI void transpose_convert(const float* __restrict__ W, int K, int N, int Npad, u16* __restrict__ Wt, char* smem) {
  float* tile = (float*)smem;
  const int tid = opq(threadIdx.x);
  const int ntn = Npad / 64, ntk = K / 64;
  for (int t = blockIdx.x; t < ntn * ntk; t += gridDim.x) {
    const int n0 = (t % ntn) * 64, k0 = (t / ntn) * 64;
#pragma unroll 4
    for (int i = 0; i < 16; ++i) {
      int idx = tid + i * 256; int kk = idx >> 6, nn = idx & 63;
      float val = (n0 + nn < N) ? W[(size_t)(k0 + kk) * N + n0 + nn] : 0.f;
      tile[kk * 65 + nn] = val;
    }
    __syncthreads();
#pragma unroll 4
    for (int i = 0; i < 16; ++i) {
      int idx = tid + i * 256; int nn = idx >> 6, kk = idx & 63;
      Wt[(size_t)(n0 + nn) * K + k0 + kk] = f2bf(tile[kk * 65 + nn]);
    }
    __syncthreads();
  }
}

DI void phase_prologue(const Params& p, char* smem) {
  char* const WS = opqp(p.ws);
  const int tid = opq(threadIdx.x), lane = tid & 63, w = tid >> 6;
  u16* HB = (u16*)(WS + OFF_HB);
  float lg[16], lb[16];
  load_gb16(lg, lb, p.ln_in_g, p.ln_in_b, lane);
  for (int r = blockIdx.x * 4 + w; r < MR; r += gridDim.x * 4) {
    const int b = r / LP, pp = r % LP;
    float v[16];
    if (pp < PADR) {
#pragma unroll
      for (int i = 0; i < 16; ++i) v[i] = 0.f;
    } else {
      const float* src = (pp < 64) ? (p.meta + (size_t)(pp - PADR) * DM) : (p.x + ((size_t)b * SEQ + (pp - 64)) * DM);
#pragma unroll
      for (int i4 = 0; i4 < 4; ++i4) {
        float4 t = *(const float4*)(src + lane * 16 + i4 * 4);
        v[i4 * 4] = t.x; v[i4 * 4 + 1] = t.y; v[i4 * 4 + 2] = t.z; v[i4 * 4 + 3] = t.w;
      }
      ln_row16_reg(v, lg, lb);
    }
    store_row16_bf16(HB + (size_t)r * DM, v, lane);
  }
  for (int l = 0; l < 2; ++l) {
    transpose_convert(p.w_in + (size_t)l * 1024 * NPROJ, 1024, NPROJ, NPROJP, (u16*)(WS + OFF_WIN + l * SZ_WIN1), smem);
    transpose_convert(p.w_out + (size_t)l * 1024 * 1024, 1024, 1024, 1024, (u16*)(WS + OFF_WOUT + l * SZ_WOUT1), smem);
    transpose_convert(p.w_q + (size_t)l * 1024 * 2048, 1024, 2048, 2048, (u16*)(WS + OFF_WQ + l * SZ_WQ1), smem);
  }
  u16* SK = (u16*)(WS + OFF_SK);
  for (int i = blockIdx.x * 256 + tid; i < 2 * 2 * 16384; i += gridDim.x * 256) {
    int l = i >> 15, rem = i & 32767, hf = rem >> 14, e = rem & 16383;
    const float* src = (hf ? p.k2 : p.k1) + (size_t)l * 16384;
    SK[i] = f2bf(src[e]);
  }
}

DI void convert_tables(const Params& p, int l, int first_block) {
  char* const WS = opqp(p.ws);
  u32* TAB = (u32*)(WS + OFF_TAB);
  const size_t n16 = (size_t)2 * 16384 * 1024 / 16;
  for (size_t i = (size_t)((opqs(blockIdx.x) - first_block) * 256 + opq(threadIdx.x)); i < n16; i += (size_t)(gridDim.x - first_block) * 256) {
    const size_t e0 = i * 16;
    const int which = (int)(e0 >> 24);
    const size_t off = e0 & (((size_t)1 << 24) - 1);
    const float* src = (which ? p.pv : p.pu) + (size_t)l * 16384 * 1024 + off;
    uint4 o;
    float4 a = *(const float4*)(src), b = *(const float4*)(src + 4), c = *(const float4*)(src + 8), d = *(const float4*)(src + 12);
    o.x = enc_fp8x4(a.x * TSCALE, a.y * TSCALE, a.z * TSCALE, a.w * TSCALE);
    o.y = enc_fp8x4(b.x * TSCALE, b.y * TSCALE, b.z * TSCALE, b.w * TSCALE);
    o.z = enc_fp8x4(c.x * TSCALE, c.y * TSCALE, c.z * TSCALE, c.w * TSCALE);
    o.w = enc_fp8x4(d.x * TSCALE, d.y * TSCALE, d.z * TSCALE, d.w * TSCALE);
    *(uint4*)(TAB + i * 4) = o;
  }
}

template <int EPI>
DI void gemm_phase(const Params& p, size_t offA, size_t offB, int ntn, char* smem) {
  char* const WS = opqp(p.ws);
  const u16* __restrict__ A = (const u16*)(WS + offA);
  const u16* __restrict__ Bt = (const u16*)(WS + offB);
  constexpr int K = 1024, LDS_ST = 64;
  u16* As = (u16*)smem;
  u16* Bs = As + 2 * 128 * LDS_ST;
  const int tid = opq(threadIdx.x), lane = tid & 63, w = tid >> 6, wm = w >> 1, wn = w & 1;
  const int l15 = lane & 15, q = lane >> 4;
  const int ntm = MR / 128;
  const int T_ = ntm * ntn;
  const int NX = ((gridDim.x & 7) == 0) ? 8 : 1;
  const int xcd = blockIdx.x % NX, bi = blockIdx.x / NX, nbx = gridDim.x / NX;
  const int pbeg = (xcd * T_) / NX, pend = ((xcd + 1) * T_) / NX;
  for (int pos = pbeg + bi; pos < pend; pos += nbx) {
    const int nig = 8 * ntn, gid = pos / nig, fm = gid * 8, gsz = min(8, ntm - fm), rem = pos - gid * nig;
    const int tm = fm + rem % gsz, tn = rem / gsz;
    const u16* Ag = A + (size_t)(tm * 128) * K;
    const u16* Bg = Bt + (size_t)(tn * 128) * K;
    f32x4 acc[4][4];
#pragma unroll
    for (int i = 0; i < 4; ++i)
#pragma unroll
      for (int j = 0; j < 4; ++j) acc[i][j] = (f32x4){0.f, 0.f, 0.f, 0.f};
    uint4 a0_0, a0_1, a0_2, a0_3, b0_0, b0_1, b0_2, b0_3, a1_0, a1_1, a1_2, a1_3, b1_0, b1_1, b1_2, b1_3;
    const int lrow = tid >> 3, lc = (tid & 7) * 8;
    const int lcs = ((tid & 7) ^ ((lrow >> 1) & 7)) * 8;
    const int rsw = (l15 >> 1) & 7;
    const u16* Agl = Ag + (size_t)lrow * K + lc;
    const u16* Bgl = Bg + (size_t)lrow * K + lc;
#define G_LD(S, k0) { S##a##_0 = *(const uint4*)(Agl + (k0)); S##a##_1 = *(const uint4*)(Agl + (size_t)32 * K + (k0)); \
      S##a##_2 = *(const uint4*)(Agl + (size_t)64 * K + (k0)); S##a##_3 = *(const uint4*)(Agl + (size_t)96 * K + (k0)); \
      S##b##_0 = *(const uint4*)(Bgl + (k0)); S##b##_1 = *(const uint4*)(Bgl + (size_t)32 * K + (k0)); \
      S##b##_2 = *(const uint4*)(Bgl + (size_t)64 * K + (k0)); S##b##_3 = *(const uint4*)(Bgl + (size_t)96 * K + (k0)); }
#define G_LD0(k0) { a0_0 = *(const uint4*)(Agl + (k0)); a0_1 = *(const uint4*)(Agl + (size_t)32 * K + (k0)); \
      a0_2 = *(const uint4*)(Agl + (size_t)64 * K + (k0)); a0_3 = *(const uint4*)(Agl + (size_t)96 * K + (k0)); \
      b0_0 = *(const uint4*)(Bgl + (k0)); b0_1 = *(const uint4*)(Bgl + (size_t)32 * K + (k0)); \
      b0_2 = *(const uint4*)(Bgl + (size_t)64 * K + (k0)); b0_3 = *(const uint4*)(Bgl + (size_t)96 * K + (k0)); }
#define G_LD1(k0) { a1_0 = *(const uint4*)(Agl + (k0)); a1_1 = *(const uint4*)(Agl + (size_t)32 * K + (k0)); \
      a1_2 = *(const uint4*)(Agl + (size_t)64 * K + (k0)); a1_3 = *(const uint4*)(Agl + (size_t)96 * K + (k0)); \
      b1_0 = *(const uint4*)(Bgl + (k0)); b1_1 = *(const uint4*)(Bgl + (size_t)32 * K + (k0)); \
      b1_2 = *(const uint4*)(Bgl + (size_t)64 * K + (k0)); b1_3 = *(const uint4*)(Bgl + (size_t)96 * K + (k0)); }
#define L_ST0(buf) { u16* An_ = As + (buf) * 128 * LDS_ST + lrow * LDS_ST + lcs; u16* Bn_ = Bs + (buf) * 128 * LDS_ST + lrow * LDS_ST + lcs; \
      *(uint4*)(An_) = a0_0; *(uint4*)(An_ + 32 * LDS_ST) = a0_1; *(uint4*)(An_ + 64 * LDS_ST) = a0_2; *(uint4*)(An_ + 96 * LDS_ST) = a0_3; \
      *(uint4*)(Bn_) = b0_0; *(uint4*)(Bn_ + 32 * LDS_ST) = b0_1; *(uint4*)(Bn_ + 64 * LDS_ST) = b0_2; *(uint4*)(Bn_ + 96 * LDS_ST) = b0_3; }
#define L_ST1(buf) { u16* An_ = As + (buf) * 128 * LDS_ST + lrow * LDS_ST + lcs; u16* Bn_ = Bs + (buf) * 128 * LDS_ST + lrow * LDS_ST + lcs; \
      *(uint4*)(An_) = a1_0; *(uint4*)(An_ + 32 * LDS_ST) = a1_1; *(uint4*)(An_ + 64 * LDS_ST) = a1_2; *(uint4*)(An_ + 96 * LDS_ST) = a1_3; \
      *(uint4*)(Bn_) = b1_0; *(uint4*)(Bn_ + 32 * LDS_ST) = b1_1; *(uint4*)(Bn_ + 64 * LDS_ST) = b1_2; *(uint4*)(Bn_ + 96 * LDS_ST) = b1_3; }
#define G_COMPUTE(buf) { const u16* Ac = As + (buf) * 128 * LDS_ST; const u16* Bc = Bs + (buf) * 128 * LDS_ST; \
      _Pragma("unroll") for (int kk = 0; kk < 2; ++kk) { \
        bf16x8 af[4], bfr[4]; \
        _Pragma("unroll") for (int mt = 0; mt < 4; ++mt) af[mt] = *(const bf16x8*)(Ac + (wm * 64 + mt * 16 + l15) * LDS_ST + (((kk * 4 + q) ^ rsw) * 8)); \
        _Pragma("unroll") for (int nt = 0; nt < 4; ++nt) bfr[nt] = *(const bf16x8*)(Bc + (wn * 64 + nt * 16 + l15) * LDS_ST + (((kk * 4 + q) ^ rsw) * 8)); \
        _Pragma("unroll") for (int mt = 0; mt < 4; ++mt) \
          _Pragma("unroll") for (int nt = 0; nt < 4; ++nt) acc[mt][nt] = MFMA16(bfr[nt], af[mt], acc[mt][nt]); } }
    constexpr int nk = K / 64;
    G_LD0(0)
    L_ST0(0)
    G_LD0(64)
    __syncthreads();
    for (int kt = 0; kt < nk; kt += 2) {
      L_ST0(1)
      if (kt + 2 < nk) G_LD1((kt + 2) * 64)
      G_COMPUTE(0)
      __syncthreads();
      if (kt + 2 < nk) L_ST1(0)
      if (kt + 3 < nk) G_LD0((kt + 3) * 64)
      G_COMPUTE(1)
      __syncthreads();
    }
#pragma unroll
    for (int mt = 0; mt < 4; ++mt) {
      const size_t m = (size_t)tm * 128 + wm * 64 + mt * 16 + l15;
#pragma unroll
      for (int nt = 0; nt < 4; ++nt) {
        const int n = tn * 128 + wn * 64 + nt * 16 + q * 4;
        const f32x4 a = acc[mt][nt];
        if (EPI == 1) {
          if (tn < 24) {
            uint2 o; o.x = pack2(a[0], a[1]); o.y = pack2(a[2], a[3]);
            *(uint2*)((u16*)(WS + OFF_R1) + m * 3072 + n) = o;
          } else if (tn < 28) {
            uint2 o; o.x = pack2(a[0], a[1]); o.y = pack2(a[2], a[3]);
            *(uint2*)((u16*)(WS + OFF_ZB) + m * 512 + (n - 3072)) = o;
          } else {
            if (n - 3584 < 8) *(float4*)((float*)(WS + OFF_AB) + m * 8 + (n - 3584)) = make_float4(a[0], a[1], a[2], a[3]);
          }
        } else if (EPI == 2) {
          uint2 o; o.x = pack2(a[0], a[1]); o.y = pack2(a[2], a[3]);
          *(uint2*)((u16*)(WS + OFF_R1) + m * 1024 + n) = o;
        } else {
          uint2 o; o.x = pack2(a[0], a[1]); o.y = pack2(a[2], a[3]);
          *(uint2*)((u16*)(WS + OFF_R1) + m * 2048 + n) = o;
        }
      }
    }
  }
}

DI void phase_p2(const Params& p, int l, char* smem) {
  char* const WS = opqp(p.ws);
  const int tid = opq(threadIdx.x), lane = tid & 63, w = tid >> 6;
  float* cw = (float*)smem;
  float* gw = cw + 3 * 512;
  {
    const float* cwg = p.conv_w + (size_t)l * 3 * 512;
    const float* gwg = p.gdn_conv_w + (size_t)l * 4 * 1536;
    for (int i = tid; i < 3 * 512 / 4; i += 256) *(float4*)(cw + i * 4) = *(const float4*)(cwg + i * 4);
    for (int i = tid; i < 4 * 1536 / 4; i += 256) *(float4*)(gw + i * 4) = *(const float4*)(gwg + i * 4);
  }
  __syncthreads();
  const u16* R1 = (const u16*)(WS + OFF_R1);
  u16* QKV = (u16*)(WS + OFF_QKV);
  u16* YB = (u16*)(WS + OFF_YB);
  const float* AB = (const float*)(WS + OFF_AB);
  float* GB = (float*)(WS + OFF_GB);
  const int gwv = blockIdx.x * 4 + w, nwv = gridDim.x * 4;
  const int rchunk = (int)(((unsigned)MR + (unsigned)nwv - 1u) / (unsigned)nwv);
  const int r_beg = min(MR, gwv * rchunk), r_end = min(MR, r_beg + rchunk);
  for (int r = r_beg; r < r_end; ++r) {
    const int pp = r % LP;
    if (pp < PADR) {
      const uint4 z4 = make_uint4(0, 0, 0, 0);
#pragma unroll
      for (int i = 0; i < 3; ++i) *(uint4*)(QKV + (size_t)r * 1536 + i * 512 + lane * 8) = z4;
      *(uint4*)(YB + (size_t)r * 1024 + lane * 8) = z4;
      *(uint4*)(YB + (size_t)r * 1024 + 512 + lane * 8) = z4;
      if (lane < 8) GB[(size_t)r * 8 + lane] = 0.f;
      continue;
    }
    const int c0 = lane * 8;
    {
      float cb[8], acc[8];
      unpack8(*(const uint4*)(R1 + (size_t)r * 3072 + c0), cb);
#pragma unroll
      for (int i = 0; i < 8; ++i) acc[i] = 0.f;
#pragma unroll
      for (int j = 0; j < 3; ++j) {
        const size_t rr = (size_t)(r - 2 + j);
        float cc[8], ch[8];
        unpack8(*(const uint4*)(R1 + rr * 3072 + 512 + c0), cc);
        unpack8(*(const uint4*)(R1 + rr * 3072 + 1024 + c0), ch);
        float4 w0 = *(const float4*)(cw + j * 512 + c0), w1 = *(const float4*)(cw + j * 512 + c0 + 4);
        const float ww[8] = {w0.x, w0.y, w0.z, w0.w, w1.x, w1.y, w1.z, w1.w};
#pragma unroll
        for (int i = 0; i < 8; ++i) acc[i] += ww[i] * (cc[i] * ch[i]);
      }
#pragma unroll
      for (int i = 0; i < 8; ++i) acc[i] *= cb[i];
      *(uint4*)(YB + (size_t)r * 1024 + c0) = pack8(acc);
    }
#pragma unroll
    for (int part = 0; part < 3; ++part) {
      const int c = part * 512 + c0;
      float acc[8];
#pragma unroll
      for (int i = 0; i < 8; ++i) acc[i] = 0.f;
#pragma unroll
      for (int j = 0; j < 4; ++j) {
        const size_t rr = (size_t)(r - 3 + j);
        float xv[8];
        unpack8(*(const uint4*)(R1 + rr * 3072 + 1536 + c), xv);
        float4 w0 = *(const float4*)(gw + j * 1536 + c), w1 = *(const float4*)(gw + j * 1536 + c + 4);
        const float ww[8] = {w0.x, w0.y, w0.z, w0.w, w1.x, w1.y, w1.z, w1.w};
#pragma unroll
        for (int i = 0; i < 8; ++i) acc[i] += ww[i] * xv[i];
      }
      float ss = 0.f;
#pragma unroll
      for (int i = 0; i < 8; ++i) { acc[i] = siluf(acc[i]); ss += acc[i] * acc[i]; }
      if (part < 2) {
        ss += __shfl_xor(ss, 1); ss += __shfl_xor(ss, 2); ss += __shfl_xor(ss, 4); ss += __shfl_xor(ss, 8);
        float sc = rsqrtf(ss + RMS_EPS);
        if (part == 0) sc *= 0.08838834764831845f;
#pragma unroll
        for (int i = 0; i < 8; ++i) acc[i] *= sc;
      }
      *(uint4*)(QKV + (size_t)r * 1536 + c) = pack8(acc);
    }
    if (lane < 4) {
      const float a = AB[(size_t)r * 8 + lane], bb = AB[(size_t)r * 8 + 4 + lane];
      const float xx = a + p.dt_bias[l * 4 + lane];
      const float tt = __expf(-fabsf(xx));
      const float l1p = (tt < 0.01f) ? tt * (1.0f - tt * (0.5f - tt * 0.33333333f)) : __logf(1.0f + tt);
      const float sp = fmaxf(xx, 0.f) + l1p;
      GB[(size_t)r * 8 + lane] = -__expf(p.a_log[l * 4 + lane]) * sp;
      GB[(size_t)r * 8 + 4 + lane] = 1.0f / (1.0f + __expf(-bb));
    }
  }
}

DI void phase_p3(const Params& p, char* smem) {
  char* const WS = opqp(p.ws);
  constexpr int ST = 136, AST = 68;
  u16* kb = (u16*)smem;
  u16* qb = kb + 64 * ST;
  u16* kbb = qb + 64 * ST;
  float* As = (float*)(kbb + 64 * ST);
  float* s_gc = As + 64 * AST;
  float* s_bt = s_gc + 64;
  const int tid = opq(threadIdx.x), lane = tid & 63, w = tid >> 6, l15 = lane & 15, q = lane >> 4;
  const u16* QKV = (const u16*)(WS + OFF_QKV);
  const float* GB = (const float*)(WS + OFF_GB);
  for (int task = blockIdx.x; task < NB * NCH * 4; task += gridDim.x) {
    const int h = task & 3, bn = task >> 2, b = bn / NCH, n = bn % NCH;
    const size_t row0 = (size_t)b * LP + (size_t)n * 64;
    char* rec = WS + OFF_R1 + (size_t)task * REC_BYTES;
    u16* rec_u = (u16*)rec; u16* rec_w = rec_u + 8192; u16* rec_kT = rec_w + 8192; u16* rec_at = rec_kT + 8192;
    float* rec_eg = (float*)(rec + 57344); float* rec_egl = rec_eg + 64; float* rec_gl = rec_egl + 64;
    const int npad = (n == 0) ? PADR : 0;
    if (tid < 64) {
      const bool pad = tid < npad;
      float g = pad ? 0.f : GB[(row0 + tid) * 8 + h];
      float bt = pad ? 0.f : GB[(row0 + tid) * 8 + 4 + h];
#pragma unroll
      for (int o = 1; o < 64; o <<= 1) { float t = __shfl_up(g, o); if (lane >= o) g += t; }
      s_gc[tid] = g; s_bt[tid] = bt;
      const float gl = __shfl(g, 63);
      rec_eg[tid] = __expf(g);
      rec_egl[tid] = __expf(gl - g);
      if (tid == 0) rec_gl[0] = __expf(gl);
    }
    __syncthreads();
#pragma unroll
    for (int i = 0; i < 4; ++i) {
      int idx = tid + i * 256; int row = idx >> 4, c = idx & 15;
      uint4 kv = make_uint4(0, 0, 0, 0), qv = make_uint4(0, 0, 0, 0);
      if (row >= npad) {
        kv = *(const uint4*)(QKV + (row0 + row) * 1536 + 512 + h * 128 + c * 8);
        qv = *(const uint4*)(QKV + (row0 + row) * 1536 + h * 128 + c * 8);
      }
      *(uint4*)(kb + row * ST + c * 8) = kv;
      *(uint4*)(qb + row * ST + c * 8) = qv;
      float kf[8]; unpack8(kv, kf);
      const float bt = s_bt[row];
#pragma unroll
      for (int j = 0; j < 8; ++j) kf[j] *= bt;
      *(uint4*)(kbb + row * ST + c * 8) = pack8(kf);
    }
    __syncthreads();
#pragma unroll
    for (int it = 0; it < 4; ++it) {
      int idx = tid + it * 256; int d = idx >> 3, i8 = idx & 7;
      u32 t[4];
#pragma unroll
      for (int jj = 0; jj < 4; ++jj) t[jj] = (u32)kb[(i8 * 8 + 2 * jj) * ST + d] | ((u32)kb[(i8 * 8 + 2 * jj + 1) * ST + d] << 16);
      *(uint4*)(rec_kT + d * 64 + i8 * 8) = make_uint4(t[0], t[1], t[2], t[3]);
    }
    {
      const int mat = w >> 1;
      const u16* src = mat ? qb : kbb;
      f32x4 acc[2][4];
#pragma unroll
      for (int i = 0; i < 2; ++i)
#pragma unroll
        for (int j = 0; j < 4; ++j) acc[i][j] = (f32x4){0.f, 0.f, 0.f, 0.f};
#pragma unroll
      for (int ks = 0; ks < 4; ++ks) {
        bf16x8 a[2], bb[4];
#pragma unroll
        for (int mi = 0; mi < 2; ++mi) a[mi] = *(const bf16x8*)(src + (((w & 1) * 2 + mi) * 16 + l15) * ST + ks * 32 + q * 8);
#pragma unroll
        for (int nt = 0; nt < 4; ++nt) bb[nt] = *(const bf16x8*)(kb + (nt * 16 + l15) * ST + ks * 32 + q * 8);
#pragma unroll
        for (int mi = 0; mi < 2; ++mi)
#pragma unroll
          for (int nt = 0; nt < 4; ++nt) acc[mi][nt] = MFMA16(a[mi], bb[nt], acc[mi][nt]);
      }
#pragma unroll
      for (int mi = 0; mi < 2; ++mi)
#pragma unroll
        for (int nt = 0; nt < 4; ++nt)
#pragma unroll
          for (int r = 0; r < 4; ++r) {
            const int i = ((w & 1) * 2 + mi) * 16 + q * 4 + r, j = nt * 16 + l15;
            const float dec = __expf(s_gc[i] - s_gc[j]);
            if (mat == 0) As[i * AST + j] = (i > j) ? acc[mi][nt][r] * dec : 0.f;
            else rec_at[i * 64 + j] = f2bf((i >= j) ? acc[mi][nt][r] * dec : 0.f);
          }
    }
    __syncthreads();
    {
      const int mat = tid >> 7, c = tid & 127;
      float x[64];
      if (mat == 0) {
#pragma unroll
        for (int i = 0; i < 64; ++i) {
          const float vv = (i >= npad) ? bf2f(QKV[(row0 + i) * 1536 + 1024 + h * 128 + c]) : 0.f;
          x[i] = vv * s_bt[i];
        }
      } else {
#pragma unroll
        for (int i = 0; i < 64; ++i) x[i] = bf2f(kb[i * ST + c]) * s_bt[i] * __expf(s_gc[i]);
      }
#pragma unroll
      for (int i = 1; i < 64; ++i) {
        float s = x[i];
#pragma unroll
        for (int j4 = 0; j4 < (i + 3) / 4; ++j4) {
          const float4 a = *(const float4*)(As + i * AST + j4 * 4);
          s -= a.x * x[j4 * 4 + 0];
          if (j4 * 4 + 1 < i) s -= a.y * x[j4 * 4 + 1];
          if (j4 * 4 + 2 < i) s -= a.z * x[j4 * 4 + 2];
          if (j4 * 4 + 3 < i) s -= a.w * x[j4 * 4 + 3];
        }
        x[i] = s;
        if ((i & 3) == 3) SCHED_FENCE;
      }
      if (mat) {
#pragma unroll
        for (int i = 0; i < 64; ++i) rec_w[i * 128 + c] = f2bf(x[i]);
      } else {
        const int ug = c >> 4, ul = c & 15;
#pragma unroll
        for (int mt = 0; mt < 4; ++mt)
#pragma unroll
          for (int qq = 0; qq < 4; ++qq) {
            const int i0 = mt * 16 + qq * 4;
            uint2 o; o.x = pack2(x[i0], x[i0 + 1]); o.y = pack2(x[i0 + 2], x[i0 + 3]);
            *(uint2*)(rec_u + ((ug * 64 + qq * 16 + ul) * 16 + mt * 4)) = o;
          }
      }
    }
    __syncthreads();
  }
}

DI void phase_scan(const Params& p, int l, char* smem) {
  char* const WS = opqp(p.ws);
  if (blockIdx.x >= 32) { convert_tables(p, l, 32); return; }
  constexpr int ST = 136, ST2 = 72;
  u16* ws_ = (u16*)smem;
  u16* qs_ = ws_ + 64 * ST;
  u16* kts = qs_ + 64 * ST;
  u16* ats = kts + 128 * ST2;
  float* scl = (float*)(ats + 64 * ST2);
  const int tid = opq(threadIdx.x), lane = tid & 63, w = tid >> 6, l15 = lane & 15, q = lane >> 4;
  const int b = blockIdx.x >> 3, h = (blockIdx.x >> 1) & 3, half = blockIdx.x & 1;
  const u16* QKV = (const u16*)(WS + OFF_QKV);
  u16* YB = (u16*)(WS + OFF_YB);
  const int uoff = ((half * 4 + w) * 64 + lane) * 16;
  f32x4 S[8];
#pragma unroll
  for (int i = 0; i < 8; ++i) S[i] = (f32x4){0.f, 0.f, 0.f, 0.f};
  uint4 uc0, uc1;
  {
    const int task = ((b * NCH) << 2) + h;
    const size_t row0 = (size_t)b * LP;
    const char* rec = WS + OFF_R1 + (size_t)task * REC_BYTES;
    const u16* rec_u = (const u16*)rec; const u16* rec_w = rec_u + 8192; const u16* rec_kT = rec_w + 8192; const u16* rec_at = rec_kT + 8192;
    const float* rec_eg = (const float*)(rec + 57344);
#pragma unroll
    for (int i = 0; i < 4; ++i) {
      int idx = tid + i * 256; int row = idx >> 4, c = idx & 15;
      *(uint4*)(ws_ + row * ST + c * 8) = *(const uint4*)(rec_w + row * 128 + c * 8);
      *(uint4*)(qs_ + row * ST + c * 8) = *(const uint4*)(QKV + (row0 + row) * 1536 + h * 128 + c * 8);
      int rk = idx >> 3, ck = idx & 7;
      *(uint4*)(kts + rk * ST2 + ck * 8) = *(const uint4*)(rec_kT + rk * 64 + ck * 8);
    }
#pragma unroll
    for (int i = 0; i < 2; ++i) { int idx = tid + i * 256; int row = idx >> 3, c = idx & 7; *(uint4*)(ats + row * ST2 + c * 8) = *(const uint4*)(rec_at + row * 64 + c * 8); }
    if (tid < 129) scl[tid] = rec_eg[tid];
    uc0 = *(const uint4*)(rec_u + uoff); uc1 = *(const uint4*)(rec_u + uoff + 8);
  }
  __syncthreads();
  for (int n = 0; n < NCH; ++n) {
    const int cur = n & 1;
    const bool has_next = (n + 1 < NCH);
    const size_t row0 = (size_t)b * LP + (size_t)n * 64;
    const int taskn = ((b * NCH + (has_next ? n + 1 : n)) << 2) + h;
    const char* recn = WS + OFF_R1 + (size_t)taskn * REC_BYTES;
    const u16* recn_u = (const u16*)recn; const u16* recn_w = recn_u + 8192; const u16* recn_kT = recn_w + 8192; const u16* recn_at = recn_kT + 8192;
    const float* recn_eg = (const float*)(recn + 57344);
    const size_t row0n = has_next ? row0 + 64 : row0;
    const float* egs = scl + cur * 132;
    const float* egls = egs + 64;
    uint4 ra0, ra1, ra2, ra3, ra4, ra5, ra6, ra7;
    {
      const int tl = opq(threadIdx.x);
#define LD_A(i, RW, RQ) { const int idx = tl + (i) * 256; const int row = idx >> 4, c = idx & 15; \
        RW = *(const uint4*)(recn_w + row * 128 + c * 8); RQ = *(const uint4*)(QKV + (row0n + row) * 1536 + h * 128 + c * 8); }
      LD_A(0, ra0, ra4) LD_A(1, ra1, ra5) LD_A(2, ra2, ra6) LD_A(3, ra3, ra7)
    }
    f32x4 P[4], O[4];
#pragma unroll
    for (int i = 0; i < 4; ++i) { P[i] = O[i] = (f32x4){0.f, 0.f, 0.f, 0.f}; }
#pragma unroll
    for (int ks = 0; ks < 4; ++ks) {
      const bf16x8 sb0 = pack_acc2(S[2 * ks], S[2 * ks + 1]);
#pragma unroll
      for (int mt = 0; mt < 4; ++mt) {
        const bf16x8 aw = read2x4(ws_ + (mt * 16 + l15) * ST, ks * 32 + 4 * q, ks * 32 + 16 + 4 * q);
        const bf16x8 aq = read2x4(qs_ + (mt * 16 + l15) * ST, ks * 32 + 4 * q, ks * 32 + 16 + 4 * q);
        P[mt] = MFMA16(aw, sb0, P[mt]);
        O[mt] = MFMA16(aq, sb0, O[mt]);
      }
    }
    {
      const u32 uw_[8] = {uc0.x, uc0.y, uc0.z, uc0.w, uc1.x, uc1.y, uc1.z, uc1.w};
#pragma unroll
      for (int mt = 0; mt < 4; ++mt)
#pragma unroll
        for (int r = 0; r < 4; ++r) {
          const int i = mt * 16 + 4 * q + r;
          const int ui = mt * 4 + r;
          const float uv = (ui & 1) ? bfhi(uw_[ui >> 1]) : bflo(uw_[ui >> 1]);
          P[mt][r] = uv - P[mt][r];
          O[mt][r] *= egs[i];
        }
    }
    SCHED_FENCE;
    __syncthreads();
    uint4 rb0, rb1, rb2, rb3, rb4, rb5, un0, un1;
    float e_next = 0.f;
    {
      const int tl = opq(threadIdx.x);
#define ST_A(i, RW, RQ) { const int idx = tl + (i) * 256; const int row = idx >> 4, c = idx & 15; \
        *(uint4*)(ws_ + row * ST + c * 8) = RW; *(uint4*)(qs_ + row * ST + c * 8) = RQ; }
      ST_A(0, ra0, ra4) ST_A(1, ra1, ra5) ST_A(2, ra2, ra6) ST_A(3, ra3, ra7)
#define LD_K(i, R) { const int idx = tl + (i) * 256; const int rk = idx >> 3, ck = idx & 7; R = *(const uint4*)(recn_kT + rk * 64 + ck * 8); }
      LD_K(0, rb0) LD_K(1, rb1) LD_K(2, rb2) LD_K(3, rb3)
#define LD_T(i, R) { const int idx = tl + (i) * 256; const int row = idx >> 3, c = idx & 7; R = *(const uint4*)(recn_at + row * 64 + c * 8); }
      LD_T(0, rb4) LD_T(1, rb5)
      un0 = *(const uint4*)(recn_u + uoff);
      un1 = *(const uint4*)(recn_u + uoff + 8);
      if (tl < 129) e_next = recn_eg[tl];
    }
    {
      bf16x8 vb[2];
#pragma unroll
      for (int k2 = 0; k2 < 2; ++k2) vb[k2] = pack_acc2(P[2 * k2], P[2 * k2 + 1]);
#pragma unroll
      for (int k2 = 0; k2 < 2; ++k2)
#pragma unroll
        for (int mt = 0; mt < 4; ++mt) {
          const bf16x8 aa = read2x4(ats + (mt * 16 + l15) * ST2, k2 * 32 + 4 * q, k2 * 32 + 16 + 4 * q);
          O[mt] = MFMA16(aa, vb[k2], O[mt]);
        }
    }
    {
      const int npad = (n == 0) ? PADR : 0;
      u16* yp = YB + (row0 + 4 * q) * 1024 + 512 + h * 128 + half * 64 + w * 16 + l15;
#pragma unroll
      for (int mt = 0; mt < 4; ++mt)
#pragma unroll
        for (int r = 0; r < 4; ++r)
          if (mt * 16 + 4 * q + r >= npad) yp[(mt * 16 + r) * 1024] = f2bf(O[mt][r]);
    }
    {
#pragma unroll
      for (int mt = 0; mt < 4; ++mt)
#pragma unroll
        for (int r = 0; r < 4; ++r) P[mt][r] *= egls[mt * 16 + 4 * q + r];
      bf16x8 vb[2];
#pragma unroll
      for (int k2 = 0; k2 < 2; ++k2) vb[k2] = pack_acc2(P[2 * k2], P[2 * k2 + 1]);
      const float egl = egs[128];
#pragma unroll
      for (int dt = 0; dt < 8; ++dt) S[dt] *= egl;
#pragma unroll
      for (int k2 = 0; k2 < 2; ++k2)
#pragma unroll
        for (int dt = 0; dt < 8; ++dt) {
          const bf16x8 ak = read2x4(kts + (dt * 16 + l15) * ST2, k2 * 32 + 4 * q, k2 * 32 + 16 + 4 * q);
          S[dt] = MFMA16(ak, vb[k2], S[dt]);
        }
    }
    SCHED_FENCE;
    __syncthreads();
    {
      const int tl = opq(threadIdx.x);
#define ST_K(i, R) { const int idx = tl + (i) * 256; const int rk = idx >> 3, ck = idx & 7; *(uint4*)(kts + rk * ST2 + ck * 8) = R; }
      ST_K(0, rb0) ST_K(1, rb1) ST_K(2, rb2) ST_K(3, rb3)
#define ST_T(i, R) { const int idx = tl + (i) * 256; const int row = idx >> 3, c = idx & 7; *(uint4*)(ats + row * ST2 + c * 8) = R; }
      ST_T(0, rb4) ST_T(1, rb5)
      if (tl < 129) scl[(cur ^ 1) * 132 + tl] = e_next;
    }
    uc0 = un0; uc1 = un1;
    __syncthreads();
  }
}

DI void phase_p5(const Params& p, int l) {
  char* const WS = opqp(p.ws);
  const int tid = opq(threadIdx.x), lane = tid & 63, w = tid >> 6;
  const u16* ZB = (const u16*)(WS + OFF_ZB);
  u16* YB = (u16*)(WS + OFF_YB);
  const float* nw = p.gdn_norm_w + l * 128;
  const int c0 = (lane & 15) * 8;
  const float4 n0 = *(const float4*)(nw + c0), n1 = *(const float4*)(nw + c0 + 4);
  const float nn[8] = {n0.x, n0.y, n0.z, n0.w, n1.x, n1.y, n1.z, n1.w};
  for (int ti = blockIdx.x * 4 + w; ti < NB * (SEQ + NMETA); ti += gridDim.x * 4) {
    const int b = ti / (SEQ + NMETA), pp = PADR + ti % (SEQ + NMETA);
    const size_t r = (size_t)b * LP + pp;
    float ov[8], zf[8], yv[8];
    unpack8(*(const uint4*)(YB + r * 1024 + 512 + lane * 8), ov);
    unpack8(*(const uint4*)(ZB + r * 512 + lane * 8), zf);
    float ss = 0.f;
#pragma unroll
    for (int j = 0; j < 8; ++j) ss += ov[j] * ov[j];
    ss += __shfl_xor(ss, 1); ss += __shfl_xor(ss, 2); ss += __shfl_xor(ss, 4); ss += __shfl_xor(ss, 8);
    const float rs = rsqrtf(ss * (1.0f / 128.0f) + RMS_EPS);
#pragma unroll
    for (int j = 0; j < 8; ++j) yv[j] = ov[j] * rs * nn[j] * siluf(zf[j]);
    *(uint4*)(YB + r * 1024 + 512 + lane * 8) = pack8(yv);
  }
}

DI void phase_ln1(const Params& p, int l) {
  char* const WS = opqp(p.ws);
  const int tid = opq(threadIdx.x), lane = tid & 63, w = tid >> 6;
  const u16* HB = (const u16*)(WS + OFF_HB);
  const u16* MIX = (const u16*)(WS + OFF_R1);
  u16* H1 = (u16*)(WS + OFF_QKV);
  float lg[16], lb[16];
  load_gb16(lg, lb, p.ln1_g + l * 1024, p.ln1_b + l * 1024, lane);
  const int gwv = blockIdx.x * 4 + w, nwv = gridDim.x * 4;
  const int rchunk = (int)(((unsigned)MR + (unsigned)nwv - 1u) / (unsigned)nwv);
  const int r_beg = min(MR, gwv * rchunk), r_end = min(MR, r_beg + rchunk);
  for (int r = r_beg; r < r_end; ++r) {
    const int pp = r % LP;
    float v[16];
    if (pp < PADR) {
#pragma unroll
      for (int i = 0; i < 16; ++i) v[i] = 0.f;
    } else {
      float hv[16];
      unpack8(*(const uint4*)(HB + (size_t)r * 1024 + lane * 16), hv);
      unpack8(*(const uint4*)(HB + (size_t)r * 1024 + lane * 16 + 8), hv + 8);
      float mv[16];
      unpack8(*(const uint4*)(MIX + (size_t)r * 1024 + lane * 16), mv);
      unpack8(*(const uint4*)(MIX + (size_t)r * 1024 + lane * 16 + 8), mv + 8);
#pragma unroll
      for (int i = 0; i < 16; ++i) v[i] = ALPHA * hv[i] + mv[i];
      ln_row16_reg(v, lg, lb);
    }
    store_row16_bf16(H1 + (size_t)r * 1024, v, lane);
  }
}

#define CE_DESC(x, y) { const u32 _hi = max(x, y); const u32 _lo = min(x, y); x = _hi; y = _lo; }
#define CE_ASC(x, y)  { const u32 _hi = max(x, y); const u32 _lo = min(x, y); x = _lo; y = _hi; }
DI void bitonic_sort16(u32* v) {
#pragma unroll
  for (int k = 2; k <= 16; k <<= 1)
#pragma unroll
    for (int j = k >> 1; j > 0; j >>= 1)
#pragma unroll
      for (int i = 0; i < 16; ++i) {
        const int l = i ^ j;
        if (l > i) { if ((i & k) == 0) CE_DESC(v[i], v[l]) else CE_ASC(v[i], v[l]) }
      }
}
DI void bitonic_merge16(u32* v) {
#pragma unroll
  for (int j = 8; j > 0; j >>= 1)
#pragma unroll
    for (int i = 0; i < 16; ++i) { const int l = i ^ j; if (l > i) CE_DESC(v[i], v[l]) }
}
DI void merge_top16(u32* a, const u32* b) {
#pragma unroll
  for (int i = 0; i < 16; ++i) a[i] = max(a[i], b[15 - i]);
  bitonic_merge16(a);
}
DI void xmerge_top16(u32* v, int mask) {
  u32 t[16];
#pragma unroll
  for (int i = 0; i < 16; ++i) t[i] = (u32)__shfl_xor((int)v[15 - i], mask);
#pragma unroll
  for (int i = 0; i < 16; ++i) v[i] = max(v[i], t[i]);
  bitonic_merge16(v);
}
DI float unorder(u32 u) { return __uint_as_float(u ^ ((u >> 31) ? 0x80000000u : 0xffffffffu)); }
__device__ __attribute__((aligned(16))) const unsigned char P6_CAND[64] = {
  0, 1, 2, 3, 4, 5, 6, 7, 8, 9, 10, 11, 12, 13, 14, 15,
  16, 17, 18, 19, 20, 21, 22, 23, 64, 65, 66, 80, 81, 128, 144, 160,
  32, 33, 34, 35, 36, 48, 49, 50, 51, 96, 97, 112, 113, 176, 192, 208,
  224, 240, 255, 255, 255, 255, 255, 255, 255, 255, 255, 255, 255, 255, 255, 255};

DI void phase_p6(const Params& p, int l, char* smem) {
  char* const WS = opqp(p.ws);
  constexpr int KST = 136;
  u16* kh = (u16*)smem;
  u32* lists = (u32*)(smem + 2 * 128 * KST * 2);
  const int tid = opq(threadIdx.x), lane = tid & 63, w = tid >> 6, l15 = lane & 15, q = lane >> 4;
  const u16* QP = (const u16*)(WS + OFF_R1);
  const u16* SK = (const u16*)(WS + OFF_SK) + (size_t)l * 2 * 16384;
  int* IDX = (int*)(WS + OFF_IDX);
  float* GATE = (float*)(WS + OFF_GATE);
  for (int idx = tid; idx < 2 * 128 * 16; idx += 256) {
    const int row = idx >> 4, c = idx & 15;
    *(uint4*)(kh + row * KST + c * 8) = *(const uint4*)(SK + row * 128 + c * 8);
  }
  __syncthreads();
  u32* mylist = lists + (w * 16 + l15) * 32;
  const uint4 cw = *(const uint4*)(P6_CAND + q * 16);
  const u32 cwv[4] = {cw.x, cw.y, cw.z, cw.w};
  const int gw = blockIdx.x * 4 + w, nw_ = gridDim.x * 4;
  for (int task = gw; task < (MR / 16) * 8; task += nw_) {
    const int tt = task >> 3, hd = task & 7;
    const size_t row = (size_t)tt * 16 + l15;
#pragma unroll
    for (int hf = 0; hf < 2; ++hf) {
      f32x4 acc[8];
#pragma unroll
      for (int i = 0; i < 8; ++i) acc[i] = (f32x4){0.f, 0.f, 0.f, 0.f};
      const u16* qrow = QP + row * 2048 + hd * 256 + hf * 128;
      const u16* khh = kh + hf * 128 * KST;
#pragma unroll
      for (int ks = 0; ks < 4; ++ks) {
        const bf16x8 aq = *(const bf16x8*)(qrow + ks * 32 + q * 8);
#pragma unroll
        for (int nt = 0; nt < 8; ++nt) {
          const bf16x8 bk = *(const bf16x8*)(khh + (nt * 16 + l15) * KST + ks * 32 + q * 8);
          acc[nt] = MFMA16(bk, aq, acc[nt]);
        }
      }
      u32 va[16], vb2[16];
#pragma unroll
      for (int nt = 0; nt < 4; ++nt)
#pragma unroll
        for (int r = 0; r < 4; ++r) {
          va[nt * 4 + r] = (orderable(acc[nt][r]) & ~127u) | (u32)(127 - (nt * 16 + 4 * q + r));
          vb2[nt * 4 + r] = (orderable(acc[nt + 4][r]) & ~127u) | (u32)(127 - ((nt + 4) * 16 + 4 * q + r));
        }
      bitonic_sort16(va);
      bitonic_sort16(vb2);
      merge_top16(va, vb2);
      xmerge_top16(va, 16);
      xmerge_top16(va, 32);
      if (q == 0) {
#pragma unroll
        for (int i = 0; i < 4; ++i) *(uint4*)(mylist + hf * 16 + i * 4) = make_uint4(va[i * 4], va[i * 4 + 1], va[i * 4 + 2], va[i * 4 + 3]);
      }
    }
    u32 vc[16];
#pragma unroll
    for (int s_ = 0; s_ < 16; ++s_) {
      const u32 ci = (cwv[s_ >> 2] >> ((s_ & 3) * 8)) & 255u;
      const bool ok = (ci != 255u);
      const u32 a_ = ok ? (ci >> 4) : 0u, b_ = ok ? (ci & 15u) : 0u;
      const float sum = unorder(mylist[a_] & ~127u) + unorder(mylist[16 + b_] & ~127u);
      vc[s_] = ok ? ((orderable(sum) & ~255u) | (255u - ci)) : 0u;
    }
    bitonic_sort16(vc);
    xmerge_top16(vc, 16);
    xmerge_top16(vc, 32);
    const float mx = unorder(vc[0] & ~255u);
    float den = 0.f;
#pragma unroll
    for (int k = 0; k < 16; ++k) den += __expf(unorder(vc[k] & ~255u) - mx);
    const float inv = 1.0f / den;
    int ex[4]; float gt[4];
#pragma unroll
    for (int j = 0; j < 4; ++j) {
      const u32 pk = (q == 0) ? vc[j] : ((q == 1) ? vc[4 + j] : ((q == 2) ? vc[8 + j] : vc[12 + j]));
      const u32 ci = 255u - (pk & 255u);
      const u32 p1 = mylist[ci >> 4], p2 = mylist[16 + (ci & 15u)];
      ex[j] = (int)((127u - (p1 & 127u)) * 128u + (127u - (p2 & 127u)));
      gt[j] = __expf(unorder(p1 & ~127u) + unorder(p2 & ~127u) - mx) * inv;
    }
#pragma unroll
    for (int j = 0; j < 4; ++j) {
      const int ps = p7_pos(hd * 16 + q * 4 + j);
      IDX[row * 128 + ps] = ex[j];
      GATE[row * 128 + ps] = gt[j];
    }
  }
}

DI void phase_p7(const Params& p, int l) {
  char* const WS = opqp(p.ws);
  const int tid = opq(threadIdx.x), lane = tid & 63, w = tid >> 6;
  const u16* H1 = (const u16*)(WS + OFF_QKV);
  u16* HB = (u16*)(WS + OFF_HB);
  const char* TU = WS + OFF_TAB;
  const char* TV = TU + (size_t)16384 * 1024;
  const int* IDX = (const int*)(WS + OFF_IDX);
  const float* GATE = (const float*)(WS + OFF_GATE);
  const bool last = (l == 1);
  const int per_b = last ? SEQ : (SEQ + NMETA);
  const int ntok = NB * per_b;
  float lg[16], lb[16];
  load_gb16(lg, lb, p.ln2_g + l * 1024, p.ln2_b + l * 1024, lane);
  for (int ti = blockIdx.x * 4 + w; ti < ntok; ti += gridDim.x * 4) {
    const int b = ti / per_b, pp = (last ? 64 : PADR) + ti % per_b;
    const size_t r = (size_t)b * LP + pp;
    float x[16];
    unpack8(*(const uint4*)(H1 + r * 1024 + lane * 16), x);
    unpack8(*(const uint4*)(H1 + r * 1024 + lane * 16 + 8), x + 8);
    const int id0 = IDX[r * 128 + lane], id1 = IDX[r * 128 + 64 + lane];
    const float g0 = GATE[r * 128 + lane], g1 = GATE[r * 128 + 64 + lane];
    float d0 = 0.f, d1 = 0.f;
    for (int eb = 0; eb < 128; eb += 8) {
      uint4 ud[8];
#pragma unroll
      for (int j = 0; j < 8; ++j) {
        const int e = eb + j;
        const int id = __builtin_amdgcn_readlane((eb < 64) ? id0 : id1, e & 63);
        ud[j] = *(const uint4*)(TU + (size_t)id * 1024 + lane * 16);
      }
#pragma unroll
      for (int j = 0; j < 8; ++j) {
        float f[16]; dec_fp8x16(ud[j], f);
        float s = 0.f;
#pragma unroll
        for (int i = 0; i < 16; ++i) s += x[i] * f[i];
        s = wsum(s);
        const int e = eb + j;
        if (lane == (e & 63)) { if (eb < 64) d0 = s; else d1 = s; }
      }
    }
    float c0, c1;
    { const float a = d0 * TINV; c0 = g0 * 0.5f * a * (1.0f + erf_as(a * 0.7071067811865476f)) * TINV; }
    { const float a = d1 * TINV; c1 = g1 * 0.5f * a * (1.0f + erf_as(a * 0.7071067811865476f)) * TINV; }
    float acc[16];
#pragma unroll
    for (int i = 0; i < 16; ++i) acc[i] = 0.f;
    for (int eb = 0; eb < 128; eb += 8) {
      uint4 vd[8];
#pragma unroll
      for (int j = 0; j < 8; ++j) {
        const int e = eb + j;
        const int id = __builtin_amdgcn_readlane((eb < 64) ? id0 : id1, e & 63);
        vd[j] = *(const uint4*)(TV + (size_t)id * 1024 + lane * 16);
      }
#pragma unroll
      for (int j = 0; j < 8; ++j) {
        const int e = eb + j;
        const float cf = __int_as_float(__builtin_amdgcn_readlane(__float_as_int((eb < 64) ? c0 : c1), e & 63));
        float f[16]; dec_fp8x16(vd[j], f);
#pragma unroll
        for (int i = 0; i < 16; ++i) acc[i] += cf * f[i];
      }
    }
#pragma unroll
    for (int i = 0; i < 16; ++i) acc[i] += ALPHA * x[i];
    ln_row16_reg(acc, lg, lb);
    if (!last) {
      store_row16_bf16(HB + r * 1024, acc, lane);
    } else {
      float* o = p.out + ((size_t)b * SEQ + (pp - 64)) * 1024 + lane * 16;
#pragma unroll
      for (int i4 = 0; i4 < 4; ++i4) *(float4*)(o + i4 * 4) = make_float4(acc[i4 * 4], acc[i4 * 4 + 1], acc[i4 * 4 + 2], acc[i4 * 4 + 3]);
    }
  }
}

constexpr size_t OFF_PD = OFF_R1;
DI void p7_token(int ti, bool last, int& b, int& pp, size_t& r) {
  const int per_b = last ? SEQ : (SEQ + NMETA);
  b = ti / per_b; pp = (last ? 64 : PADR) + ti % per_b; r = (size_t)b * LP + pp;
}
DI void phase_p7a(const Params& p, int l) {
  char* const WS = opqp(p.ws);
  const int tid = opq(threadIdx.x), lane = tid & 63, w = tid >> 6;
  const int j = blockIdx.x & 7, wr = (blockIdx.x >> 3) * 4 + w, nwv = (gridDim.x >> 3) * 4;
  const u16* H1 = (const u16*)(WS + OFF_QKV);
  const char* TU = WS + OFF_TAB + j * 128 + (lane & 7) * 16;
  const int* IDX = (const int*)(WS + OFF_IDX);
  float* PD = (float*)(WS + OFF_PD) + (size_t)j * MR * 128;
  const bool last = (l == 1);
  const int ntok = NB * (last ? SEQ : (SEQ + NMETA));
  const int l7 = lane & 7, lg = lane >> 3;
#define P7A_LOADI(t, IV, X0, X1, R) { int b_, pp_; p7_token(min((t), ntok - 1), last, b_, pp_, R); \
    IV[0] = *(const int4*)(IDX + R * 128 + lg * 16); IV[1] = *(const int4*)(IDX + R * 128 + lg * 16 + 4); \
    IV[2] = *(const int4*)(IDX + R * 128 + lg * 16 + 8); IV[3] = *(const int4*)(IDX + R * 128 + lg * 16 + 12); \
    X0 = *(const uint4*)(H1 + R * 1024 + j * 128 + l7 * 16); X1 = *(const uint4*)(H1 + R * 1024 + j * 128 + l7 * 16 + 8); }
#define P7_IDV(IV, i) ((((i) & 3) == 0) ? IV[(i) >> 2].x : ((((i) & 3) == 1) ? IV[(i) >> 2].y : ((((i) & 3) == 2) ? IV[(i) >> 2].z : IV[(i) >> 2].w)))
#define P7_GATHER(TAB, IV, DST) { _Pragma("unroll") for (int i = 0; i < 16; ++i) DST[i] = *(const uint4*)(TAB + (size_t)P7_IDV(IV, i) * 1024); }
  int4 idN[4]; uint4 xN0, xN1; size_t rN;
  uint4 ud[16]; uint4 xc0, xc1; size_t rc;
  P7A_LOADI(wr, idN, xN0, xN1, rN)
  P7_GATHER(TU, idN, ud)
  xc0 = xN0; xc1 = xN1; rc = rN;
  P7A_LOADI(wr + nwv, idN, xN0, xN1, rN)
  for (int ti = wr; ti < ntok; ti += nwv) {
    uint4 udn[16];
    P7_GATHER(TU, idN, udn)
    const uint4 xG0 = xN0, xG1 = xN1; const size_t rG = rN;
    P7A_LOADI(ti + 2 * nwv, idN, xN0, xN1, rN)
    float xs[16];
    unpack8(xc0, xs); unpack8(xc1, xs + 8);
    float sel0 = 0.f, sel1 = 0.f;
#pragma unroll
    for (int i = 0; i < 16; ++i) {
      f32x2 f[8]; dec_fp8x16_v2(ud[i], f);
      f32x2 s2 = {0.f, 0.f};
#pragma unroll
      for (int c = 0; c < 8; ++c) { const f32x2 xv = {xs[2 * c], xs[2 * c + 1]}; s2 = __builtin_elementwise_fma(xv, f[c], s2); }
      const float sacc = red8(s2[0] + s2[1]);
      if ((i & 7) == l7) { if (i < 8) sel0 = sacc; else sel1 = sacc; }
    }
    PD[rc * 128 + 8 * l7 + lg] = sel0;
    PD[rc * 128 + 64 + 8 * l7 + lg] = sel1;
#pragma unroll
    for (int i = 0; i < 16; ++i) ud[i] = udn[i];
    xc0 = xG0; xc1 = xG1; rc = rG;
  }
}
DI void phase_p7coef(const Params& p, int l) {
  char* const WS = opqp(p.ws);
  const int tid = opq(threadIdx.x), lane = tid & 63, w = tid >> 6;
  float* GATE = (float*)(WS + OFF_GATE);
  const float* PD = (const float*)(WS + OFF_PD);
  const bool last = (l == 1);
  const int ntok = NB * (last ? SEQ : (SEQ + NMETA));
  for (int ti = blockIdx.x * 4 + w; ti < ntok; ti += gridDim.x * 4) {
    int b, pp; size_t r; p7_token(ti, last, b, pp, r);
    float d0 = 0.f, d1 = 0.f;
#pragma unroll
    for (int k = 0; k < 8; ++k) { d0 += PD[((size_t)k * MR + r) * 128 + lane]; d1 += PD[((size_t)k * MR + r) * 128 + 64 + lane]; }
    const int ps0 = p7_pos(lane), ps1 = p7_pos(64 + lane);
    const float g0 = GATE[r * 128 + ps0], g1 = GATE[r * 128 + ps1];
    const float a0 = d0 * TINV, a1 = d1 * TINV;
    GATE[r * 128 + ps0] = g0 * 0.5f * a0 * (1.0f + erf_as(a0 * 0.7071067811865476f)) * TINV;
    GATE[r * 128 + ps1] = g1 * 0.5f * a1 * (1.0f + erf_as(a1 * 0.7071067811865476f)) * TINV;
  }
}
DI void phase_p7b(const Params& p, int l) {
  char* const WS = opqp(p.ws);
  const int tid = opq(threadIdx.x), lane = tid & 63, w = tid >> 6;
  const int j = blockIdx.x & 7, wr = (blockIdx.x >> 3) * 4 + w, nwv = (gridDim.x >> 3) * 4;
  const char* TV = WS + OFF_TAB + (size_t)16384 * 1024 + j * 128 + (lane & 7) * 16;
  const int* IDX = (const int*)(WS + OFF_IDX);
  const float* COEF = (const float*)(WS + OFF_GATE);
  u16* OUTB = (u16*)(WS + OFF_YB);
  const bool last = (l == 1);
  const int ntok = NB * (last ? SEQ : (SEQ + NMETA));
  const int l7 = lane & 7, lg = lane >> 3;
#define P7B_LOADI(t, IV, CV, R) { int b_, pp_; p7_token(min((t), ntok - 1), last, b_, pp_, R); \
    _Pragma("unroll") for (int k4 = 0; k4 < 4; ++k4) { IV[k4] = *(const int4*)(IDX + R * 128 + lg * 16 + k4 * 4); CV[k4] = *(const float4*)(COEF + R * 128 + lg * 16 + k4 * 4); } }
#define P7_CFV(CV, i) ((((i) & 3) == 0) ? CV[(i) >> 2].x : ((((i) & 3) == 1) ? CV[(i) >> 2].y : ((((i) & 3) == 2) ? CV[(i) >> 2].z : CV[(i) >> 2].w)))
  int4 idN[4]; float4 cN[4]; size_t rN;
  P7B_LOADI(wr, idN, cN, rN)
  for (int ti = wr; ti < ntok; ti += nwv) {
    uint4 vd[16];
    P7_GATHER(TV, idN, vd)
    float4 cc[4];
#pragma unroll
    for (int k4 = 0; k4 < 4; ++k4) cc[k4] = cN[k4];
    const size_t rc = rN;
    P7B_LOADI(ti + nwv, idN, cN, rN)
    f32x2 acc2[8];
#pragma unroll
    for (int c = 0; c < 8; ++c) acc2[c] = (f32x2){0.f, 0.f};
#pragma unroll
    for (int i = 0; i < 16; ++i) {
      f32x2 f[8]; dec_fp8x16_v2(vd[i], f);
      const float cfi = P7_CFV(cc, i);
      const f32x2 cv = {cfi, cfi};
#pragma unroll
      for (int c = 0; c < 8; ++c) acc2[c] = __builtin_elementwise_fma(cv, f[c], acc2[c]);
    }
    float acc[16];
#pragma unroll
    for (int c = 0; c < 8; ++c) { acc[2 * c] = acc2[c][0]; acc[2 * c + 1] = acc2[c][1]; }
    float r8[8], r4[4];
    {
      const bool hi = (lane & 32) != 0;
#pragma unroll
      for (int k = 0; k < 8; ++k) {
        const float mine = hi ? acc[8 + k] : acc[k], send = hi ? acc[k] : acc[8 + k];
        r8[k] = mine + __shfl_xor(send, 32);
      }
    }
    {
      const bool hi = (lane & 16) != 0;
#pragma unroll
      for (int k = 0; k < 4; ++k) {
        const float mine = hi ? r8[4 + k] : r8[k], send = hi ? r8[k] : r8[4 + k];
        r4[k] = mine + __shfl_xor(send, 16);
      }
    }
    {
      const bool hi = (lane & 8) != 0;
      const float m0 = hi ? r4[2] : r4[0], m1 = hi ? r4[3] : r4[1], s0 = hi ? r4[0] : r4[2], s1 = hi ? r4[1] : r4[3];
      const float o0 = m0 + dpp_get<0x128>(s0);
      const float o1 = m1 + dpp_get<0x128>(s1);
      *(u32*)(OUTB + rc * 1024 + j * 128 + l7 * 16 + 2 * lg) = pack2(o0, o1);
    }
  }
}
DI void phase_p7c(const Params& p, int l) {
  char* const WS = opqp(p.ws);
  const int tid = opq(threadIdx.x), lane = tid & 63, w = tid >> 6;
  const u16* H1 = (const u16*)(WS + OFF_QKV);
  const u16* OUTB = (const u16*)(WS + OFF_YB);
  u16* HB = (u16*)(WS + OFF_HB);
  const bool last = (l == 1);
  const int ntok = NB * (last ? SEQ : (SEQ + NMETA));
  float lg_[16], lb_[16];
  load_gb16(lg_, lb_, p.ln2_g + l * 1024, p.ln2_b + l * 1024, lane);
  for (int ti = blockIdx.x * 4 + w; ti < ntok; ti += gridDim.x * 4) {
    int b, pp; size_t r; p7_token(ti, last, b, pp, r);
    float x[16], f[16];
    unpack8(*(const uint4*)(H1 + r * 1024 + lane * 16), x);
    unpack8(*(const uint4*)(H1 + r * 1024 + lane * 16 + 8), x + 8);
    unpack8(*(const uint4*)(OUTB + r * 1024 + lane * 16), f);
    unpack8(*(const uint4*)(OUTB + r * 1024 + lane * 16 + 8), f + 8);
#pragma unroll
    for (int i = 0; i < 16; ++i) f[i] += ALPHA * x[i];
    ln_row16_reg(f, lg_, lb_);
    if (!last) {
      store_row16_bf16(HB + r * 1024, f, lane);
    } else {
      float* o = p.out + ((size_t)b * SEQ + (pp - 64)) * 1024 + lane * 16;
#pragma unroll
      for (int i4 = 0; i4 < 4; ++i4) *(float4*)(o + i4 * 4) = make_float4(f[i4 * 4], f[i4 * 4 + 1], f[i4 * 4 + 2], f[i4 * 4 + 3]);
    }
  }
}

#define XB_TMO      128
#define XB_XCNT(j)  (256  + 64 * (j))
#define XB_XSUB(j)  (1280 + 64 * (j))
#define XB_XGEN(j)  (2304 + 64 * (j))
#define XB_TOP      3328
#define XB_TOPGEN   3392
#define XCD_BAR_WORDS 3456
#define XB_SPIN_CAP (1u << 22)
#define LAS __attribute__((address_space(3)))
DI unsigned xb_ld(unsigned* p)              { return __hip_atomic_load(p, __ATOMIC_RELAXED, __HIP_MEMORY_SCOPE_AGENT); }
DI unsigned xb_add(unsigned* p, unsigned v) { return __hip_atomic_fetch_add(p, v, __ATOMIC_RELAXED, __HIP_MEMORY_SCOPE_AGENT); }
DI unsigned xb_xcc_id() { return (unsigned)__builtin_amdgcn_s_getreg((3 << 11) | 20) & 0xFu; }
#define XB_SPIN(cond, bar) do { unsigned _sp = 0; while (cond) { __builtin_amdgcn_s_sleep(1); \
    if ((++_sp & 255u) == 0u) { if (xb_ld(&(bar)[XB_TMO])) break; if (_sp > XB_SPIN_CAP) { atomicAdd(&(bar)[XB_TMO], 1u); break; } } } } while (0)
struct XcdBarrier { unsigned* bar; unsigned x; volatile LAS unsigned* st; };
DI XcdBarrier xcd_barrier_post(unsigned* bar, volatile LAS unsigned* st) {
  XcdBarrier b; b.bar = bar; b.x = xb_xcc_id(); b.st = st;
  if (threadIdx.x == 0) (void)xb_add(&bar[XB_XCNT(b.x)], 1u);
  return b;
}
DI void xcd_barrier_complete(unsigned* bar, unsigned x, unsigned& nloc, unsigned& nx) {
  const unsigned G = gridDim.x * gridDim.y * gridDim.z;
  unsigned sum, cnt, mine, sp = 0u;
  for (;;) {
    sum = 0u; cnt = 0u; mine = 0u;
#pragma unroll
    for (unsigned j = 0; j < 16; ++j) { const unsigned c = xb_ld(&bar[XB_XCNT(j)]); sum += c; cnt += (c > 0u) ? 1u : 0u; mine = (j == x) ? c : mine; }
    if (sum == G) break;
    __builtin_amdgcn_s_sleep(1);
    if ((++sp & 255u) == 0u) { if (xb_ld(&bar[XB_TMO])) break; if (sp > XB_SPIN_CAP) { atomicAdd(&bar[XB_TMO], 1u); break; } }
  }
  nloc = mine > 0u ? mine : 1u; nx = cnt > 0u ? cnt : 1u;
}
DI void xcd_barrier(const XcdBarrier& b) {
  asm volatile("s_waitcnt vmcnt(0)" ::: "memory");
  __syncthreads();
  if (threadIdx.x == 0) {
    unsigned* bar = b.bar;
    __builtin_amdgcn_s_waitcnt(0);
    unsigned nloc = b.st[0], nx = b.st[1];
    if (nloc == 0u) { xcd_barrier_complete(bar, b.x, nloc, nx); b.st[0] = nloc; b.st[1] = nx; }
    const unsigned old = xb_add(&bar[XB_XSUB(b.x)], 1u);
    const unsigned gen = old / nloc;
    if (old + 1u == (gen + 1u) * nloc) {
      __builtin_amdgcn_fence(__ATOMIC_RELEASE, "agent");
      asm volatile("s_waitcnt vmcnt(0)" ::: "memory");
      const unsigned og = xb_add(&bar[XB_TOP], 1u);
      const unsigned tg = og / nx;
      if (og + 1u == (tg + 1u) * nx) xb_add(&bar[XB_TOPGEN], 1u);
      else XB_SPIN(xb_ld(&bar[XB_TOPGEN]) == tg, bar);
      __builtin_amdgcn_fence(__ATOMIC_ACQUIRE, "agent");
      xb_add(&bar[XB_XGEN(b.x)], 1u);
      asm volatile("s_waitcnt vmcnt(0)" ::: "memory");
    } else {
      XB_SPIN(xb_ld(&bar[XB_XGEN(b.x)]) == gen, bar);
      __builtin_amdgcn_fence(__ATOMIC_ACQUIRE, "agent");
      asm volatile("s_waitcnt vmcnt(0)" ::: "memory");
    }
  }
  __syncthreads();
}

#ifndef DUP_GEMM
#define DUP_GEMM 0
#endif
#ifndef DUP_P7
#define DUP_P7 0
#endif
#ifndef DUP_SCAN
#define DUP_SCAN 0
#endif
#ifndef DUP_P3
#define DUP_P3 0
#endif
#ifndef DUP_P6
#define DUP_P6 0
#endif
#ifndef DUP_MISC
#define DUP_MISC 0
#endif
template <int l>
DI void layer(const Params& p, char* smem, const XcdBarrier& xb) {
  for (int rep = 0; rep <= DUP_GEMM; ++rep) { gemm_phase<1>(p, OFF_HB, OFF_WIN + l * SZ_WIN1, NPROJP / 128, smem); xcd_barrier(xb); }
  for (int rep = 0; rep <= DUP_MISC; ++rep) { phase_p2(p, l, smem); xcd_barrier(xb); }
  for (int rep = 0; rep <= DUP_P3; ++rep) { phase_p3(p, smem); xcd_barrier(xb); }
  for (int rep = 0; rep <= DUP_SCAN; ++rep) { phase_scan(p, l, smem); xcd_barrier(xb); }
  phase_p5(p, l); xcd_barrier(xb);
  for (int rep = 0; rep <= DUP_GEMM; ++rep) { gemm_phase<2>(p, OFF_YB, OFF_WOUT + l * SZ_WOUT1, 8, smem); xcd_barrier(xb); }
  for (int rep = 0; rep <= DUP_MISC; ++rep) { phase_ln1(p, l); xcd_barrier(xb); }
  for (int rep = 0; rep <= DUP_GEMM; ++rep) { gemm_phase<3>(p, OFF_QKV, OFF_WQ + l * SZ_WQ1, 16, smem); xcd_barrier(xb); }
  for (int rep = 0; rep <= DUP_P6; ++rep) { phase_p6(p, l, smem); xcd_barrier(xb); }
#ifdef P7_GATHER_IC
  for (int rep = 0; rep <= DUP_P7; ++rep) { phase_p7(p, l); if (rep < DUP_P7) xcd_barrier(xb); }
#else
  phase_p7a(p, l); xcd_barrier(xb);
  phase_p7coef(p, l); xcd_barrier(xb);
  phase_p7b(p, l); xcd_barrier(xb);
  phase_p7c(p, l);
#endif
}
__global__ void __launch_bounds__(256, 2) fwd_megakernel(Params p) {
  __shared__ __attribute__((aligned(16))) char smem[78848];
  cg::grid_group grid = cg::this_grid();
  if (threadIdx.x == 0) *(uint4*)(smem + 78832) = make_uint4(0u, 0u, 0u, 0u);
  __syncthreads();
  const XcdBarrier xb = xcd_barrier_post((unsigned*)(p.ws + OFF_BAR), (volatile LAS unsigned*)(smem + 78832));
  phase_prologue(p, smem);
  grid.sync();
  layer<0>(p, smem, xb);
  xcd_barrier(xb);
  layer<1>(p, smem, xb);
}

extern "C" void kernel_launch(void* const* d_in, const int* in_sizes, int n_in, void* d_out,
                              int out_size, void* d_ws, size_t ws_size, hipStream_t stream) {
  static int grid_blocks = 0;
  if (!grid_blocks) {
    int dev = 0, cus = 0, per_cu = 0;
    (void)hipGetDevice(&dev);
    (void)hipDeviceGetAttribute(&cus, hipDeviceAttributeMultiprocessorCount, dev);
    (void)hipOccupancyMaxActiveBlocksPerMultiprocessor(&per_cu, fwd_megakernel, 256, 0);
    if (per_cu > 2) per_cu = 2;
    if (per_cu < 1) per_cu = 1;
    grid_blocks = cus * per_cu;
  }
  if (ws_size < WS_NEED) { fprintf(stderr, "workspace too small\n"); return; }
  Params p{};
  p.x = (const float*)d_in[0]; p.meta = (const float*)d_in[1]; p.ln_in_g = (const float*)d_in[2]; p.ln_in_b = (const float*)d_in[3];
  p.w_in = (const float*)d_in[4]; p.conv_w = (const float*)d_in[5]; p.gdn_conv_w = (const float*)d_in[6]; p.a_log = (const float*)d_in[7];
  p.dt_bias = (const float*)d_in[8]; p.gdn_norm_w = (const float*)d_in[9]; p.w_out = (const float*)d_in[10]; p.ln1_g = (const float*)d_in[11];
  p.ln1_b = (const float*)d_in[12]; p.w_q = (const float*)d_in[13]; p.k1 = (const float*)d_in[14]; p.k2 = (const float*)d_in[15];
  p.pu = (const float*)d_in[16]; p.pv = (const float*)d_in[17]; p.ln2_g = (const float*)d_in[18]; p.ln2_b = (const float*)d_in[19];
  p.out = (float*)d_out; p.ws = (char*)d_ws;
  (void)hipMemsetAsync((char*)d_ws + OFF_BAR, 0, 16384, stream);
  void* args[] = {&p};
  hipError_t e = hipLaunchCooperativeKernel((void*)fwd_megakernel, dim3(grid_blocks), dim3(256), args, 0, stream);
  if (e != hipSuccess) fprintf(stderr, "cooperative launch failed: %s (grid %d)\n", hipGetErrorString(e), grid_blocks);
}
```

```cpp
#include <hip/hip_runtime.h>
#include <hip/hip_cooperative_groups.h>
#include <cstdio>
namespace cg = cooperative_groups;

typedef unsigned short u16;
typedef unsigned int u32;
using bf16x8 = __attribute__((ext_vector_type(8))) short;
using s16x4 = __attribute__((ext_vector_type(4))) short;
using f32x4 = __attribute__((ext_vector_type(4))) float;
using f32x2 = __attribute__((ext_vector_type(2))) float;

#define DI __device__ __forceinline__
#define MFMA16(a, b, c) __builtin_amdgcn_mfma_f32_16x16x32_bf16((a), (b), (c), 0, 0, 0)

constexpr int NB = 4, SEQ = 8192, NMETA = 16, DM = 1024;
constexpr int LP = 8256;
constexpr int PADR = 48;
constexpr int MR = NB * LP;
constexpr int NCH = 129;
constexpr int NPROJ = 3592, NPROJP = 3712;
constexpr float ALPHA = 1.4142135623730951f;
constexpr float LN_EPS = 1e-5f, RMS_EPS = 1e-6f;
constexpr float TSCALE = 64.0f, TINV = 1.0f / 64.0f;

constexpr size_t SZ_HB = (size_t)MR * 1024 * 2;
constexpr size_t OFF_HB = 0;
constexpr size_t OFF_R1 = OFF_HB + SZ_HB;
constexpr size_t SZ_R1 = (size_t)MR * 3072 * 2;
constexpr size_t OFF_ZB = OFF_R1 + SZ_R1;
constexpr size_t SZ_ZB = (size_t)MR * 512 * 2;
constexpr size_t OFF_QKV = OFF_ZB + SZ_ZB;
constexpr size_t SZ_QKV = (size_t)MR * 1536 * 2;
constexpr size_t OFF_YB = OFF_QKV + SZ_QKV;
constexpr size_t OFF_AB = OFF_YB + SZ_HB;
constexpr size_t SZ_AB = (size_t)MR * 8 * 4;
constexpr size_t OFF_GB = OFF_AB + SZ_AB;
constexpr size_t OFF_WIN = OFF_GB + SZ_AB;
constexpr size_t SZ_WIN1 = (size_t)NPROJP * 1024 * 2;
constexpr size_t OFF_WOUT = OFF_WIN + 2 * SZ_WIN1;
constexpr size_t SZ_WOUT1 = (size_t)1024 * 1024 * 2;
constexpr size_t OFF_WQ = OFF_WOUT + 2 * SZ_WOUT1;
constexpr size_t SZ_WQ1 = (size_t)2048 * 1024 * 2;
constexpr size_t OFF_SK = OFF_WQ + 2 * SZ_WQ1;
constexpr size_t SZ_SK1 = (size_t)2 * 128 * 128 * 2;
constexpr size_t OFF_BAR = OFF_SK + 2 * SZ_SK1;
constexpr size_t WS_NEED = OFF_BAR + 16384;
constexpr size_t REC_BYTES = 58368;
constexpr size_t OFF_IDX = OFF_R1 + (size_t)MR * 2048 * 2;
constexpr size_t OFF_GATE = OFF_IDX + (size_t)MR * 128 * 4;
constexpr size_t OFF_TAB = OFF_GATE + (size_t)MR * 128 * 4;
static_assert((size_t)NB * NCH * 4 * REC_BYTES <= SZ_R1, "rec");
static_assert(OFF_GATE + (size_t)MR * 128 * 4 <= OFF_R1 + SZ_R1, "idx");
static_assert(OFF_TAB + (size_t)2 * 16384 * 1024 <= OFF_R1 + SZ_R1, "tab");
static_assert(WS_NEED <= (size_t)512 * 1024 * 1024, "ws");

struct Params {
  const float* x; const float* meta; const float* ln_in_g; const float* ln_in_b;
  const float* w_in; const float* conv_w; const float* gdn_conv_w; const float* a_log; const float* dt_bias;
  const float* gdn_norm_w; const float* w_out; const float* ln1_g; const float* ln1_b;
  const float* w_q; const float* k1; const float* k2; const float* pu; const float* pv;
  const float* ln2_g; const float* ln2_b;
  float* out; char* ws;
};

DI int opq(int x) { asm volatile("" : "+v"(x)); return x; }
DI char* opqp(char* w) { long z = 0; asm volatile("" : "+s"(z)); return w + z; }
DI int opqs(int x) { asm volatile("" : "+s"(x)); return x; }
#define SCHED_FENCE __builtin_amdgcn_sched_barrier(0)
typedef __bf16 hbf16x2 __attribute__((ext_vector_type(2)));
DI u32 pack2(float a, float b) { f32x2 v = {a, b}; hbf16x2 r = __builtin_convertvector(v, hbf16x2); return __builtin_bit_cast(u32, r); }
DI u16 f2bf(float x) { return (u16)(pack2(x, 0.f) & 0xffffu); }
DI float bf2f(u16 h) { return __uint_as_float(((u32)h) << 16); }
DI float bflo(u32 w) { return __uint_as_float(w << 16); }
DI float bfhi(u32 w) { return __uint_as_float(w & 0xffff0000u); }
template <int CTRL, int ROWMASK>
DI float dpp_get_rm(float v) { return __int_as_float(__builtin_amdgcn_update_dpp(0, __float_as_int(v), CTRL, ROWMASK, 0xF, false)); }
DI float red16(float v) {
  v += dpp_get_rm<0xB1, 0xF>(v); v += dpp_get_rm<0x4E, 0xF>(v); v += dpp_get_rm<0x141, 0xF>(v); v += dpp_get_rm<0x140, 0xF>(v);
  return v;
}
DI float wsum(float v) {
  v = red16(v);
  v += dpp_get_rm<0x142, 0xA>(v);
  v += dpp_get_rm<0x143, 0xC>(v);
  return __int_as_float(__builtin_amdgcn_readlane(__float_as_int(v), 63));
}
DI float erf_as(float x) {
  const float ax = fabsf(x);
  const float t = 1.0f / (1.0f + 0.3275911f * ax);
  const float poly = t * (0.254829592f + t * (-0.284496736f + t * (1.421413741f + t * (-1.453152027f + t * 1.061405429f))));
  const float r = 1.0f - poly * __expf(-ax * ax);
  return x < 0.f ? -r : r;
}
template <int CTRL>
DI float dpp_get(float v) { return __int_as_float(__builtin_amdgcn_update_dpp(0, __float_as_int(v), CTRL, 0xF, 0xF, false)); }
DI float red8(float v) { v += dpp_get<0xB1>(v); v += dpp_get<0x4E>(v); v += dpp_get<0x141>(v); return v; }
DI int p7_pos(int s_) { return (s_ & 7) * 16 + ((s_ >> 3) & 7) + ((s_ >> 6) << 3); }
DI u32 xch32(u32 x, bool upper) { auto r = __builtin_amdgcn_permlane32_swap(x, x, false, false); return upper ? r[0] : r[1]; }
DI u32 xch16(u32 x, bool oddrow) { auto r = __builtin_amdgcn_permlane16_swap(x, x, false, false); return oddrow ? r[0] : r[1]; }
DI float siluf(float x) { return x / (1.0f + __expf(-x)); }
DI void unpack8(const uint4& v, float* f) {
  f[0] = bflo(v.x); f[1] = bfhi(v.x); f[2] = bflo(v.y); f[3] = bfhi(v.y);
  f[4] = bflo(v.z); f[5] = bfhi(v.z); f[6] = bflo(v.w); f[7] = bfhi(v.w);
}
DI uint4 pack8(const float* f) {
  uint4 v; v.x = pack2(f[0], f[1]); v.y = pack2(f[2], f[3]); v.z = pack2(f[4], f[5]); v.w = pack2(f[6], f[7]); return v;
}
DI bf16x8 pack_acc2(const f32x4& a, const f32x4& b) {
  uint4 v; v.x = pack2(a[0], a[1]); v.y = pack2(a[2], a[3]); v.z = pack2(b[0], b[1]); v.w = pack2(b[2], b[3]);
  return __builtin_bit_cast(bf16x8, v);
}
DI bf16x8 read2x4(const u16* p, int c0, int c1) {
  uint2 lo = *(const uint2*)(p + c0);
  uint2 hi = *(const uint2*)(p + c1);
  uint4 v; v.x = lo.x; v.y = lo.y; v.z = hi.x; v.w = hi.y;
  return __builtin_bit_cast(bf16x8, v);
}
DI u32 enc_fp8x4(float a, float b, float c, float d) {
  int v = 0;
  v = __builtin_amdgcn_cvt_pk_fp8_f32(a, b, v, false);
  v = __builtin_amdgcn_cvt_pk_fp8_f32(c, d, v, true);
  return (u32)v;
}
DI void dec_fp8x16(const uint4& v, float* f) {
  f32x2 t;
  t = __builtin_amdgcn_cvt_pk_f32_fp8((int)v.x, false); f[0] = t[0]; f[1] = t[1];
  t = __builtin_amdgcn_cvt_pk_f32_fp8((int)v.x, true);  f[2] = t[0]; f[3] = t[1];
  t = __builtin_amdgcn_cvt_pk_f32_fp8((int)v.y, false); f[4] = t[0]; f[5] = t[1];
  t = __builtin_amdgcn_cvt_pk_f32_fp8((int)v.y, true);  f[6] = t[0]; f[7] = t[1];
  t = __builtin_amdgcn_cvt_pk_f32_fp8((int)v.z, false); f[8] = t[0]; f[9] = t[1];
  t = __builtin_amdgcn_cvt_pk_f32_fp8((int)v.z, true);  f[10] = t[0]; f[11] = t[1];
  t = __builtin_amdgcn_cvt_pk_f32_fp8((int)v.w, false); f[12] = t[0]; f[13] = t[1];
  t = __builtin_amdgcn_cvt_pk_f32_fp8((int)v.w, true);  f[14] = t[0]; f[15] = t[1];
}
DI void dec_fp8x16_v2(const uint4& v, f32x2* f) {
  f[0] = __builtin_amdgcn_cvt_pk_f32_fp8((int)v.x, false); f[1] = __builtin_amdgcn_cvt_pk_f32_fp8((int)v.x, true);
  f[2] = __builtin_amdgcn_cvt_pk_f32_fp8((int)v.y, false); f[3] = __builtin_amdgcn_cvt_pk_f32_fp8((int)v.y, true);
  f[4] = __builtin_amdgcn_cvt_pk_f32_fp8((int)v.z, false); f[5] = __builtin_amdgcn_cvt_pk_f32_fp8((int)v.z, true);
  f[6] = __builtin_amdgcn_cvt_pk_f32_fp8((int)v.w, false); f[7] = __builtin_amdgcn_cvt_pk_f32_fp8((int)v.w, true);
}
DI u32 orderable(float f) { u32 u = __float_as_uint(f); return u ^ ((u >> 31) ? 0xffffffffu : 0x80000000u); }
#define INS16(v, xx) { u32 _x = (xx); _Pragma("unroll") for (int _i = 0; _i < 16; ++_i) { u32 _h = max(v[_i], _x); _x = min(v[_i], _x); v[_i] = _h; } }

DI void ln_row16(float* v, const float* __restrict__ g, const float* __restrict__ b, int lane) {
  float s = 0.f;
#pragma unroll
  for (int i = 0; i < 16; ++i) s += v[i];
  float mu = wsum(s) * (1.0f / 1024.0f);
  float q = 0.f;
#pragma unroll
  for (int i = 0; i < 16; ++i) { float d = v[i] - mu; q += d * d; }
  float var = wsum(q) * (1.0f / 1024.0f);
  float rs = rsqrtf(var + LN_EPS);
#pragma unroll
  for (int i4 = 0; i4 < 4; ++i4) {
    float4 gg = *(const float4*)(g + lane * 16 + i4 * 4);
    float4 bb = *(const float4*)(b + lane * 16 + i4 * 4);
    v[i4 * 4 + 0] = (v[i4 * 4 + 0] - mu) * rs * gg.x + bb.x;
    v[i4 * 4 + 1] = (v[i4 * 4 + 1] - mu) * rs * gg.y + bb.y;
    v[i4 * 4 + 2] = (v[i4 * 4 + 2] - mu) * rs * gg.z + bb.z;
    v[i4 * 4 + 3] = (v[i4 * 4 + 3] - mu) * rs * gg.w + bb.w;
  }
}
DI void load_gb16(float* g, float* b, const float* __restrict__ gp, const float* __restrict__ bp, int lane) {
#pragma unroll
  for (int i4 = 0; i4 < 4; ++i4) {
    float4 gg = *(const float4*)(gp + lane * 16 + i4 * 4);
    float4 bb = *(const float4*)(bp + lane * 16 + i4 * 4);
    g[i4 * 4] = gg.x; g[i4 * 4 + 1] = gg.y; g[i4 * 4 + 2] = gg.z; g[i4 * 4 + 3] = gg.w;
    b[i4 * 4] = bb.x; b[i4 * 4 + 1] = bb.y; b[i4 * 4 + 2] = bb.z; b[i4 * 4 + 3] = bb.w;
  }
}
DI void ln_row16_reg(float* v, const float* g, const float* b) {
  float s = 0.f;
#pragma unroll
  for (int i = 0; i < 16; ++i) s += v[i];
  const float mu = wsum(s) * (1.0f / 1024.0f);
  float q = 0.f;
#pragma unroll
  for (int i = 0; i < 16; ++i) { const float d = v[i] - mu; q += d * d; }
  const float var = wsum(q) * (1.0f / 1024.0f);
  const float rs = rsqrtf(var + LN_EPS);
#pragma unroll
  for (int i = 0; i < 16; ++i) v[i] = (v[i] - mu) * rs * g[i] + b[i];
}
DI void store_row16_bf16(u16* dst, const float* v, int lane) {
  *(uint4*)(dst + lane * 16) = pack8(v);
  *(uint4*)(dst + lane * 16 + 8) = pack8(v + 8);
}

DI void transpose_convert(const float* __restrict__ W, int K, int N, int Npad, u16* __restrict__ Wt, char* smem) {
  float* tile = (float*)smem;
  const int tid = opq(threadIdx.x);
  const int ntn = Npad / 64, ntk = K / 64;
  for (int t = blockIdx.x; t < ntn * ntk; t += gridDim.x) {
    const int n0 = (t % ntn) * 64, k0 = (t / ntn) * 64;
#pragma unroll 4
    for (int i = 0; i < 16; ++i) {
      int idx = tid + i * 256; int kk = idx >> 6, nn = idx & 63;
      float val = (n0 + nn < N) ? W[(size_t)(k0 + kk) * N + n0 + nn] : 0.f;
      tile[kk * 65 + nn] = val;
    }
    __syncthreads();
#pragma unroll 4
    for (int i = 0; i < 16; ++i) {
      int idx = tid + i * 256; int nn = idx >> 6, kk = idx & 63;
      Wt[(size_t)(n0 + nn) * K + k0 + kk] = f2bf(tile[kk * 65 + nn]);
    }
    __syncthreads();
  }
}

DI void phase_prologue(const Params& p, char* smem) {
  char* const WS = opqp(p.ws);
  const int tid = opq(threadIdx.x), lane = tid & 63, w = tid >> 6;
  u16* HB = (u16*)(WS + OFF_HB);
  float lg[16], lb[16];
  load_gb16(lg, lb, p.ln_in_g, p.ln_in_b, lane);
  for (int r = blockIdx.x * 4 + w; r < MR; r += gridDim.x * 4) {
    const int b = r / LP, pp = r % LP;
    float v[16];
    if (pp < PADR) {
#pragma unroll
      for (int i = 0; i < 16; ++i) v[i] = 0.f;
    } else {
      const float* src = (pp < 64) ? (p.meta + (size_t)(pp - PADR) * DM) : (p.x + ((size_t)b * SEQ + (pp - 64)) * DM);
#pragma unroll
      for (int i4 = 0; i4 < 4; ++i4) {
        float4 t = *(const float4*)(src + lane * 16 + i4 * 4);
        v[i4 * 4] = t.x; v[i4 * 4 + 1] = t.y; v[i4 * 4 + 2] = t.z; v[i4 * 4 + 3] = t.w;
      }
      ln_row16_reg(v, lg, lb);
    }
    store_row16_bf16(HB + (size_t)r * DM, v, lane);
  }
  for (int l = 0; l < 2; ++l) {
    transpose_convert(p.w_in + (size_t)l * 1024 * NPROJ, 1024, NPROJ, NPROJP, (u16*)(WS + OFF_WIN + l * SZ_WIN1), smem);
    transpose_convert(p.w_out + (size_t)l * 1024 * 1024, 1024, 1024, 1024, (u16*)(WS + OFF_WOUT + l * SZ_WOUT1), smem);
    transpose_convert(p.w_q + (size_t)l * 1024 * 2048, 1024, 2048, 2048, (u16*)(WS + OFF_WQ + l * SZ_WQ1), smem);
  }
  u16* SK = (u16*)(WS + OFF_SK);
  for (int i = blockIdx.x * 256 + tid; i < 2 * 2 * 16384; i += gridDim.x * 256) {
    int l = i >> 15, rem = i & 32767, hf = rem >> 14, e = rem & 16383;
    const float* src = (hf ? p.k2 : p.k1) + (size_t)l * 16384;
    SK[i] = f2bf(src[e]);
  }
}

DI void convert_tables(const Params& p, int l, int first_block) {
  char* const WS = opqp(p.ws);
  u32* TAB = (u32*)(WS + OFF_TAB);
  const size_t n16 = (size_t)2 * 16384 * 1024 / 16;
  for (size_t i = (size_t)((opqs(blockIdx.x) - first_block) * 256 + opq(threadIdx.x)); i < n16; i += (size_t)(gridDim.x - first_block) * 256) {
    const size_t e0 = i * 16;
    const int which = (int)(e0 >> 24);
    const size_t off = e0 & (((size_t)1 << 24) - 1);
    const float* src = (which ? p.pv : p.pu) + (size_t)l * 16384 * 1024 + off;
    uint4 o;
    float4 a = *(const float4*)(src), b = *(const float4*)(src + 4), c = *(const float4*)(src + 8), d = *(const float4*)(src + 12);
    o.x = enc_fp8x4(a.x * TSCALE, a.y * TSCALE, a.z * TSCALE, a.w * TSCALE);
    o.y = enc_fp8x4(b.x * TSCALE, b.y * TSCALE, b.z * TSCALE, b.w * TSCALE);
    o.z = enc_fp8x4(c.x * TSCALE, c.y * TSCALE, c.z * TSCALE, c.w * TSCALE);
    o.w = enc_fp8x4(d.x * TSCALE, d.y * TSCALE, d.z * TSCALE, d.w * TSCALE);
    *(uint4*)(TAB + i * 4) = o;
  }
}

template <int EPI>
DI void gemm_phase(const Params& p, size_t offA, size_t offB, int ntn, char* smem) {
  char* const WS = opqp(p.ws);
  const u16* __restrict__ A = (const u16*)(WS + offA);
  const u16* __restrict__ Bt = (const u16*)(WS + offB);
  constexpr int K = 1024, LDS_ST = 64;
  u16* As = (u16*)smem;
  u16* Bs = As + 2 * 128 * LDS_ST;
  const int tid = opq(threadIdx.x), lane = tid & 63, w = tid >> 6, wm = w >> 1, wn = w & 1;
  const int l15 = lane & 15, q = lane >> 4;
  const int ntm = MR / 128;
  const int T_ = ntm * ntn;
  const int NX = ((gridDim.x & 7) == 0) ? 8 : 1;
  const int xcd = blockIdx.x % NX, bi = blockIdx.x / NX, nbx = gridDim.x / NX;
  const int pbeg = (xcd * T_) / NX, pend = ((xcd + 1) * T_) / NX;
  for (int pos = pbeg + bi; pos < pend; pos += nbx) {
    const int nig = 8 * ntn, gid = pos / nig, fm = gid * 8, gsz = min(8, ntm - fm), rem = pos - gid * nig;
    const int tm = fm + rem % gsz, tn = rem / gsz;
    const u16* Ag = A + (size_t)(tm * 128) * K;
    const u16* Bg = Bt + (size_t)(tn * 128) * K;
    f32x4 acc[4][4];
#pragma unroll
    for (int i = 0; i < 4; ++i)
#pragma unroll
      for (int j = 0; j < 4; ++j) acc[i][j] = (f32x4){0.f, 0.f, 0.f, 0.f};
    uint4 a0_0, a0_1, a0_2, a0_3, b0_0, b0_1, b0_2, b0_3, a1_0, a1_1, a1_2, a1_3, b1_0, b1_1, b1_2, b1_3;
    const int lrow = tid >> 3, lc = (tid & 7) * 8;
    const int lcs = ((tid & 7) ^ ((lrow >> 1) & 7)) * 8;
    const int rsw = (l15 >> 1) & 7;
    const u16* Agl = Ag + (size_t)lrow * K + lc;
    const u16* Bgl = Bg + (size_t)lrow * K + lc;
#define G_LD(S, k0) { S##a##_0 = *(const uint4*)(Agl + (k0)); S##a##_1 = *(const uint4*)(Agl + (size_t)32 * K + (k0)); \
      S##a##_2 = *(const uint4*)(Agl + (size_t)64 * K + (k0)); S##a##_3 = *(const uint4*)(Agl + (size_t)96 * K + (k0)); \
      S##b##_0 = *(const uint4*)(Bgl + (k0)); S##b##_1 = *(const uint4*)(Bgl + (size_t)32 * K + (k0)); \
      S##b##_2 = *(const uint4*)(Bgl + (size_t)64 * K + (k0)); S##b##_3 = *(const uint4*)(Bgl + (size_t)96 * K + (k0)); }
#define G_LD0(k0) { a0_0 = *(const uint4*)(Agl + (k0)); a0_1 = *(const uint4*)(Agl + (size_t)32 * K + (k0)); \
      a0_2 = *(const uint4*)(Agl + (size_t)64 * K + (k0)); a0_3 = *(const uint4*)(Agl + (size_t)96 * K + (k0)); \
      b0_0 = *(const uint4*)(Bgl + (k0)); b0_1 = *(const uint4*)(Bgl + (size_t)32 * K + (k0)); \
      b0_2 = *(const uint4*)(Bgl + (size_t)64 * K + (k0)); b0_3 = *(const uint4*)(Bgl + (size_t)96 * K + (k0)); }
#define G_LD1(k0) { a1_0 = *(const uint4*)(Agl + (k0)); a1_1 = *(const uint4*)(Agl + (size_t)32 * K + (k0)); \
      a1_2 = *(const uint4*)(Agl + (size_t)64 * K + (k0)); a1_3 = *(const uint4*)(Agl + (size_t)96 * K + (k0)); \
      b1_0 = *(const uint4*)(Bgl + (k0)); b1_1 = *(const uint4*)(Bgl + (size_t)32 * K + (k0)); \
      b1_2 = *(const uint4*)(Bgl + (size_t)64 * K + (k0)); b1_3 = *(const uint4*)(Bgl + (size_t)96 * K + (k0)); }
#define L_ST0(buf) { u16* An_ = As + (buf) * 128 * LDS_ST + lrow * LDS_ST + lcs; u16* Bn_ = Bs + (buf) * 128 * LDS_ST + lrow * LDS_ST + lcs; \
      *(uint4*)(An_) = a0_0; *(uint4*)(An_ + 32 * LDS_ST) = a0_1; *(uint4*)(An_ + 64 * LDS_ST) = a0_2; *(uint4*)(An_ + 96 * LDS_ST) = a0_3; \
      *(uint4*)(Bn_) = b0_0; *(uint4*)(Bn_ + 32 * LDS_ST) = b0_1; *(uint4*)(Bn_ + 64 * LDS_ST) = b0_2; *(uint4*)(Bn_ + 96 * LDS_ST) = b0_3; }
#define L_ST1(buf) { u16* An_ = As + (buf) * 128 * LDS_ST + lrow * LDS_ST + lcs; u16* Bn_ = Bs + (buf) * 128 * LDS_ST + lrow * LDS_ST + lcs; \
      *(uint4*)(An_) = a1_0; *(uint4*)(An_ + 32 * LDS_ST) = a1_1; *(uint4*)(An_ + 64 * LDS_ST) = a1_2; *(uint4*)(An_ + 96 * LDS_ST) = a1_3; \
      *(uint4*)(Bn_) = b1_0; *(uint4*)(Bn_ + 32 * LDS_ST) = b1_1; *(uint4*)(Bn_ + 64 * LDS_ST) = b1_2; *(uint4*)(Bn_ + 96 * LDS_ST) = b1_3; }
#define G_COMPUTE(buf) { const u16* Ac = As + (buf) * 128 * LDS_ST; const u16* Bc = Bs + (buf) * 128 * LDS_ST; \
      _Pragma("unroll") for (int kk = 0; kk < 2; ++kk) { \
        bf16x8 af[4], bfr[4]; \
        _Pragma("unroll") for (int mt = 0; mt < 4; ++mt) af[mt] = *(const bf16x8*)(Ac + (wm * 64 + mt * 16 + l15) * LDS_ST + (((kk * 4 + q) ^ rsw) * 8)); \
        _Pragma("unroll") for (int nt = 0; nt < 4; ++nt) bfr[nt] = *(const bf16x8*)(Bc + (wn * 64 + nt * 16 + l15) * LDS_ST + (((kk * 4 + q) ^ rsw) * 8)); \
        _Pragma("unroll") for (int mt = 0; mt < 4; ++mt) \
          _Pragma("unroll") for (int nt = 0; nt < 4; ++nt) acc[mt][nt] = MFMA16(bfr[nt], af[mt], acc[mt][nt]); } }
    constexpr int nk = K / 64;
    G_LD0(0)
    L_ST0(0)
    G_LD0(64)
    __syncthreads();
    for (int kt = 0; kt < nk; kt += 2) {
      L_ST0(1)
      if (kt + 2 < nk) G_LD1((kt + 2) * 64)
      G_COMPUTE(0)
      __syncthreads();
      if (kt + 2 < nk) L_ST1(0)
      if (kt + 3 < nk) G_LD0((kt + 3) * 64)
      G_COMPUTE(1)
      __syncthreads();
    }
#pragma unroll
    for (int mt = 0; mt < 4; ++mt) {
      const size_t m = (size_t)tm * 128 + wm * 64 + mt * 16 + l15;
#pragma unroll
      for (int nt = 0; nt < 4; ++nt) {
        const int n = tn * 128 + wn * 64 + nt * 16 + q * 4;
        const f32x4 a = acc[mt][nt];
        if (EPI == 1) {
          if (tn < 24) {
            uint2 o; o.x = pack2(a[0], a[1]); o.y = pack2(a[2], a[3]);
            *(uint2*)((u16*)(WS + OFF_R1) + m * 3072 + n) = o;
          } else if (tn < 28) {
            uint2 o; o.x = pack2(a[0], a[1]); o.y = pack2(a[2], a[3]);
            *(uint2*)((u16*)(WS + OFF_ZB) + m * 512 + (n - 3072)) = o;
          } else {
            if (n - 3584 < 8) *(float4*)((float*)(WS + OFF_AB) + m * 8 + (n - 3584)) = make_float4(a[0], a[1], a[2], a[3]);
          }
        } else if (EPI == 2) {
          uint2 o; o.x = pack2(a[0], a[1]); o.y = pack2(a[2], a[3]);
          *(uint2*)((u16*)(WS + OFF_R1) + m * 1024 + n) = o;
        } else {
          uint2 o; o.x = pack2(a[0], a[1]); o.y = pack2(a[2], a[3]);
          *(uint2*)((u16*)(WS + OFF_R1) + m * 2048 + n) = o;
        }
      }
    }
  }
}

DI void phase_p2(const Params& p, int l, char* smem) {
  char* const WS = opqp(p.ws);
  const int tid = opq(threadIdx.x), lane = tid & 63, w = tid >> 6;
  float* cw = (float*)smem;
  float* gw = cw + 3 * 512;
  {
    const float* cwg = p.conv_w + (size_t)l * 3 * 512;
    const float* gwg = p.gdn_conv_w + (size_t)l * 4 * 1536;
    for (int i = tid; i < 3 * 512 / 4; i += 256) *(float4*)(cw + i * 4) = *(const float4*)(cwg + i * 4);
    for (int i = tid; i < 4 * 1536 / 4; i += 256) *(float4*)(gw + i * 4) = *(const float4*)(gwg + i * 4);
  }
  __syncthreads();
  const u16* R1 = (const u16*)(WS + OFF_R1);
  u16* QKV = (u16*)(WS + OFF_QKV);
  u16* YB = (u16*)(WS + OFF_YB);
  const float* AB = (const float*)(WS + OFF_AB);
  float* GB = (float*)(WS + OFF_GB);
  const int gwv = blockIdx.x * 4 + w, nwv = gridDim.x * 4;
  const int rchunk = (int)(((unsigned)MR + (unsigned)nwv - 1u) / (unsigned)nwv);
  const int r_beg = min(MR, gwv * rchunk), r_end = min(MR, r_beg + rchunk);
  for (int r = r_beg; r < r_end; ++r) {
    const int pp = r % LP;
    if (pp < PADR) {
      const uint4 z4 = make_uint4(0, 0, 0, 0);
#pragma unroll
      for (int i = 0; i < 3; ++i) *(uint4*)(QKV + (size_t)r * 1536 + i * 512 + lane * 8) = z4;
      *(uint4*)(YB + (size_t)r * 1024 + lane * 8) = z4;
      *(uint4*)(YB + (size_t)r * 1024 + 512 + lane * 8) = z4;
      if (lane < 8) GB[(size_t)r * 8 + lane] = 0.f;
      continue;
    }
    const int c0 = lane * 8;
    {
      float cb[8], acc[8];
      unpack8(*(const uint4*)(R1 + (size_t)r * 3072 + c0), cb);
#pragma unroll
      for (int i = 0; i < 8; ++i) acc[i] = 0.f;
#pragma unroll
      for (int j = 0; j < 3; ++j) {
        const size_t rr = (size_t)(r - 2 + j);
        float cc[8], ch[8];
        unpack8(*(const uint4*)(R1 + rr * 3072 + 512 + c0), cc);
        unpack8(*(const uint4*)(R1 + rr * 3072 + 1024 + c0), ch);
        float4 w0 = *(const float4*)(cw + j * 512 + c0), w1 = *(const float4*)(cw + j * 512 + c0 + 4);
        const float ww[8] = {w0.x, w0.y, w0.z, w0.w, w1.x, w1.y, w1.z, w1.w};
#pragma unroll
        for (int i = 0; i < 8; ++i) acc[i] += ww[i] * (cc[i] * ch[i]);
      }
#pragma unroll
      for (int i = 0; i < 8; ++i) acc[i] *= cb[i];
      *(uint4*)(YB + (size_t)r * 1024 + c0) = pack8(acc);
    }
#pragma unroll
    for (int part = 0; part < 3; ++part) {
      const int c = part * 512 + c0;
      float acc[8];
#pragma unroll
      for (int i = 0; i < 8; ++i) acc[i] = 0.f;
#pragma unroll
      for (int j = 0; j < 4; ++j) {
        const size_t rr = (size_t)(r - 3 + j);
        float xv[8];
        unpack8(*(const uint4*)(R1 + rr * 3072 + 1536 + c), xv);
        float4 w0 = *(const float4*)(gw + j * 1536 + c), w1 = *(const float4*)(gw + j * 1536 + c + 4);
        const float ww[8] = {w0.x, w0.y, w0.z, w0.w, w1.x, w1.y, w1.z, w1.w};
#pragma unroll
        for (int i = 0; i < 8; ++i) acc[i] += ww[i] * xv[i];
      }
      float ss = 0.f;
#pragma unroll
      for (int i = 0; i < 8; ++i) { acc[i] = siluf(acc[i]); ss += acc[i] * acc[i]; }
      if (part < 2) {
        ss = red16(ss);
        float sc = rsqrtf(ss + RMS_EPS);
        if (part == 0) sc *= 0.08838834764831845f;
#pragma unroll
        for (int i = 0; i < 8; ++i) acc[i] *= sc;
      }
      *(uint4*)(QKV + (size_t)r * 1536 + c) = pack8(acc);
    }
    if (lane < 4) {
      const float a = AB[(size_t)r * 8 + lane], bb = AB[(size_t)r * 8 + 4 + lane];
      const float xx = a + p.dt_bias[l * 4 + lane];
      const float tt = __expf(-fabsf(xx));
      const float l1p = (tt < 0.01f) ? tt * (1.0f - tt * (0.5f - tt * 0.33333333f)) : __logf(1.0f + tt);
      const float sp = fmaxf(xx, 0.f) + l1p;
      GB[(size_t)r * 8 + lane] = -__expf(p.a_log[l * 4 + lane]) * sp;
      GB[(size_t)r * 8 + 4 + lane] = 1.0f / (1.0f + __expf(-bb));
    }
  }
}

DI void phase_p3(const Params& p, char* smem) {
  char* const WS = opqp(p.ws);
  constexpr int ST = 136, AST = 68;
  u16* kb = (u16*)smem;
  u16* qb = kb + 64 * ST;
  u16* kbb = qb + 64 * ST;
  float* As = (float*)(kbb + 64 * ST);
  float* s_gc = As + 64 * AST;
  float* s_bt = s_gc + 64;
  const int tid = opq(threadIdx.x), lane = tid & 63, w = tid >> 6, l15 = lane & 15, q = lane >> 4;
  const u16* QKV = (const u16*)(WS + OFF_QKV);
  const float* GB = (const float*)(WS + OFF_GB);
  for (int task = blockIdx.x; task < NB * NCH * 4; task += gridDim.x) {
    const int h = task & 3, bn = task >> 2, b = bn / NCH, n = bn % NCH;
    const size_t row0 = (size_t)b * LP + (size_t)n * 64;
    char* rec = WS + OFF_R1 + (size_t)task * REC_BYTES;
    u16* rec_u = (u16*)rec; u16* rec_w = rec_u + 8192; u16* rec_kT = rec_w + 8192; u16* rec_at = rec_kT + 8192;
    float* rec_eg = (float*)(rec + 57344); float* rec_egl = rec_eg + 64; float* rec_gl = rec_egl + 64;
    const int npad = (n == 0) ? PADR : 0;
    if (tid < 64) {
      const bool pad = tid < npad;
      float g = pad ? 0.f : GB[(row0 + tid) * 8 + h];
      float bt = pad ? 0.f : GB[(row0 + tid) * 8 + 4 + h];
#pragma unroll
      for (int o = 1; o < 64; o <<= 1) { float t = __shfl_up(g, o); if (lane >= o) g += t; }
      s_gc[tid] = g; s_bt[tid] = bt;
      const float gl = __shfl(g, 63);
      rec_eg[tid] = __expf(g);
      rec_egl[tid] = __expf(gl - g);
      if (tid == 0) rec_gl[0] = __expf(gl);
    }
    __syncthreads();
#pragma unroll
    for (int i = 0; i < 4; ++i) {
      int idx = tid + i * 256; int row = idx >> 4, c = idx & 15;
      uint4 kv = make_uint4(0, 0, 0, 0), qv = make_uint4(0, 0, 0, 0);
      if (row >= npad) {
        kv = *(const uint4*)(QKV + (row0 + row) * 1536 + 512 + h * 128 + c * 8);
        qv = *(const uint4*)(QKV + (row0 + row) * 1536 + h * 128 + c * 8);
      }
      *(uint4*)(kb + row * ST + c * 8) = kv;
      *(uint4*)(qb + row * ST + c * 8) = qv;
      float kf[8]; unpack8(kv, kf);
      const float bt = s_bt[row];
#pragma unroll
      for (int j = 0; j < 8; ++j) kf[j] *= bt;
      *(uint4*)(kbb + row * ST + c * 8) = pack8(kf);
    }
    __syncthreads();
#pragma unroll
    for (int it = 0; it < 4; ++it) {
      int idx = tid + it * 256; int d = idx >> 3, i8 = idx & 7;
      u32 t[4];
#pragma unroll
      for (int jj = 0; jj < 4; ++jj) t[jj] = (u32)kb[(i8 * 8 + 2 * jj) * ST + d] | ((u32)kb[(i8 * 8 + 2 * jj + 1) * ST + d] << 16);
      *(uint4*)(rec_kT + d * 64 + i8 * 8) = make_uint4(t[0], t[1], t[2], t[3]);
    }
    {
      const int mat = w >> 1;
      const u16* src = mat ? qb : kbb;
      f32x4 acc[2][4];
#pragma unroll
      for (int i = 0; i < 2; ++i)
#pragma unroll
        for (int j = 0; j < 4; ++j) acc[i][j] = (f32x4){0.f, 0.f, 0.f, 0.f};
#pragma unroll
      for (int ks = 0; ks < 4; ++ks) {
        bf16x8 a[2], bb[4];
#pragma unroll
        for (int mi = 0; mi < 2; ++mi) a[mi] = *(const bf16x8*)(src + (((w & 1) * 2 + mi) * 16 + l15) * ST + ks * 32 + q * 8);
#pragma unroll
        for (int nt = 0; nt < 4; ++nt) bb[nt] = *(const bf16x8*)(kb + (nt * 16 + l15) * ST + ks * 32 + q * 8);
#pragma unroll
        for (int mi = 0; mi < 2; ++mi)
#pragma unroll
          for (int nt = 0; nt < 4; ++nt) acc[mi][nt] = MFMA16(a[mi], bb[nt], acc[mi][nt]);
      }
#pragma unroll
      for (int mi = 0; mi < 2; ++mi)
#pragma unroll
        for (int nt = 0; nt < 4; ++nt)
#pragma unroll
          for (int r = 0; r < 4; ++r) {
            const int i = ((w & 1) * 2 + mi) * 16 + q * 4 + r, j = nt * 16 + l15;
            const float dec = __expf(s_gc[i] - s_gc[j]);
            if (mat == 0) As[i * AST + j] = (i > j) ? acc[mi][nt][r] * dec : 0.f;
            else rec_at[i * 64 + j] = f2bf((i >= j) ? acc[mi][nt][r] * dec : 0.f);
          }
    }
    __syncthreads();
    {
      const int mat = tid >> 7, c = tid & 127;
      float x[64];
      if (mat == 0) {
#pragma unroll
        for (int i = 0; i < 64; ++i) {
          const float vv = (i >= npad) ? bf2f(QKV[(row0 + i) * 1536 + 1024 + h * 128 + c]) : 0.f;
          x[i] = vv * s_bt[i];
        }
      } else {
#pragma unroll
        for (int i = 0; i < 64; ++i) x[i] = bf2f(kb[i * ST + c]) * s_bt[i] * __expf(s_gc[i]);
      }
#pragma unroll
      for (int i = 1; i < 64; ++i) {
        float s = x[i];
#pragma unroll
        for (int j4 = 0; j4 < (i + 3) / 4; ++j4) {
          const float4 a = *(const float4*)(As + i * AST + j4 * 4);
          s -= a.x * x[j4 * 4 + 0];
          if (j4 * 4 + 1 < i) s -= a.y * x[j4 * 4 + 1];
          if (j4 * 4 + 2 < i) s -= a.z * x[j4 * 4 + 2];
          if (j4 * 4 + 3 < i) s -= a.w * x[j4 * 4 + 3];
        }
        x[i] = s;
        if ((i & 3) == 3) SCHED_FENCE;
      }
      if (mat) {
#pragma unroll
        for (int i = 0; i < 64; ++i) rec_w[i * 128 + c] = f2bf(x[i]);
      } else {
        const int ug = c >> 4, ul = c & 15;
#pragma unroll
        for (int mt = 0; mt < 4; ++mt)
#pragma unroll
          for (int qq = 0; qq < 4; ++qq) {
            const int i0 = mt * 16 + qq * 4;
            uint2 o; o.x = pack2(x[i0], x[i0 + 1]); o.y = pack2(x[i0 + 2], x[i0 + 3]);
            *(uint2*)(rec_u + ((ug * 64 + qq * 16 + ul) * 16 + mt * 4)) = o;
          }
      }
    }
    __syncthreads();
  }
}

DI void phase_scan(const Params& p, int l, char* smem) {
  char* const WS = opqp(p.ws);
  if (blockIdx.x >= 32) { convert_tables(p, l, 32); return; }
  constexpr int ST = 136, ST2 = 72;
  u16* ws_ = (u16*)smem;
  u16* qs_ = ws_ + 64 * ST;
  u16* kts = qs_ + 64 * ST;
  u16* ats = kts + 128 * ST2;
  float* scl = (float*)(ats + 64 * ST2);
  const int tid = opq(threadIdx.x), lane = tid & 63, w = tid >> 6, l15 = lane & 15, q = lane >> 4;
  const int b = blockIdx.x >> 3, h = (blockIdx.x >> 1) & 3, half = blockIdx.x & 1;
  const u16* QKV = (const u16*)(WS + OFF_QKV);
  u16* YB = (u16*)(WS + OFF_YB);
  const int uoff = ((half * 4 + w) * 64 + lane) * 16;
  f32x4 S[8];
#pragma unroll
  for (int i = 0; i < 8; ++i) S[i] = (f32x4){0.f, 0.f, 0.f, 0.f};
  uint4 uc0, uc1;
  {
    const int task = ((b * NCH) << 2) + h;
    const size_t row0 = (size_t)b * LP;
    const char* rec = WS + OFF_R1 + (size_t)task * REC_BYTES;
    const u16* rec_u = (const u16*)rec; const u16* rec_w = rec_u + 8192; const u16* rec_kT = rec_w + 8192; const u16* rec_at = rec_kT + 8192;
    const float* rec_eg = (const float*)(rec + 57344);
#pragma unroll
    for (int i = 0; i < 4; ++i) {
      int idx = tid + i * 256; int row = idx >> 4, c = idx & 15;
      *(uint4*)(ws_ + row * ST + c * 8) = *(const uint4*)(rec_w + row * 128 + c * 8);
      *(uint4*)(qs_ + row * ST + c * 8) = *(const uint4*)(QKV + (row0 + row) * 1536 + h * 128 + c * 8);
      int rk = idx >> 3, ck = idx & 7;
      *(uint4*)(kts + rk * ST2 + ck * 8) = *(const uint4*)(rec_kT + rk * 64 + ck * 8);
    }
#pragma unroll
    for (int i = 0; i < 2; ++i) { int idx = tid + i * 256; int row = idx >> 3, c = idx & 7; *(uint4*)(ats + row * ST2 + c * 8) = *(const uint4*)(rec_at + row * 64 + c * 8); }
    if (tid < 129) scl[tid] = rec_eg[tid];
    uc0 = *(const uint4*)(rec_u + uoff); uc1 = *(const uint4*)(rec_u + uoff + 8);
  }
  __syncthreads();
  for (int n = 0; n < NCH; ++n) {
    const int cur = n & 1;
    const bool has_next = (n + 1 < NCH);
    const size_t row0 = (size_t)b * LP + (size_t)n * 64;
    const int taskn = ((b * NCH + (has_next ? n + 1 : n)) << 2) + h;
    const char* recn = WS + OFF_R1 + (size_t)taskn * REC_BYTES;
    const u16* recn_u = (const u16*)recn; const u16* recn_w = recn_u + 8192; const u16* recn_kT = recn_w + 8192; const u16* recn_at = recn_kT + 8192;
    const float* recn_eg = (const float*)(recn + 57344);
    const size_t row0n = has_next ? row0 + 64 : row0;
    const float* egs = scl + cur * 132;
    const float* egls = egs + 64;
    uint4 ra0, ra1, ra2, ra3, ra4, ra5, ra6, ra7;
    {
      const int tl = opq(threadIdx.x);
#define LD_A(i, RW, RQ) { const int idx = tl + (i) * 256; const int row = idx >> 4, c = idx & 15; \
        RW = *(const uint4*)(recn_w + row * 128 + c * 8); RQ = *(const uint4*)(QKV + (row0n + row) * 1536 + h * 128 + c * 8); }
      LD_A(0, ra0, ra4) LD_A(1, ra1, ra5) LD_A(2, ra2, ra6) LD_A(3, ra3, ra7)
    }
    f32x4 P[4], O[4];
#pragma unroll
    for (int i = 0; i < 4; ++i) { P[i] = O[i] = (f32x4){0.f, 0.f, 0.f, 0.f}; }
#pragma unroll
    for (int ks = 0; ks < 4; ++ks) {
      const bf16x8 sb0 = pack_acc2(S[2 * ks], S[2 * ks + 1]);
#pragma unroll
      for (int mt = 0; mt < 4; ++mt) {
        const bf16x8 aw = read2x4(ws_ + (mt * 16 + l15) * ST, ks * 32 + 4 * q, ks * 32 + 16 + 4 * q);
        const bf16x8 aq = read2x4(qs_ + (mt * 16 + l15) * ST, ks * 32 + 4 * q, ks * 32 + 16 + 4 * q);
        P[mt] = MFMA16(aw, sb0, P[mt]);
        O[mt] = MFMA16(aq, sb0, O[mt]);
      }
    }
    {
      const u32 uw_[8] = {uc0.x, uc0.y, uc0.z, uc0.w, uc1.x, uc1.y, uc1.z, uc1.w};
#pragma unroll
      for (int mt = 0; mt < 4; ++mt)
#pragma unroll
        for (int r = 0; r < 4; ++r) {
          const int i = mt * 16 + 4 * q + r;
          const int ui = mt * 4 + r;
          const float uv = (ui & 1) ? bfhi(uw_[ui >> 1]) : bflo(uw_[ui >> 1]);
          P[mt][r] = uv - P[mt][r];
          O[mt][r] *= egs[i];
        }
    }
    SCHED_FENCE;
    __syncthreads();
    uint4 rb0, rb1, rb2, rb3, rb4, rb5, un0, un1;
    float e_next = 0.f;
    {
      const int tl = opq(threadIdx.x);
#define ST_A(i, RW, RQ) { const int idx = tl + (i) * 256; const int row = idx >> 4, c = idx & 15; \
        *(uint4*)(ws_ + row * ST + c * 8) = RW; *(uint4*)(qs_ + row * ST + c * 8) = RQ; }
      ST_A(0, ra0, ra4) ST_A(1, ra1, ra5) ST_A(2, ra2, ra6) ST_A(3, ra3, ra7)
#define LD_K(i, R) { const int idx = tl + (i) * 256; const int rk = idx >> 3, ck = idx & 7; R = *(const uint4*)(recn_kT + rk * 64 + ck * 8); }
      LD_K(0, rb0) LD_K(1, rb1) LD_K(2, rb2) LD_K(3, rb3)
#define LD_T(i, R) { const int idx = tl + (i) * 256; const int row = idx >> 3, c = idx & 7; R = *(const uint4*)(recn_at + row * 64 + c * 8); }
      LD_T(0, rb4) LD_T(1, rb5)
      un0 = *(const uint4*)(recn_u + uoff);
      un1 = *(const uint4*)(recn_u + uoff + 8);
      if (tl < 129) e_next = recn_eg[tl];
    }
    {
      bf16x8 vb[2];
#pragma unroll
      for (int k2 = 0; k2 < 2; ++k2) vb[k2] = pack_acc2(P[2 * k2], P[2 * k2 + 1]);
#pragma unroll
      for (int k2 = 0; k2 < 2; ++k2)
#pragma unroll
        for (int mt = 0; mt < 4; ++mt) {
          const bf16x8 aa = read2x4(ats + (mt * 16 + l15) * ST2, k2 * 32 + 4 * q, k2 * 32 + 16 + 4 * q);
          O[mt] = MFMA16(aa, vb[k2], O[mt]);
        }
    }
    {
      const int npad = (n == 0) ? PADR : 0;
      u16* yp = YB + (row0 + 4 * q) * 1024 + 512 + h * 128 + half * 64 + w * 16 + l15;
#pragma unroll
      for (int mt = 0; mt < 4; ++mt)
#pragma unroll
        for (int r = 0; r < 4; ++r)
          if (mt * 16 + 4 * q + r >= npad) yp[(mt * 16 + r) * 1024] = f2bf(O[mt][r]);
    }
    {
#pragma unroll
      for (int mt = 0; mt < 4; ++mt)
#pragma unroll
        for (int r = 0; r < 4; ++r) P[mt][r] *= egls[mt * 16 + 4 * q + r];
      bf16x8 vb[2];
#pragma unroll
      for (int k2 = 0; k2 < 2; ++k2) vb[k2] = pack_acc2(P[2 * k2], P[2 * k2 + 1]);
      const float egl = egs[128];
#pragma unroll
      for (int dt = 0; dt < 8; ++dt) S[dt] *= egl;
#pragma unroll
      for (int k2 = 0; k2 < 2; ++k2)
#pragma unroll
        for (int dt = 0; dt < 8; ++dt) {
          const bf16x8 ak = read2x4(kts + (dt * 16 + l15) * ST2, k2 * 32 + 4 * q, k2 * 32 + 16 + 4 * q);
          S[dt] = MFMA16(ak, vb[k2], S[dt]);
        }
    }
    SCHED_FENCE;
    __syncthreads();
    {
      const int tl = opq(threadIdx.x);
#define ST_K(i, R) { const int idx = tl + (i) * 256; const int rk = idx >> 3, ck = idx & 7; *(uint4*)(kts + rk * ST2 + ck * 8) = R; }
      ST_K(0, rb0) ST_K(1, rb1) ST_K(2, rb2) ST_K(3, rb3)
#define ST_T(i, R) { const int idx = tl + (i) * 256; const int row = idx >> 3, c = idx & 7; *(uint4*)(ats + row * ST2 + c * 8) = R; }
      ST_T(0, rb4) ST_T(1, rb5)
      if (tl < 129) scl[(cur ^ 1) * 132 + tl] = e_next;
    }
    uc0 = un0; uc1 = un1;
    __syncthreads();
  }
}

DI void phase_p5(const Params& p, int l) {
  char* const WS = opqp(p.ws);
  const int tid = opq(threadIdx.x), lane = tid & 63, w = tid >> 6;
  const u16* ZB = (const u16*)(WS + OFF_ZB);
  u16* YB = (u16*)(WS + OFF_YB);
  const float* nw = p.gdn_norm_w + l * 128;
  const int c0 = (lane & 15) * 8;
  const float4 n0 = *(const float4*)(nw + c0), n1 = *(const float4*)(nw + c0 + 4);
  const float nn[8] = {n0.x, n0.y, n0.z, n0.w, n1.x, n1.y, n1.z, n1.w};
  for (int ti = blockIdx.x * 4 + w; ti < NB * (SEQ + NMETA); ti += gridDim.x * 4) {
    const int b = ti / (SEQ + NMETA), pp = PADR + ti % (SEQ + NMETA);
    const size_t r = (size_t)b * LP + pp;
    float ov[8], zf[8], yv[8];
    unpack8(*(const uint4*)(YB + r * 1024 + 512 + lane * 8), ov);
    unpack8(*(const uint4*)(ZB + r * 512 + lane * 8), zf);
    float ss = 0.f;
#pragma unroll
    for (int j = 0; j < 8; ++j) ss += ov[j] * ov[j];
    ss = red16(ss);
    const float rs = rsqrtf(ss * (1.0f / 128.0f) + RMS_EPS);
#pragma unroll
    for (int j = 0; j < 8; ++j) yv[j] = ov[j] * rs * nn[j] * siluf(zf[j]);
    *(uint4*)(YB + r * 1024 + 512 + lane * 8) = pack8(yv);
  }
}

DI void phase_ln1(const Params& p, int l) {
  char* const WS = opqp(p.ws);
  const int tid = opq(threadIdx.x), lane = tid & 63, w = tid >> 6;
  const u16* HB = (const u16*)(WS + OFF_HB);
  const u16* MIX = (const u16*)(WS + OFF_R1);
  u16* H1 = (u16*)(WS + OFF_QKV);
  float lg[16], lb[16];
  load_gb16(lg, lb, p.ln1_g + l * 1024, p.ln1_b + l * 1024, lane);
  const int gwv = blockIdx.x * 4 + w, nwv = gridDim.x * 4;
  const int rchunk = (int)(((unsigned)MR + (unsigned)nwv - 1u) / (unsigned)nwv);
  const int r_beg = min(MR, gwv * rchunk), r_end = min(MR, r_beg + rchunk);
  auto proc = [&](int rr, const uint4& h0, const uint4& h1, const uint4& m0, const uint4& m1) {
    float v[16];
    if (rr % LP < PADR) {
#pragma unroll
      for (int i = 0; i < 16; ++i) v[i] = 0.f;
    } else {
      float hv[16], mv[16];
      unpack8(h0, hv); unpack8(h1, hv + 8); unpack8(m0, mv); unpack8(m1, mv + 8);
#pragma unroll
      for (int i = 0; i < 16; ++i) v[i] = ALPHA * hv[i] + mv[i];
      ln_row16_reg(v, lg, lb);
    }
    store_row16_bf16(H1 + (size_t)rr * 1024, v, lane);
  };
  for (int r = r_beg; r < r_end; r += 2) {
    const int rB = min(r + 1, r_end - 1);
    const uint4 hA0 = *(const uint4*)(HB + (size_t)r * 1024 + lane * 16), hA1 = *(const uint4*)(HB + (size_t)r * 1024 + lane * 16 + 8);
    const uint4 mA0 = *(const uint4*)(MIX + (size_t)r * 1024 + lane * 16), mA1 = *(const uint4*)(MIX + (size_t)r * 1024 + lane * 16 + 8);
    const uint4 hB0 = *(const uint4*)(HB + (size_t)rB * 1024 + lane * 16), hB1 = *(const uint4*)(HB + (size_t)rB * 1024 + lane * 16 + 8);
    const uint4 mB0 = *(const uint4*)(MIX + (size_t)rB * 1024 + lane * 16), mB1 = *(const uint4*)(MIX + (size_t)rB * 1024 + lane * 16 + 8);
    proc(r, hA0, hA1, mA0, mA1);
    if (r + 1 < r_end) proc(rB, hB0, hB1, mB0, mB1);
  }
}

#define CE_DESC(x, y) { const u32 _hi = max(x, y); const u32 _lo = min(x, y); x = _hi; y = _lo; }
#define CE_ASC(x, y)  { const u32 _hi = max(x, y); const u32 _lo = min(x, y); x = _lo; y = _hi; }
DI void bitonic_sort16(u32* v) {
#pragma unroll
  for (int k = 2; k <= 16; k <<= 1)
#pragma unroll
    for (int j = k >> 1; j > 0; j >>= 1)
#pragma unroll
      for (int i = 0; i < 16; ++i) {
        const int l = i ^ j;
        if (l > i) { if ((i & k) == 0) CE_DESC(v[i], v[l]) else CE_ASC(v[i], v[l]) }
      }
}
DI void bitonic_merge16(u32* v) {
#pragma unroll
  for (int j = 8; j > 0; j >>= 1)
#pragma unroll
    for (int i = 0; i < 16; ++i) { const int l = i ^ j; if (l > i) CE_DESC(v[i], v[l]) }
}
DI void merge_top16(u32* a, const u32* b) {
#pragma unroll
  for (int i = 0; i < 16; ++i) a[i] = max(a[i], b[15 - i]);
  bitonic_merge16(a);
}
DI void xmerge_top16(u32* v, int mask) {
  u32 t[16];
  const int ln = __lane_id();
  const bool up32 = (ln & 32) != 0, odd16 = (ln & 16) != 0;
#pragma unroll
  for (int i = 0; i < 16; ++i) t[i] = (mask == 32) ? xch32(v[15 - i], up32) : xch16(v[15 - i], odd16);
#pragma unroll
  for (int i = 0; i < 16; ++i) v[i] = max(v[i], t[i]);
  bitonic_merge16(v);
}
DI float unorder(u32 u) { return __uint_as_float(u ^ ((u >> 31) ? 0x80000000u : 0xffffffffu)); }
__device__ __attribute__((aligned(16))) const unsigned char P6_CAND[64] = {
  0, 1, 2, 3, 4, 5, 6, 7, 8, 9, 10, 11, 12, 13, 14, 15,
  16, 17, 18, 19, 20, 21, 22, 23, 64, 65, 66, 80, 81, 128, 144, 160,
  32, 33, 34, 35, 36, 48, 49, 50, 51, 96, 97, 112, 113, 176, 192, 208,
  224, 240, 255, 255, 255, 255, 255, 255, 255, 255, 255, 255, 255, 255, 255, 255};

DI void phase_p6(const Params& p, int l, char* smem) {
  char* const WS = opqp(p.ws);
  constexpr int KST = 136;
  u16* kh = (u16*)smem;
  u32* lists = (u32*)(smem + 2 * 128 * KST * 2);
  const int tid = opq(threadIdx.x), lane = tid & 63, w = tid >> 6, l15 = lane & 15, q = lane >> 4;
  const u16* QP = (const u16*)(WS + OFF_R1);
  const u16* SK = (const u16*)(WS + OFF_SK) + (size_t)l * 2 * 16384;
  int* IDX = (int*)(WS + OFF_IDX);
  float* GATE = (float*)(WS + OFF_GATE);
  for (int idx = tid; idx < 2 * 128 * 16; idx += 256) {
    const int row = idx >> 4, c = idx & 15;
    *(uint4*)(kh + row * KST + c * 8) = *(const uint4*)(SK + row * 128 + c * 8);
  }
  __syncthreads();
  u32* mylist = lists + (w * 16 + l15) * 32;
  const uint4 cw = *(const uint4*)(P6_CAND + q * 16);
  const u32 cwv[4] = {cw.x, cw.y, cw.z, cw.w};
  const int gw = blockIdx.x * 4 + w, nw_ = gridDim.x * 4;
  for (int task = gw; task < (MR / 16) * 8; task += nw_) {
    const int tt = task >> 3, hd = task & 7;
    const size_t row = (size_t)tt * 16 + l15;
#pragma unroll
    for (int hf = 0; hf < 2; ++hf) {
      f32x4 acc[8];
#pragma unroll
      for (int i = 0; i < 8; ++i) acc[i] = (f32x4){0.f, 0.f, 0.f, 0.f};
      const u16* qrow = QP + row * 2048 + hd * 256 + hf * 128;
      const u16* khh = kh + hf * 128 * KST;
#pragma unroll
      for (int ks = 0; ks < 4; ++ks) {
        const bf16x8 aq = *(const bf16x8*)(qrow + ks * 32 + q * 8);
#pragma unroll
        for (int nt = 0; nt < 8; ++nt) {
          const bf16x8 bk = *(const bf16x8*)(khh + (nt * 16 + l15) * KST + ks * 32 + q * 8);
          acc[nt] = MFMA16(bk, aq, acc[nt]);
        }
      }
      u32 va[16], vb2[16];
#pragma unroll
      for (int nt = 0; nt < 4; ++nt)
#pragma unroll
        for (int r = 0; r < 4; ++r) {
          va[nt * 4 + r] = (orderable(acc[nt][r]) & ~127u) | (u32)(127 - (nt * 16 + 4 * q + r));
          vb2[nt * 4 + r] = (orderable(acc[nt + 4][r]) & ~127u) | (u32)(127 - ((nt + 4) * 16 + 4 * q + r));
        }
      bitonic_sort16(va);
      bitonic_sort16(vb2);
      merge_top16(va, vb2);
      xmerge_top16(va, 16);
      xmerge_top16(va, 32);
      if (q == 0) {
#pragma unroll
        for (int i = 0; i < 4; ++i) *(uint4*)(mylist + hf * 16 + i * 4) = make_uint4(va[i * 4], va[i * 4 + 1], va[i * 4 + 2], va[i * 4 + 3]);
      }
    }
    u32 vc[16];
#pragma unroll
    for (int s_ = 0; s_ < 16; ++s_) {
      const u32 ci = (cwv[s_ >> 2] >> ((s_ & 3) * 8)) & 255u;
      const bool ok = (ci != 255u);
      const u32 a_ = ok ? (ci >> 4) : 0u, b_ = ok ? (ci & 15u) : 0u;
      const float sum = unorder(mylist[a_] & ~127u) + unorder(mylist[16 + b_] & ~127u);
      vc[s_] = ok ? ((orderable(sum) & ~255u) | (255u - ci)) : 0u;
    }
    bitonic_sort16(vc);
    xmerge_top16(vc, 16);
    xmerge_top16(vc, 32);
    const float mx = unorder(vc[0] & ~255u);
    float den = 0.f;
#pragma unroll
    for (int k = 0; k < 16; ++k) den += __expf(unorder(vc[k] & ~255u) - mx);
    const float inv = 1.0f / den;
    int ex[4]; float gt[4];
#pragma unroll
    for (int j = 0; j < 4; ++j) {
      const u32 pk = (q == 0) ? vc[j] : ((q == 1) ? vc[4 + j] : ((q == 2) ? vc[8 + j] : vc[12 + j]));
      const u32 ci = 255u - (pk & 255u);
      const u32 p1 = mylist[ci >> 4], p2 = mylist[16 + (ci & 15u)];
      ex[j] = (int)((127u - (p1 & 127u)) * 128u + (127u - (p2 & 127u)));
      gt[j] = __expf(unorder(p1 & ~127u) + unorder(p2 & ~127u) - mx) * inv;
    }
#pragma unroll
    for (int j = 0; j < 4; ++j) {
      const int ps = p7_pos(hd * 16 + q * 4 + j);
      IDX[row * 128 + ps] = ex[j];
      GATE[row * 128 + ps] = gt[j];
    }
  }
}

DI void phase_p7(const Params& p, int l) {
  char* const WS = opqp(p.ws);
  const int tid = opq(threadIdx.x), lane = tid & 63, w = tid >> 6;
  const u16* H1 = (const u16*)(WS + OFF_QKV);
  u16* HB = (u16*)(WS + OFF_HB);
  const char* TU = WS + OFF_TAB;
  const char* TV = TU + (size_t)16384 * 1024;
  const int* IDX = (const int*)(WS + OFF_IDX);
  const float* GATE = (const float*)(WS + OFF_GATE);
  const bool last = (l == 1);
  const int per_b = last ? SEQ : (SEQ + NMETA);
  const int ntok = NB * per_b;
  float lg[16], lb[16];
  load_gb16(lg, lb, p.ln2_g + l * 1024, p.ln2_b + l * 1024, lane);
  for (int ti = blockIdx.x * 4 + w; ti < ntok; ti += gridDim.x * 4) {
    const int b = ti / per_b, pp = (last ? 64 : PADR) + ti % per_b;
    const size_t r = (size_t)b * LP + pp;
    float x[16];
    unpack8(*(const uint4*)(H1 + r * 1024 + lane * 16), x);
    unpack8(*(const uint4*)(H1 + r * 1024 + lane * 16 + 8), x + 8);
    const int id0 = IDX[r * 128 + lane], id1 = IDX[r * 128 + 64 + lane];
    const float g0 = GATE[r * 128 + lane], g1 = GATE[r * 128 + 64 + lane];
    float d0 = 0.f, d1 = 0.f;
    for (int eb = 0; eb < 128; eb += 8) {
      uint4 ud[8];
#pragma unroll
      for (int j = 0; j < 8; ++j) {
        const int e = eb + j;
        const int id = __builtin_amdgcn_readlane((eb < 64) ? id0 : id1, e & 63);
        ud[j] = *(const uint4*)(TU + (size_t)id * 1024 + lane * 16);
      }
#pragma unroll
      for (int j = 0; j < 8; ++j) {
        float f[16]; dec_fp8x16(ud[j], f);
        float s = 0.f;
#pragma unroll
        for (int i = 0; i < 16; ++i) s += x[i] * f[i];
        s = wsum(s);
        const int e = eb + j;
        if (lane == (e & 63)) { if (eb < 64) d0 = s; else d1 = s; }
      }
    }
    float c0, c1;
    { const float a = d0 * TINV; c0 = g0 * 0.5f * a * (1.0f + erf_as(a * 0.7071067811865476f)) * TINV; }
    { const float a = d1 * TINV; c1 = g1 * 0.5f * a * (1.0f + erf_as(a * 0.7071067811865476f)) * TINV; }
    float acc[16];
#pragma unroll
    for (int i = 0; i < 16; ++i) acc[i] = 0.f;
    for (int eb = 0; eb < 128; eb += 8) {
      uint4 vd[8];
#pragma unroll
      for (int j = 0; j < 8; ++j) {
        const int e = eb + j;
        const int id = __builtin_amdgcn_readlane((eb < 64) ? id0 : id1, e & 63);
        vd[j] = *(const uint4*)(TV + (size_t)id * 1024 + lane * 16);
      }
#pragma unroll
      for (int j = 0; j < 8; ++j) {
        const int e = eb + j;
        const float cf = __int_as_float(__builtin_amdgcn_readlane(__float_as_int((eb < 64) ? c0 : c1), e & 63));
        float f[16]; dec_fp8x16(vd[j], f);
#pragma unroll
        for (int i = 0; i < 16; ++i) acc[i] += cf * f[i];
      }
    }
#pragma unroll
    for (int i = 0; i < 16; ++i) acc[i] += ALPHA * x[i];
    ln_row16_reg(acc, lg, lb);
    if (!last) {
      store_row16_bf16(HB + r * 1024, acc, lane);
    } else {
      float* o = p.out + ((size_t)b * SEQ + (pp - 64)) * 1024 + lane * 16;
#pragma unroll
      for (int i4 = 0; i4 < 4; ++i4) *(float4*)(o + i4 * 4) = make_float4(acc[i4 * 4], acc[i4 * 4 + 1], acc[i4 * 4 + 2], acc[i4 * 4 + 3]);
    }
  }
}

constexpr size_t OFF_PD = OFF_R1;
DI void p7_token(int ti, bool last, int& b, int& pp, size_t& r) {
  const int per_b = last ? SEQ : (SEQ + NMETA);
  b = ti / per_b; pp = (last ? 64 : PADR) + ti % per_b; r = (size_t)b * LP + pp;
}
DI void phase_p7a(const Params& p, int l) {
  char* const WS = opqp(p.ws);
  const int tid = opq(threadIdx.x), lane = tid & 63, w = tid >> 6;
  const int j = blockIdx.x & 7, wr = (blockIdx.x >> 3) * 4 + w, nwv = (gridDim.x >> 3) * 4;
  const u16* H1 = (const u16*)(WS + OFF_QKV);
  const char* TU = WS + OFF_TAB + j * 128 + (lane & 7) * 16;
  const int* IDX = (const int*)(WS + OFF_IDX);
  float* PD = (float*)(WS + OFF_PD) + (size_t)j * MR * 128;
  const bool last = (l == 1);
  const int ntok = NB * (last ? SEQ : (SEQ + NMETA));
  const int l7 = lane & 7, lg = lane >> 3;
#define P7A_LOADI(t, IV, X0, X1, R) { int b_, pp_; p7_token(min((t), ntok - 1), last, b_, pp_, R); \
    IV[0] = *(const int4*)(IDX + R * 128 + lg * 16); IV[1] = *(const int4*)(IDX + R * 128 + lg * 16 + 4); \
    IV[2] = *(const int4*)(IDX + R * 128 + lg * 16 + 8); IV[3] = *(const int4*)(IDX + R * 128 + lg * 16 + 12); \
    X0 = *(const uint4*)(H1 + R * 1024 + j * 128 + l7 * 16); X1 = *(const uint4*)(H1 + R * 1024 + j * 128 + l7 * 16 + 8); }
#define P7_IDV(IV, i) ((((i) & 3) == 0) ? IV[(i) >> 2].x : ((((i) & 3) == 1) ? IV[(i) >> 2].y : ((((i) & 3) == 2) ? IV[(i) >> 2].z : IV[(i) >> 2].w)))
#define P7_GATHER(TAB, IV, DST) { _Pragma("unroll") for (int i = 0; i < 16; ++i) DST[i] = *(const uint4*)(TAB + (size_t)P7_IDV(IV, i) * 1024); }
  int4 idN[4]; uint4 xN0, xN1; size_t rN;
  uint4 ud[16]; uint4 xc0, xc1; size_t rc;
  P7A_LOADI(wr, idN, xN0, xN1, rN)
  P7_GATHER(TU, idN, ud)
  xc0 = xN0; xc1 = xN1; rc = rN;
  P7A_LOADI(wr + nwv, idN, xN0, xN1, rN)
  for (int ti = wr; ti < ntok; ti += nwv) {
    uint4 udn[16];
    P7_GATHER(TU, idN, udn)
    const uint4 xG0 = xN0, xG1 = xN1; const size_t rG = rN;
    P7A_LOADI(ti + 2 * nwv, idN, xN0, xN1, rN)
    float xs[16];
    unpack8(xc0, xs); unpack8(xc1, xs + 8);
    float sel0 = 0.f, sel1 = 0.f;
#pragma unroll
    for (int i = 0; i < 16; ++i) {
      f32x2 f[8]; dec_fp8x16_v2(ud[i], f);
      f32x2 s2 = {0.f, 0.f};
#pragma unroll
      for (int c = 0; c < 8; ++c) { const f32x2 xv = {xs[2 * c], xs[2 * c + 1]}; s2 = __builtin_elementwise_fma(xv, f[c], s2); }
      const float sacc = red8(s2[0] + s2[1]);
      if ((i & 7) == l7) { if (i < 8) sel0 = sacc; else sel1 = sacc; }
    }
    PD[rc * 128 + 8 * l7 + lg] = sel0;
    PD[rc * 128 + 64 + 8 * l7 + lg] = sel1;
#pragma unroll
    for (int i = 0; i < 16; ++i) ud[i] = udn[i];
    xc0 = xG0; xc1 = xG1; rc = rG;
  }
}
DI void phase_p7coef(const Params& p, int l) {
  char* const WS = opqp(p.ws);
  const int tid = opq(threadIdx.x), lane = tid & 63, w = tid >> 6;
  float* GATE = (float*)(WS + OFF_GATE);
  const float* PD = (const float*)(WS + OFF_PD);
  const bool last = (l == 1);
  const int ntok = NB * (last ? SEQ : (SEQ + NMETA));
  for (int ti = blockIdx.x * 4 + w; ti < ntok; ti += gridDim.x * 4) {
    int b, pp; size_t r; p7_token(ti, last, b, pp, r);
    float d0 = 0.f, d1 = 0.f;
#pragma unroll
    for (int k = 0; k < 8; ++k) { d0 += PD[((size_t)k * MR + r) * 128 + lane]; d1 += PD[((size_t)k * MR + r) * 128 + 64 + lane]; }
    const int ps0 = p7_pos(lane), ps1 = p7_pos(64 + lane);
    const float g0 = GATE[r * 128 + ps0], g1 = GATE[r * 128 + ps1];
    const float a0 = d0 * TINV, a1 = d1 * TINV;
    GATE[r * 128 + ps0] = g0 * 0.5f * a0 * (1.0f + erf_as(a0 * 0.7071067811865476f)) * TINV;
    GATE[r * 128 + ps1] = g1 * 0.5f * a1 * (1.0f + erf_as(a1 * 0.7071067811865476f)) * TINV;
  }
}
DI void phase_p7b(const Params& p, int l) {
  char* const WS = opqp(p.ws);
  const int tid = opq(threadIdx.x), lane = tid & 63, w = tid >> 6;
  const int j = blockIdx.x & 7, wr = (blockIdx.x >> 3) * 4 + w, nwv = (gridDim.x >> 3) * 4;
  const char* TV = WS + OFF_TAB + (size_t)16384 * 1024 + j * 128 + (lane & 7) * 16;
  const int* IDX = (const int*)(WS + OFF_IDX);
  const float* COEF = (const float*)(WS + OFF_GATE);
  u16* OUTB = (u16*)(WS + OFF_YB);
  const bool last = (l == 1);
  const int ntok = NB * (last ? SEQ : (SEQ + NMETA));
  const int l7 = lane & 7, lg = lane >> 3;
#define P7B_LOADI(t, IV, CV, R) { int b_, pp_; p7_token(min((t), ntok - 1), last, b_, pp_, R); \
    _Pragma("unroll") for (int k4 = 0; k4 < 4; ++k4) { IV[k4] = *(const int4*)(IDX + R * 128 + lg * 16 + k4 * 4); CV[k4] = *(const float4*)(COEF + R * 128 + lg * 16 + k4 * 4); } }
#define P7_CFV(CV, i) ((((i) & 3) == 0) ? CV[(i) >> 2].x : ((((i) & 3) == 1) ? CV[(i) >> 2].y : ((((i) & 3) == 2) ? CV[(i) >> 2].z : CV[(i) >> 2].w)))
  int4 idN[4]; float4 cN[4]; size_t rN;
  P7B_LOADI(wr, idN, cN, rN)
  for (int ti = wr; ti < ntok; ti += nwv) {
    uint4 vd[16];
    P7_GATHER(TV, idN, vd)
    float4 cc[4];
#pragma unroll
    for (int k4 = 0; k4 < 4; ++k4) cc[k4] = cN[k4];
    const size_t rc = rN;
    P7B_LOADI(ti + nwv, idN, cN, rN)
    f32x2 acc2[8];
#pragma unroll
    for (int c = 0; c < 8; ++c) acc2[c] = (f32x2){0.f, 0.f};
#pragma unroll
    for (int i = 0; i < 16; ++i) {
      f32x2 f[8]; dec_fp8x16_v2(vd[i], f);
      const float cfi = P7_CFV(cc, i);
      const f32x2 cv = {cfi, cfi};
#pragma unroll
      for (int c = 0; c < 8; ++c) acc2[c] = __builtin_elementwise_fma(cv, f[c], acc2[c]);
    }
    float acc[16];
#pragma unroll
    for (int c = 0; c < 8; ++c) { acc[2 * c] = acc2[c][0]; acc[2 * c + 1] = acc2[c][1]; }
    float r8[8], r4[4];
    {
      const bool hi = (lane & 32) != 0;
#pragma unroll
      for (int k = 0; k < 8; ++k) {
        const float mine = hi ? acc[8 + k] : acc[k], send = hi ? acc[k] : acc[8 + k];
        r8[k] = mine + __uint_as_float(xch32(__float_as_uint(send), hi));
      }
    }
    {
      const bool hi = (lane & 16) != 0;
#pragma unroll
      for (int k = 0; k < 4; ++k) {
        const float mine = hi ? r8[4 + k] : r8[k], send = hi ? r8[k] : r8[4 + k];
        r4[k] = mine + __uint_as_float(xch16(__float_as_uint(send), hi));
      }
    }
    {
      const bool hi = (lane & 8) != 0;
      const float m0 = hi ? r4[2] : r4[0], m1 = hi ? r4[3] : r4[1], s0 = hi ? r4[0] : r4[2], s1 = hi ? r4[1] : r4[3];
      const float o0 = m0 + dpp_get<0x128>(s0);
      const float o1 = m1 + dpp_get<0x128>(s1);
      *(u32*)(OUTB + rc * 1024 + j * 128 + l7 * 16 + 2 * lg) = pack2(o0, o1);
    }
  }
}
DI void phase_p7c(const Params& p, int l) {
  char* const WS = opqp(p.ws);
  const int tid = opq(threadIdx.x), lane = tid & 63, w = tid >> 6;
  const u16* H1 = (const u16*)(WS + OFF_QKV);
  const u16* OUTB = (const u16*)(WS + OFF_YB);
  u16* HB = (u16*)(WS + OFF_HB);
  const bool last = (l == 1);
  const int ntok = NB * (last ? SEQ : (SEQ + NMETA));
  float lg_[16], lb_[16];
  load_gb16(lg_, lb_, p.ln2_g + l * 1024, p.ln2_b + l * 1024, lane);
  auto proc = [&](int b, int pp, size_t r, const uint4& x0, const uint4& x1, const uint4& f0, const uint4& f1) {
    float x[16], f[16];
    unpack8(x0, x); unpack8(x1, x + 8); unpack8(f0, f); unpack8(f1, f + 8);
#pragma unroll
    for (int i = 0; i < 16; ++i) f[i] += ALPHA * x[i];
    ln_row16_reg(f, lg_, lb_);
    if (!last) {
      store_row16_bf16(HB + r * 1024, f, lane);
    } else {
      float* o = p.out + ((size_t)b * SEQ + (pp - 64)) * 1024 + lane * 16;
#pragma unroll
      for (int i4 = 0; i4 < 4; ++i4) *(float4*)(o + i4 * 4) = make_float4(f[i4 * 4], f[i4 * 4 + 1], f[i4 * 4 + 2], f[i4 * 4 + 3]);
    }
  };
  const int stride = gridDim.x * 4;
  for (int ti = blockIdx.x * 4 + w; ti < ntok; ti += 2 * stride) {
    const int tB = min(ti + stride, ntok - 1);
    int bA, ppA, bB, ppB; size_t rA, rB;
    p7_token(ti, last, bA, ppA, rA); p7_token(tB, last, bB, ppB, rB);
    const uint4 xA0 = *(const uint4*)(H1 + rA * 1024 + lane * 16), xA1 = *(const uint4*)(H1 + rA * 1024 + lane * 16 + 8);
    const uint4 fA0 = *(const uint4*)(OUTB + rA * 1024 + lane * 16), fA1 = *(const uint4*)(OUTB + rA * 1024 + lane * 16 + 8);
    const uint4 xB0 = *(const uint4*)(H1 + rB * 1024 + lane * 16), xB1 = *(const uint4*)(H1 + rB * 1024 + lane * 16 + 8);
    const uint4 fB0 = *(const uint4*)(OUTB + rB * 1024 + lane * 16), fB1 = *(const uint4*)(OUTB + rB * 1024 + lane * 16 + 8);
    proc(bA, ppA, rA, xA0, xA1, fA0, fA1);
    if (ti + stride < ntok) proc(bB, ppB, rB, xB0, xB1, fB0, fB1);
  }
}

#define XB_TMO      128
#define XB_XCNT(j)  (256  + 64 * (j))
#define XB_XSUB(j)  (1280 + 64 * (j))
#define XB_XGEN(j)  (2304 + 64 * (j))
#define XB_TOP      3328
#define XB_TOPGEN   3392
#define XCD_BAR_WORDS 3456
#define XB_SPIN_CAP (1u << 22)
#define LAS __attribute__((address_space(3)))
DI unsigned xb_ld(unsigned* p)              { return __hip_atomic_load(p, __ATOMIC_RELAXED, __HIP_MEMORY_SCOPE_AGENT); }
DI unsigned xb_add(unsigned* p, unsigned v) { return __hip_atomic_fetch_add(p, v, __ATOMIC_RELAXED, __HIP_MEMORY_SCOPE_AGENT); }
DI unsigned xb_xcc_id() { return (unsigned)__builtin_amdgcn_s_getreg((3 << 11) | 20) & 0xFu; }
#define XB_SPIN(cond, bar) do { unsigned _sp = 0; while (cond) { __builtin_amdgcn_s_sleep(1); \
    if ((++_sp & 255u) == 0u) { if (xb_ld(&(bar)[XB_TMO])) break; if (_sp > XB_SPIN_CAP) { atomicAdd(&(bar)[XB_TMO], 1u); break; } } } } while (0)
struct XcdBarrier { unsigned* bar; unsigned x; volatile LAS unsigned* st; };
DI XcdBarrier xcd_barrier_post(unsigned* bar, volatile LAS unsigned* st) {
  XcdBarrier b; b.bar = bar; b.x = xb_xcc_id(); b.st = st;
  if (threadIdx.x == 0) (void)xb_add(&bar[XB_XCNT(b.x)], 1u);
  return b;
}
DI void xcd_barrier_complete(unsigned* bar, unsigned x, unsigned& nloc, unsigned& nx) {
  const unsigned G = gridDim.x * gridDim.y * gridDim.z;
  unsigned sum, cnt, mine, sp = 0u;
  for (;;) {
    sum = 0u; cnt = 0u; mine = 0u;
#pragma unroll
    for (unsigned j = 0; j < 16; ++j) { const unsigned c = xb_ld(&bar[XB_XCNT(j)]); sum += c; cnt += (c > 0u) ? 1u : 0u; mine = (j == x) ? c : mine; }
    if (sum == G) break;
    __builtin_amdgcn_s_sleep(1);
    if ((++sp & 255u) == 0u) { if (xb_ld(&bar[XB_TMO])) break; if (sp > XB_SPIN_CAP) { atomicAdd(&bar[XB_TMO], 1u); break; } }
  }
  nloc = mine > 0u ? mine : 1u; nx = cnt > 0u ? cnt : 1u;
}
DI void xcd_barrier(const XcdBarrier& b) {
  asm volatile("s_waitcnt vmcnt(0)" ::: "memory");
  __syncthreads();
  if (threadIdx.x == 0) {
    unsigned* bar = b.bar;
    __builtin_amdgcn_s_waitcnt(0);
    unsigned nloc = b.st[0], nx = b.st[1];
    if (nloc == 0u) { xcd_barrier_complete(bar, b.x, nloc, nx); b.st[0] = nloc; b.st[1] = nx; }
    const unsigned old = xb_add(&bar[XB_XSUB(b.x)], 1u);
    const unsigned gen = old / nloc;
    if (old + 1u == (gen + 1u) * nloc) {
      __builtin_amdgcn_fence(__ATOMIC_RELEASE, "agent");
      asm volatile("s_waitcnt vmcnt(0)" ::: "memory");
      const unsigned og = xb_add(&bar[XB_TOP], 1u);
      const unsigned tg = og / nx;
      if (og + 1u == (tg + 1u) * nx) xb_add(&bar[XB_TOPGEN], 1u);
      else XB_SPIN(xb_ld(&bar[XB_TOPGEN]) == tg, bar);
      __builtin_amdgcn_fence(__ATOMIC_ACQUIRE, "agent");
      xb_add(&bar[XB_XGEN(b.x)], 1u);
      asm volatile("s_waitcnt vmcnt(0)" ::: "memory");
    } else {
      XB_SPIN(xb_ld(&bar[XB_XGEN(b.x)]) == gen, bar);
      __builtin_amdgcn_fence(__ATOMIC_ACQUIRE, "agent");
      asm volatile("s_waitcnt vmcnt(0)" ::: "memory");
    }
  }
  __syncthreads();
}

#ifndef DUP_GEMM
#define DUP_GEMM 0
#endif
#ifndef DUP_P7
#define DUP_P7 0
#endif
#ifndef DUP_SCAN
#define DUP_SCAN 0
#endif
#ifndef DUP_P3
#define DUP_P3 0
#endif
#ifndef DUP_P6
#define DUP_P6 0
#endif
#ifndef DUP_MISC
#define DUP_MISC 0
#endif
template <int l>
DI void layer(const Params& p, char* smem, const XcdBarrier& xb) {
  for (int rep = 0; rep <= DUP_GEMM; ++rep) { gemm_phase<1>(p, OFF_HB, OFF_WIN + l * SZ_WIN1, NPROJP / 128, smem); xcd_barrier(xb); }
  for (int rep = 0; rep <= DUP_MISC; ++rep) { phase_p2(p, l, smem); xcd_barrier(xb); }
  for (int rep = 0; rep <= DUP_P3; ++rep) { phase_p3(p, smem); xcd_barrier(xb); }
  for (int rep = 0; rep <= DUP_SCAN; ++rep) { phase_scan(p, l, smem); xcd_barrier(xb); }
  phase_p5(p, l); xcd_barrier(xb);
  for (int rep = 0; rep <= DUP_GEMM; ++rep) { gemm_phase<2>(p, OFF_YB, OFF_WOUT + l * SZ_WOUT1, 8, smem); xcd_barrier(xb); }
  for (int rep = 0; rep <= DUP_MISC; ++rep) { phase_ln1(p, l); xcd_barrier(xb); }
  for (int rep = 0; rep <= DUP_GEMM; ++rep) { gemm_phase<3>(p, OFF_QKV, OFF_WQ + l * SZ_WQ1, 16, smem); xcd_barrier(xb); }
  for (int rep = 0; rep <= DUP_P6; ++rep) { phase_p6(p, l, smem); xcd_barrier(xb); }
#ifdef P7_GATHER_IC
  for (int rep = 0; rep <= DUP_P7; ++rep) { phase_p7(p, l); if (rep < DUP_P7) xcd_barrier(xb); }
#else
  phase_p7a(p, l); xcd_barrier(xb);
  phase_p7coef(p, l); xcd_barrier(xb);
  phase_p7b(p, l); xcd_barrier(xb);
  phase_p7c(p, l);
#endif
}
__global__ void __launch_bounds__(256, 2) fwd_megakernel(Params p) {
  __shared__ __attribute__((aligned(16))) char smem[78848];
  cg::grid_group grid = cg::this_grid();
  if (threadIdx.x == 0) *(uint4*)(smem + 78832) = make_uint4(0u, 0u, 0u, 0u);
  __syncthreads();
  const XcdBarrier xb = xcd_barrier_post((unsigned*)(p.ws + OFF_BAR), (volatile LAS unsigned*)(smem + 78832));
  phase_prologue(p, smem);
  grid.sync();
  layer<0>(p, smem, xb);
  xcd_barrier(xb);
  layer<1>(p, smem, xb);
}

extern "C" void kernel_launch(void* const* d_in, const int* in_sizes, int n_in, void* d_out,
                              int out_size, void* d_ws, size_t ws_size, hipStream_t stream) {
  static int grid_blocks = 0;
  if (!grid_blocks) {
    int dev = 0, cus = 0, per_cu = 0;
    (void)hipGetDevice(&dev);
    (void)hipDeviceGetAttribute(&cus, hipDeviceAttributeMultiprocessorCount, dev);
    (void)hipOccupancyMaxActiveBlocksPerMultiprocessor(&per_cu, fwd_megakernel, 256, 0);
    if (per_cu > 2) per_cu = 2;
    if (per_cu < 1) per_cu = 1;
    grid_blocks = cus * per_cu;
  }
  if (ws_size < WS_NEED) { fprintf(stderr, "workspace too small\n"); return; }
  Params p{};
  p.x = (const float*)d_in[0]; p.meta = (const float*)d_in[1]; p.ln_in_g = (const float*)d_in[2]; p.ln_in_b = (const float*)d_in[3];
  p.w_in = (const float*)d_in[4]; p.conv_w = (const float*)d_in[5]; p.gdn_conv_w = (const float*)d_in[6]; p.a_log = (const float*)d_in[7];
  p.dt_bias = (const float*)d_in[8]; p.gdn_norm_w = (const float*)d_in[9]; p.w_out = (const float*)d_in[10]; p.ln1_g = (const float*)d_in[11];
  p.ln1_b = (const float*)d_in[12]; p.w_q = (const float*)d_in[13]; p.k1 = (const float*)d_in[14]; p.k2 = (const float*)d_in[15];
  p.pu = (const float*)d_in[16]; p.pv = (const float*)d_in[17]; p.ln2_g = (const float*)d_in[18]; p.ln2_b = (const float*)d_in[19];
  p.out = (float*)d_out; p.ws = (char*)d_ws;
  (void)hipMemsetAsync((char*)d_ws + OFF_BAR, 0, 16384, stream);
  void* args[] = {&p};
  hipError_t e = hipLaunchCooperativeKernel((void*)fwd_megakernel, dim3(grid_blocks), dim3(256), args, 0, stream);
  if (e != hipSuccess) fprintf(stderr, "cooperative launch failed: %s (grid %d)\n", hipGetErrorString(e), grid_blocks);
}
```

```cpp
#include <hip/hip_runtime.h>
#include <hip/hip_cooperative_groups.h>
#include <cstdio>
namespace cg = cooperative_groups;

typedef unsigned short u16;
typedef unsigned int u32;
using bf16x8 = __attribute__((ext_vector_type(8))) short;
using s16x4 = __attribute__((ext_vector_type(4))) short;
using f32x4 = __attribute__((ext_vector_type(4))) float;
using f32x2 = __attribute__((ext_vector_type(2))) float;

#define DI __device__ __forceinline__
#define MFMA16(a, b, c) __builtin_amdgcn_mfma_f32_16x16x32_bf16((a), (b), (c), 0, 0, 0)

constexpr int NB = 4, SEQ = 8192, NMETA = 16, DM = 1024;
constexpr int LP = 8256;
constexpr int PADR = 48;
constexpr int MR = NB * LP;
constexpr int NCH = 129;
constexpr int NPROJ = 3592, NPROJP = 3712;
constexpr float ALPHA = 1.4142135623730951f;
constexpr float LN_EPS = 1e-5f, RMS_EPS = 1e-6f;
constexpr float TSCALE = 64.0f, TINV = 1.0f / 64.0f;

constexpr size_t SZ_HB = (size_t)MR * 1024 * 2;
constexpr size_t OFF_HB = 0;
constexpr size_t OFF_R1 = OFF_HB + SZ_HB;
constexpr size_t SZ_R1 = (size_t)MR * 3072 * 2;
constexpr size_t OFF_ZB = OFF_R1 + SZ_R1;
constexpr size_t SZ_ZB = (size_t)MR * 512 * 2;
constexpr size_t OFF_QKV = OFF_ZB + SZ_ZB;
constexpr size_t SZ_QKV = (size_t)MR * 1536 * 2;
constexpr size_t OFF_YB = OFF_QKV + SZ_QKV;
constexpr size_t OFF_AB = OFF_YB + SZ_HB;
constexpr size_t SZ_AB = (size_t)MR * 8 * 4;
constexpr size_t OFF_GB = OFF_AB + SZ_AB;
constexpr size_t OFF_WIN = OFF_GB + SZ_AB;
constexpr size_t SZ_WIN1 = (size_t)NPROJP * 1024 * 2;
constexpr size_t OFF_WOUT = OFF_WIN + 2 * SZ_WIN1;
constexpr size_t SZ_WOUT1 = (size_t)1024 * 1024 * 2;
constexpr size_t OFF_WQ = OFF_WOUT + 2 * SZ_WOUT1;
constexpr size_t SZ_WQ1 = (size_t)2048 * 1024 * 2;
constexpr size_t OFF_SK = OFF_WQ + 2 * SZ_WQ1;
constexpr size_t SZ_SK1 = (size_t)2 * 128 * 128 * 2;
constexpr size_t OFF_BAR = OFF_SK + 2 * SZ_SK1;
constexpr size_t WS_NEED = OFF_BAR + 16384;
constexpr size_t REC_BYTES = 58368;
constexpr size_t OFF_IDX = OFF_R1 + (size_t)MR * 2048 * 2;
constexpr size_t OFF_GATE = OFF_IDX + (size_t)MR * 128 * 4;
constexpr size_t OFF_TAB = OFF_GATE + (size_t)MR * 128 * 4;
static_assert((size_t)NB * NCH * 4 * REC_BYTES <= SZ_R1, "rec");
static_assert(OFF_GATE + (size_t)MR * 128 * 4 <= OFF_R1 + SZ_R1, "idx");
static_assert(OFF_TAB + (size_t)2 * 16384 * 1024 <= OFF_R1 + SZ_R1, "tab");
static_assert(WS_NEED <= (size_t)512 * 1024 * 1024, "ws");

struct Params {
  const float* x; const float* meta; const float* ln_in_g; const float* ln_in_b;
  const float* w_in; const float* conv_w; const float* gdn_conv_w; const float* a_log; const float* dt_bias;
  const float* gdn_norm_w; const float* w_out; const float* ln1_g; const float* ln1_b;
  const float* w_q; const float* k1; const float* k2; const float* pu; const float* pv;
  const float* ln2_g; const float* ln2_b;
  float* out; char* ws;
};

DI int opq(int x) { asm volatile("" : "+v"(x)); return x; }
DI char* opqp(char* w) { long z = 0; asm volatile("" : "+s"(z)); return w + z; }
DI int opqs(int x) { asm volatile("" : "+s"(x)); return x; }
#define SCHED_FENCE __builtin_amdgcn_sched_barrier(0)
typedef __bf16 hbf16x2 __attribute__((ext_vector_type(2)));
DI u32 pack2(float a, float b) { f32x2 v = {a, b}; hbf16x2 r = __builtin_convertvector(v, hbf16x2); return __builtin_bit_cast(u32, r); }
DI u16 f2bf(float x) { return (u16)(pack2(x, 0.f) & 0xffffu); }
DI float bf2f(u16 h) { return __uint_as_float(((u32)h) << 16); }
DI float bflo(u32 w) { return __uint_as_float(w << 16); }
DI float bfhi(u32 w) { return __uint_as_float(w & 0xffff0000u); }
template <int CTRL, int ROWMASK>
DI float dpp_get_rm(float v) { return __int_as_float(__builtin_amdgcn_update_dpp(0, __float_as_int(v), CTRL, ROWMASK, 0xF, false)); }
DI float red16(float v) {
  v += dpp_get_rm<0xB1, 0xF>(v); v += dpp_get_rm<0x4E, 0xF>(v); v += dpp_get_rm<0x141, 0xF>(v); v += dpp_get_rm<0x140, 0xF>(v);
  return v;
}
DI float wsum(float v) {
  v = red16(v);
  v += dpp_get_rm<0x142, 0xA>(v);
  v += dpp_get_rm<0x143, 0xC>(v);
  return __int_as_float(__builtin_amdgcn_readlane(__float_as_int(v), 63));
}
DI float erf_as(float x) {
  const float ax = fabsf(x);
  const float t = 1.0f / (1.0f + 0.3275911f * ax);
  const float poly = t * (0.254829592f + t * (-0.284496736f + t * (1.421413741f + t * (-1.453152027f + t * 1.061405429f))));
  const float r = 1.0f - poly * __expf(-ax * ax);
  return x < 0.f ? -r : r;
}
template <int CTRL>
DI float dpp_get(float v) { return __int_as_float(__builtin_amdgcn_update_dpp(0, __float_as_int(v), CTRL, 0xF, 0xF, false)); }
DI float red8(float v) { v += dpp_get<0xB1>(v); v += dpp_get<0x4E>(v); v += dpp_get<0x141>(v); return v; }
DI int p7_pos(int s_) { return (s_ & 7) * 16 + ((s_ >> 3) & 7) + ((s_ >> 6) << 3); }
DI u32 xch32(u32 x, bool upper) { auto r = __builtin_amdgcn_permlane32_swap(x, x, false, false); return upper ? r[0] : r[1]; }
DI u32 xch16(u32 x, bool oddrow) { auto r = __builtin_amdgcn_permlane16_swap(x, x, false, false); return oddrow ? r[0] : r[1]; }
DI float siluf(float x) { return x / (1.0f + __expf(-x)); }
DI void unpack8(const uint4& v, float* f) {
  f[0] = bflo(v.x); f[1] = bfhi(v.x); f[2] = bflo(v.y); f[3] = bfhi(v.y);
  f[4] = bflo(v.z); f[5] = bfhi(v.z); f[6] = bflo(v.w); f[7] = bfhi(v.w);
}
DI uint4 pack8(const float* f) {
  uint4 v; v.x = pack2(f[0], f[1]); v.y = pack2(f[2], f[3]); v.z = pack2(f[4], f[5]); v.w = pack2(f[6], f[7]); return v;
}
DI bf16x8 pack_acc2(const f32x4& a, const f32x4& b) {
  uint4 v; v.x = pack2(a[0], a[1]); v.y = pack2(a[2], a[3]); v.z = pack2(b[0], b[1]); v.w = pack2(b[2], b[3]);
  return __builtin_bit_cast(bf16x8, v);
}
DI bf16x8 read2x4(const u16* p, int c0, int c1) {
  uint2 lo = *(const uint2*)(p + c0);
  uint2 hi = *(const uint2*)(p + c1);
  uint4 v; v.x = lo.x; v.y = lo.y; v.z = hi.x; v.w = hi.y;
  return __builtin_bit_cast(bf16x8, v);
}
DI u32 enc_fp8x4(float a, float b, float c, float d) {
  int v = 0;
  v = __builtin_amdgcn_cvt_pk_fp8_f32(a, b, v, false);
  v = __builtin_amdgcn_cvt_pk_fp8_f32(c, d, v, true);
  return (u32)v;
}
DI void dec_fp8x16(const uint4& v, float* f) {
  f32x2 t;
  t = __builtin_amdgcn_cvt_pk_f32_fp8((int)v.x, false); f[0] = t[0]; f[1] = t[1];
  t = __builtin_amdgcn_cvt_pk_f32_fp8((int)v.x, true);  f[2] = t[0]; f[3] = t[1];
  t = __builtin_amdgcn_cvt_pk_f32_fp8((int)v.y, false); f[4] = t[0]; f[5] = t[1];
  t = __builtin_amdgcn_cvt_pk_f32_fp8((int)v.y, true);  f[6] = t[0]; f[7] = t[1];
  t = __builtin_amdgcn_cvt_pk_f32_fp8((int)v.z, false); f[8] = t[0]; f[9] = t[1];
  t = __builtin_amdgcn_cvt_pk_f32_fp8((int)v.z, true);  f[10] = t[0]; f[11] = t[1];
  t = __builtin_amdgcn_cvt_pk_f32_fp8((int)v.w, false); f[12] = t[0]; f[13] = t[1];
  t = __builtin_amdgcn_cvt_pk_f32_fp8((int)v.w, true);  f[14] = t[0]; f[15] = t[1];
}
DI void dec_fp8x16_v2(const uint4& v, f32x2* f) {
  f[0] = __builtin_amdgcn_cvt_pk_f32_fp8((int)v.x, false); f[1] = __builtin_amdgcn_cvt_pk_f32_fp8((int)v.x, true);
  f[2] = __builtin_amdgcn_cvt_pk_f32_fp8((int)v.y, false); f[3] = __builtin_amdgcn_cvt_pk_f32_fp8((int)v.y, true);
  f[4] = __builtin_amdgcn_cvt_pk_f32_fp8((int)v.z, false); f[5] = __builtin_amdgcn_cvt_pk_f32_fp8((int)v.z, true);
  f[6] = __builtin_amdgcn_cvt_pk_f32_fp8((int)v.w, false); f[7] = __builtin_amdgcn_cvt_pk_f32_fp8((int)v.w, true);
}
DI u32 orderable(float f) { u32 u = __float_as_uint(f); return u ^ ((u >> 31) ? 0xffffffffu : 0x80000000u); }
#define INS16(v, xx) { u32 _x = (xx); _Pragma("unroll") for (int _i = 0; _i < 16; ++_i) { u32 _h = max(v[_i], _x); _x = min(v[_i], _x); v[_i] = _h; } }

DI void ln_row16(float* v, const float* __restrict__ g, const float* __restrict__ b, int lane) {
  float s = 0.f;
#pragma unroll
  for (int i = 0; i < 16; ++i) s += v[i];
  float mu = wsum(s) * (1.0f / 1024.0f);
  float q = 0.f;
#pragma unroll
  for (int i = 0; i < 16; ++i) { float d = v[i] - mu; q += d * d; }
  float var = wsum(q) * (1.0f / 1024.0f);
  float rs = rsqrtf(var + LN_EPS);
#pragma unroll
  for (int i4 = 0; i4 < 4; ++i4) {
    float4 gg = *(const float4*)(g + lane * 16 + i4 * 4);
    float4 bb = *(const float4*)(b + lane * 16 + i4 * 4);
    v[i4 * 4 + 0] = (v[i4 * 4 + 0] - mu) * rs * gg.x + bb.x;
    v[i4 * 4 + 1] = (v[i4 * 4 + 1] - mu) * rs * gg.y + bb.y;
    v[i4 * 4 + 2] = (v[i4 * 4 + 2] - mu) * rs * gg.z + bb.z;
    v[i4 * 4 + 3] = (v[i4 * 4 + 3] - mu) * rs * gg.w + bb.w;
  }
}
DI void load_gb16(float* g, float* b, const float* __restrict__ gp, const float* __restrict__ bp, int lane) {
#pragma unroll
  for (int i4 = 0; i4 < 4; ++i4) {
    float4 gg = *(const float4*)(gp + lane * 16 + i4 * 4);
    float4 bb = *(const float4*)(bp + lane * 16 + i4 * 4);
    g[i4 * 4] = gg.x; g[i4 * 4 + 1] = gg.y; g[i4 * 4 + 2] = gg.z; g[i4 * 4 + 3] = gg.w;
    b[i4 * 4] = bb.x; b[i4 * 4 + 1] = bb.y; b[i4 * 4 + 2] = bb.z; b[i4 * 4 + 3] = bb.w;
  }
}
DI void ln_row16_reg(float* v, const float* g, const float* b) {
  float s = 0.f;
#pragma unroll
  for (int i = 0; i < 16; ++i) s += v[i];
  const float mu = wsum(s) * (1.0f / 1024.0f);
  float q = 0.f;
#pragma unroll
  for (int i = 0; i < 16; ++i) { const float d = v[i] - mu; q += d * d; }
  const float var = wsum(q) * (1.0f / 1024.0f);
  const float rs = rsqrtf(var + LN_EPS);
#pragma unroll
  for (int i = 0; i < 16; ++i) v[i] = (v[i] - mu) * rs * g[i] + b[i];
}
DI void store_row16_bf16(u16* dst, const float* v, int lane) {
  *(uint4*)(dst + lane * 16) = pack8(v);
  *(uint4*)(dst + lane * 16 + 8) = pack8(v + 8);
}

DI void transpose_convert(const float* __restrict__ W, int K, int N, int Npad, u16* __restrict__ Wt, char* smem) {
  float* tile = (float*)smem;
  const int tid = opq(threadIdx.x);
  const int ntn = Npad / 64, ntk = K / 64;
  for (int t = blockIdx.x; t < ntn * ntk; t += gridDim.x) {
    const int n0 = (t % ntn) * 64, k0 = (t / ntn) * 64;
#pragma unroll 4
    for (int i = 0; i < 16; ++i) {
      int idx = tid + i * 256; int kk = idx >> 6, nn = idx & 63;
      float val = (n0 + nn < N) ? W[(size_t)(k0 + kk) * N + n0 + nn] : 0.f;
      tile[kk * 65 + nn] = val;
    }
    __syncthreads();
#pragma unroll 4
    for (int i = 0; i < 16; ++i) {
      int idx = tid + i * 256; int nn = idx >> 6, kk = idx & 63;
      Wt[(size_t)(n0 + nn) * K + k0 + kk] = f2bf(tile[kk * 65 + nn]);
    }
    __syncthreads();
  }
}

DI void phase_prologue(const Params& p, char* smem) {
  char* const WS = opqp(p.ws);
  const int tid = opq(threadIdx.x), lane = tid & 63, w = tid >> 6;
  u16* HB = (u16*)(WS + OFF_HB);
  float lg[16], lb[16];
  load_gb16(lg, lb, p.ln_in_g, p.ln_in_b, lane);
  for (int r = blockIdx.x * 4 + w; r < MR; r += gridDim.x * 4) {
    const int b = r / LP, pp = r % LP;
    float v[16];
    if (pp < PADR) {
#pragma unroll
      for (int i = 0; i < 16; ++i) v[i] = 0.f;
    } else {
      const float* src = (pp < 64) ? (p.meta + (size_t)(pp - PADR) * DM) : (p.x + ((size_t)b * SEQ + (pp - 64)) * DM);
#pragma unroll
      for (int i4 = 0; i4 < 4; ++i4) {
        float4 t = *(const float4*)(src + lane * 16 + i4 * 4);
        v[i4 * 4] = t.x; v[i4 * 4 + 1] = t.y; v[i4 * 4 + 2] = t.z; v[i4 * 4 + 3] = t.w;
      }
      ln_row16_reg(v, lg, lb);
    }
    store_row16_bf16(HB + (size_t)r * DM, v, lane);
  }
  for (int l = 0; l < 2; ++l) {
    transpose_convert(p.w_in + (size_t)l * 1024 * NPROJ, 1024, NPROJ, NPROJP, (u16*)(WS + OFF_WIN + l * SZ_WIN1), smem);
    transpose_convert(p.w_out + (size_t)l * 1024 * 1024, 1024, 1024, 1024, (u16*)(WS + OFF_WOUT + l * SZ_WOUT1), smem);
    transpose_convert(p.w_q + (size_t)l * 1024 * 2048, 1024, 2048, 2048, (u16*)(WS + OFF_WQ + l * SZ_WQ1), smem);
  }
  u16* SK = (u16*)(WS + OFF_SK);
  for (int i = blockIdx.x * 256 + tid; i < 2 * 2 * 16384; i += gridDim.x * 256) {
    int l = i >> 15, rem = i & 32767, hf = rem >> 14, e = rem & 16383;
    const float* src = (hf ? p.k2 : p.k1) + (size_t)l * 16384;
    SK[i] = f2bf(src[e]);
  }
}

DI void convert_tables(const Params& p, int l, int first_block) {
  char* const WS = opqp(p.ws);
  u32* TAB = (u32*)(WS + OFF_TAB);
  const size_t n16 = (size_t)2 * 16384 * 1024 / 16;
  for (size_t i = (size_t)((opqs(blockIdx.x) - first_block) * 256 + opq(threadIdx.x)); i < n16; i += (size_t)(gridDim.x - first_block) * 256) {
    const size_t e0 = i * 16;
    const int which = (int)(e0 >> 24);
    const size_t off = e0 & (((size_t)1 << 24) - 1);
    const float* src = (which ? p.pv : p.pu) + (size_t)l * 16384 * 1024 + off;
    uint4 o;
    float4 a = *(const float4*)(src), b = *(const float4*)(src + 4), c = *(const float4*)(src + 8), d = *(const float4*)(src + 12);
    o.x = enc_fp8x4(a.x * TSCALE, a.y * TSCALE, a.z * TSCALE, a.w * TSCALE);
    o.y = enc_fp8x4(b.x * TSCALE, b.y * TSCALE, b.z * TSCALE, b.w * TSCALE);
    o.z = enc_fp8x4(c.x * TSCALE, c.y * TSCALE, c.z * TSCALE, c.w * TSCALE);
    o.w = enc_fp8x4(d.x * TSCALE, d.y * TSCALE, d.z * TSCALE, d.w * TSCALE);
    *(uint4*)(TAB + i * 4) = o;
  }
}

template <int EPI>
DI void gemm_phase(const Params& p, size_t offA, size_t offB, int ntn, char* smem) {
  char* const WS = opqp(p.ws);
  const u16* __restrict__ A = (const u16*)(WS + offA);
  const u16* __restrict__ Bt = (const u16*)(WS + offB);
  constexpr int K = 1024, LDS_ST = 64;
  u16* As = (u16*)smem;
  u16* Bs = As + 2 * 128 * LDS_ST;
  const int tid = opq(threadIdx.x), lane = tid & 63, w = tid >> 6, wm = w >> 1, wn = w & 1;
  const int l15 = lane & 15, q = lane >> 4;
  const int ntm = MR / 128;
  const int T_ = ntm * ntn;
  const int NX = ((gridDim.x & 7) == 0) ? 8 : 1;
  const int xcd = blockIdx.x % NX, bi = blockIdx.x / NX, nbx = gridDim.x / NX;
  const int pbeg = (xcd * T_) / NX, pend = ((xcd + 1) * T_) / NX;
  for (int pos = pbeg + bi; pos < pend; pos += nbx) {
    const int nig = 8 * ntn, gid = pos / nig, fm = gid * 8, gsz = min(8, ntm - fm), rem = pos - gid * nig;
    const int tm = fm + rem % gsz, tn = rem / gsz;
    const u16* Ag = A + (size_t)(tm * 128) * K;
    const u16* Bg = Bt + (size_t)(tn * 128) * K;
    f32x4 acc[4][4];
#pragma unroll
    for (int i = 0; i < 4; ++i)
#pragma unroll
      for (int j = 0; j < 4; ++j) acc[i][j] = (f32x4){0.f, 0.f, 0.f, 0.f};
    const int lrow = tid >> 3;
    const int gsw = ((tid & 7) ^ ((lrow >> 1) & 7)) * 8;
    const int rsw = (l15 >> 1) & 7;
    const u16* Agl = Ag + (size_t)lrow * K + gsw;
    const u16* Bgl = Bg + (size_t)lrow * K + gsw;
    u16* Al = As + tid * 8;
    u16* Bl = Bs + tid * 8;
#define G_DMA(buf, k0) { _Pragma("unroll") for (int i_ = 0; i_ < 4; ++i_) { \
      __builtin_amdgcn_global_load_lds((const unsigned*)(Agl + (size_t)(32 * i_) * K + (k0)), (unsigned*)(Al + (buf) * 8192 + i_ * 2048), 16, 0, 0); \
      __builtin_amdgcn_global_load_lds((const unsigned*)(Bgl + (size_t)(32 * i_) * K + (k0)), (unsigned*)(Bl + (buf) * 8192 + i_ * 2048), 16, 0, 0); } }
#define G_COMPUTE(buf) { const u16* Ac = As + (buf) * 128 * LDS_ST; const u16* Bc = Bs + (buf) * 128 * LDS_ST; \
      _Pragma("unroll") for (int kk = 0; kk < 2; ++kk) { \
        bf16x8 af[4], bfr[4]; \
        _Pragma("unroll") for (int mt = 0; mt < 4; ++mt) af[mt] = *(const bf16x8*)(Ac + (wm * 64 + mt * 16 + l15) * LDS_ST + (((kk * 4 + q) ^ rsw) * 8)); \
        _Pragma("unroll") for (int nt = 0; nt < 4; ++nt) bfr[nt] = *(const bf16x8*)(Bc + (wn * 64 + nt * 16 + l15) * LDS_ST + (((kk * 4 + q) ^ rsw) * 8)); \
        _Pragma("unroll") for (int mt = 0; mt < 4; ++mt) \
          _Pragma("unroll") for (int nt = 0; nt < 4; ++nt) acc[mt][nt] = MFMA16(bfr[nt], af[mt], acc[mt][nt]); } }
    constexpr int nk = K / 64;
    G_DMA(0, 0)
    asm volatile("s_waitcnt vmcnt(0)" ::: "memory");
    __syncthreads();
    for (int kt = 0; kt < nk; ++kt) {
      const int cur = kt & 1;
      if (kt + 1 < nk) G_DMA(cur ^ 1, (kt + 1) * 64)
      G_COMPUTE(cur)
      asm volatile("s_waitcnt vmcnt(0)" ::: "memory");
      __syncthreads();
    }
#pragma unroll
    for (int mt = 0; mt < 4; ++mt) {
      const size_t m = (size_t)tm * 128 + wm * 64 + mt * 16 + l15;
#pragma unroll
      for (int nt = 0; nt < 4; ++nt) {
        const int n = tn * 128 + wn * 64 + nt * 16 + q * 4;
        const f32x4 a = acc[mt][nt];
        if (EPI == 1) {
          if (tn < 24) {
            uint2 o; o.x = pack2(a[0], a[1]); o.y = pack2(a[2], a[3]);
            *(uint2*)((u16*)(WS + OFF_R1) + m * 3072 + n) = o;
          } else if (tn < 28) {
            uint2 o; o.x = pack2(a[0], a[1]); o.y = pack2(a[2], a[3]);
            *(uint2*)((u16*)(WS + OFF_ZB) + m * 512 + (n - 3072)) = o;
          } else {
            if (n - 3584 < 8) *(float4*)((float*)(WS + OFF_AB) + m * 8 + (n - 3584)) = make_float4(a[0], a[1], a[2], a[3]);
          }
        } else if (EPI == 2) {
          uint2 o; o.x = pack2(a[0], a[1]); o.y = pack2(a[2], a[3]);
          *(uint2*)((u16*)(WS + OFF_R1) + m * 1024 + n) = o;
        } else {
          uint2 o; o.x = pack2(a[0], a[1]); o.y = pack2(a[2], a[3]);
          *(uint2*)((u16*)(WS + OFF_R1) + m * 2048 + n) = o;
        }
      }
    }
  }
}

DI void phase_p2(const Params& p, int l, char* smem) {
  char* const WS = opqp(p.ws);
  const int tid = opq(threadIdx.x), lane = tid & 63, w = tid >> 6;
  float* cw = (float*)smem;
  float* gw = cw + 3 * 512;
  {
    const float* cwg = p.conv_w + (size_t)l * 3 * 512;
    const float* gwg = p.gdn_conv_w + (size_t)l * 4 * 1536;
    for (int i = tid; i < 3 * 512 / 4; i += 256) *(float4*)(cw + i * 4) = *(const float4*)(cwg + i * 4);
    for (int i = tid; i < 4 * 1536 / 4; i += 256) *(float4*)(gw + i * 4) = *(const float4*)(gwg + i * 4);
  }
  __syncthreads();
  const u16* R1 = (const u16*)(WS + OFF_R1);
  u16* QKV = (u16*)(WS + OFF_QKV);
  u16* YB = (u16*)(WS + OFF_YB);
  const float* AB = (const float*)(WS + OFF_AB);
  float* GB = (float*)(WS + OFF_GB);
  const int c0 = lane * 8;
  const float alog = (lane < 4) ? p.a_log[l * 4 + lane] : 0.f, dtb = (lane < 4) ? p.dt_bias[l * 4 + lane] : 0.f;
  const int gwv = blockIdx.x * 4 + w, nwv = gridDim.x * 4;
  const int rchunk = (int)(((unsigned)MR + (unsigned)nwv - 1u) / (unsigned)nwv);
  const int r_beg = min(MR, gwv * rchunk), r_end = min(MR, r_beg + rchunk);
  if (r_beg >= r_end) return;
  const uint4 z4 = make_uint4(0, 0, 0, 0);
  uint4 wq0[3], wq1[3], wq2[3];
  float pm2[8], pm1[8];
  {
    const size_t rm3 = (size_t)max(r_beg - 3, 0), rm2 = (size_t)max(r_beg - 2, 0), rm1 = (size_t)max(r_beg - 1, 0);
#pragma unroll
    for (int part = 0; part < 3; ++part) {
      const int c = 1536 + part * 512 + c0;
      wq0[part] = *(const uint4*)(R1 + rm3 * 3072 + c);
      wq1[part] = *(const uint4*)(R1 + rm2 * 3072 + c);
      wq2[part] = *(const uint4*)(R1 + rm1 * 3072 + c);
    }
    float a8[8], b8[8];
    unpack8(*(const uint4*)(R1 + rm2 * 3072 + 512 + c0), a8);
    unpack8(*(const uint4*)(R1 + rm2 * 3072 + 1024 + c0), b8);
#pragma unroll
    for (int i = 0; i < 8; ++i) pm2[i] = a8[i] * b8[i];
    unpack8(*(const uint4*)(R1 + rm1 * 3072 + 512 + c0), a8);
    unpack8(*(const uint4*)(R1 + rm1 * 3072 + 1024 + c0), b8);
#pragma unroll
    for (int i = 0; i < 8; ++i) pm1[i] = a8[i] * b8[i];
  }
  uint4 n_cb, n_cc, n_ch, n_q, n_k, n_v; float n_ab = 0.f;
#define P2_LOAD(rr) { const u16* rp_ = R1 + (size_t)(rr) * 3072 + c0; \
    n_cb = *(const uint4*)(rp_); n_cc = *(const uint4*)(rp_ + 512); n_ch = *(const uint4*)(rp_ + 1024); \
    n_q = *(const uint4*)(rp_ + 1536); n_k = *(const uint4*)(rp_ + 2048); n_v = *(const uint4*)(rp_ + 2560); \
    if (lane < 8) n_ab = AB[(size_t)(rr) * 8 + lane]; }
  P2_LOAD(r_beg)
  for (int r = r_beg; r < r_end; ++r) {
    const uint4 cbv = n_cb, ccv = n_cc, chv = n_ch;
    uint4 raw[3]; raw[0] = n_q; raw[1] = n_k; raw[2] = n_v;
    const float abv = n_ab;
    P2_LOAD(min(r + 1, r_end - 1))
    const bool padrow = (r % LP) < PADR;
    float prod[8];
    {
      float cb[8], cc[8], ch[8], y[8];
      unpack8(cbv, cb); unpack8(ccv, cc); unpack8(chv, ch);
      float m0[8], m1[8], m2[8];
      { const float4 a = *(const float4*)(cw + c0), b4 = *(const float4*)(cw + c0 + 4); m0[0] = a.x; m0[1] = a.y; m0[2] = a.z; m0[3] = a.w; m0[4] = b4.x; m0[5] = b4.y; m0[6] = b4.z; m0[7] = b4.w; }
      { const float4 a = *(const float4*)(cw + 512 + c0), b4 = *(const float4*)(cw + 512 + c0 + 4); m1[0] = a.x; m1[1] = a.y; m1[2] = a.z; m1[3] = a.w; m1[4] = b4.x; m1[5] = b4.y; m1[6] = b4.z; m1[7] = b4.w; }
      { const float4 a = *(const float4*)(cw + 1024 + c0), b4 = *(const float4*)(cw + 1024 + c0 + 4); m2[0] = a.x; m2[1] = a.y; m2[2] = a.z; m2[3] = a.w; m2[4] = b4.x; m2[5] = b4.y; m2[6] = b4.z; m2[7] = b4.w; }
#pragma unroll
      for (int i = 0; i < 8; ++i) {
        prod[i] = cc[i] * ch[i];
        y[i] = cb[i] * (m0[i] * pm2[i] + m1[i] * pm1[i] + m2[i] * prod[i]);
      }
      uint4 yo = pack8(y);
      if (padrow) { yo = z4; *(uint4*)(YB + (size_t)r * 1024 + 512 + c0) = z4; }
      *(uint4*)(YB + (size_t)r * 1024 + c0) = yo;
    }
    SCHED_FENCE;
#pragma unroll
    for (int part = 0; part < 3; ++part) {
      const int c = part * 512 + c0;
      float acc[8], xv[8];
#pragma unroll
      for (int i = 0; i < 8; ++i) acc[i] = 0.f;
#pragma unroll
      for (int j = 0; j < 4; ++j) {
        unpack8(j == 0 ? wq0[part] : (j == 1 ? wq1[part] : (j == 2 ? wq2[part] : raw[part])), xv);
        const float4 w0 = *(const float4*)(gw + j * 1536 + c), w1 = *(const float4*)(gw + j * 1536 + c + 4);
        const float ww[8] = {w0.x, w0.y, w0.z, w0.w, w1.x, w1.y, w1.z, w1.w};
#pragma unroll
        for (int i = 0; i < 8; ++i) acc[i] += ww[i] * xv[i];
      }
      float ss = 0.f;
#pragma unroll
      for (int i = 0; i < 8; ++i) { acc[i] = siluf(acc[i]); ss += acc[i] * acc[i]; }
      if (part < 2) {
        ss = red16(ss);
        float sc = rsqrtf(ss + RMS_EPS);
        if (part == 0) sc *= 0.08838834764831845f;
#pragma unroll
        for (int i = 0; i < 8; ++i) acc[i] *= sc;
      }
      uint4 qo = pack8(acc);
      if (padrow) qo = z4;
      *(uint4*)(QKV + (size_t)r * 1536 + c) = qo;
      SCHED_FENCE;
    }
    {
      const float a_l = __shfl(abv, lane & 3), b_l = __shfl(abv, 4 + (lane & 3));
      if (lane < 4) {
        const float xx = a_l + dtb;
        const float tt = __expf(-fabsf(xx));
        const float l1p = (tt < 0.01f) ? tt * (1.0f - tt * (0.5f - tt * 0.33333333f)) : __logf(1.0f + tt);
        const float sp = fmaxf(xx, 0.f) + l1p;
        GB[(size_t)r * 8 + lane] = padrow ? 0.f : -__expf(alog) * sp;
        GB[(size_t)r * 8 + 4 + lane] = padrow ? 0.f : 1.0f / (1.0f + __expf(-b_l));
      }
    }
#pragma unroll
    for (int part = 0; part < 3; ++part) { wq0[part] = wq1[part]; wq1[part] = wq2[part]; wq2[part] = raw[part]; }
#pragma unroll
    for (int i = 0; i < 8; ++i) { pm2[i] = pm1[i]; pm1[i] = prod[i]; }
  }
}

DI void phase_p3(const Params& p, char* smem) {
  char* const WS = opqp(p.ws);
  constexpr int ST = 136, AST = 68;
  u16* kb = (u16*)smem;
  u16* qb = kb + 64 * ST;
  u16* kbb = qb + 64 * ST;
  float* As = (float*)(kbb + 64 * ST);
  float* s_gc = As + 64 * AST;
  float* s_bt = s_gc + 64;
  const int tid = opq(threadIdx.x), lane = tid & 63, w = tid >> 6, l15 = lane & 15, q = lane >> 4;
  const u16* QKV = (const u16*)(WS + OFF_QKV);
  const float* GB = (const float*)(WS + OFF_GB);
  for (int task = blockIdx.x; task < NB * NCH * 4; task += gridDim.x) {
    const int h = task & 3, bn = task >> 2, b = bn / NCH, n = bn % NCH;
    const size_t row0 = (size_t)b * LP + (size_t)n * 64;
    char* rec = WS + OFF_R1 + (size_t)task * REC_BYTES;
    u16* rec_u = (u16*)rec; u16* rec_w = rec_u + 8192; u16* rec_kT = rec_w + 8192; u16* rec_at = rec_kT + 8192;
    float* rec_eg = (float*)(rec + 57344); float* rec_egl = rec_eg + 64; float* rec_gl = rec_egl + 64;
    const int npad = (n == 0) ? PADR : 0;
    if (tid < 64) {
      const bool pad = tid < npad;
      float g = pad ? 0.f : GB[(row0 + tid) * 8 + h];
      float bt = pad ? 0.f : GB[(row0 + tid) * 8 + 4 + h];
#pragma unroll
      for (int o = 1; o < 64; o <<= 1) { float t = __shfl_up(g, o); if (lane >= o) g += t; }
      s_gc[tid] = g; s_bt[tid] = bt;
      const float gl = __shfl(g, 63);
      rec_eg[tid] = __expf(g);
      rec_egl[tid] = __expf(gl - g);
      if (tid == 0) rec_gl[0] = __expf(gl);
    }
    __syncthreads();
#pragma unroll
    for (int i = 0; i < 4; ++i) {
      int idx = tid + i * 256; int row = idx >> 4, c = idx & 15;
      uint4 kv = make_uint4(0, 0, 0, 0), qv = make_uint4(0, 0, 0, 0);
      if (row >= npad) {
        kv = *(const uint4*)(QKV + (row0 + row) * 1536 + 512 + h * 128 + c * 8);
        qv = *(const uint4*)(QKV + (row0 + row) * 1536 + h * 128 + c * 8);
      }
      *(uint4*)(kb + row * ST + c * 8) = kv;
      *(uint4*)(qb + row * ST + c * 8) = qv;
      float kf[8]; unpack8(kv, kf);
      const float bt = s_bt[row];
#pragma unroll
      for (int j = 0; j < 8; ++j) kf[j] *= bt;
      *(uint4*)(kbb + row * ST + c * 8) = pack8(kf);
    }
    __syncthreads();
#pragma unroll
    for (int it = 0; it < 4; ++it) {
      int idx = tid + it * 256; int d = idx >> 3, i8 = idx & 7;
      u32 t[4];
#pragma unroll
      for (int jj = 0; jj < 4; ++jj) t[jj] = (u32)kb[(i8 * 8 + 2 * jj) * ST + d] | ((u32)kb[(i8 * 8 + 2 * jj + 1) * ST + d] << 16);
      *(uint4*)(rec_kT + d * 64 + i8 * 8) = make_uint4(t[0], t[1], t[2], t[3]);
    }
    {
      const int mat = w >> 1;
      const u16* src = mat ? qb : kbb;
      f32x4 acc[2][4];
#pragma unroll
      for (int i = 0; i < 2; ++i)
#pragma unroll
        for (int j = 0; j < 4; ++j) acc[i][j] = (f32x4){0.f, 0.f, 0.f, 0.f};
#pragma unroll
      for (int ks = 0; ks < 4; ++ks) {
        bf16x8 a[2], bb[4];
#pragma unroll
        for (int mi = 0; mi < 2; ++mi) a[mi] = *(const bf16x8*)(src + (((w & 1) * 2 + mi) * 16 + l15) * ST + ks * 32 + q * 8);
#pragma unroll
        for (int nt = 0; nt < 4; ++nt) bb[nt] = *(const bf16x8*)(kb + (nt * 16 + l15) * ST + ks * 32 + q * 8);
#pragma unroll
        for (int mi = 0; mi < 2; ++mi)
#pragma unroll
          for (int nt = 0; nt < 4; ++nt) acc[mi][nt] = MFMA16(a[mi], bb[nt], acc[mi][nt]);
      }
#pragma unroll
      for (int mi = 0; mi < 2; ++mi)
#pragma unroll
        for (int nt = 0; nt < 4; ++nt)
#pragma unroll
          for (int r = 0; r < 4; ++r) {
            const int i = ((w & 1) * 2 + mi) * 16 + q * 4 + r, j = nt * 16 + l15;
            const float dec = __expf(s_gc[i] - s_gc[j]);
            if (mat == 0) As[i * AST + j] = (i > j) ? acc[mi][nt][r] * dec : 0.f;
            else rec_at[i * 64 + j] = f2bf((i >= j) ? acc[mi][nt][r] * dec : 0.f);
          }
    }
    __syncthreads();
    {
      const int mat = tid >> 7, c = tid & 127;
      float x[64];
      if (mat == 0) {
#pragma unroll
        for (int i = 0; i < 64; ++i) {
          const float vv = (i >= npad) ? bf2f(QKV[(row0 + i) * 1536 + 1024 + h * 128 + c]) : 0.f;
          x[i] = vv * s_bt[i];
        }
      } else {
#pragma unroll
        for (int i = 0; i < 64; ++i) x[i] = bf2f(kb[i * ST + c]) * s_bt[i] * __expf(s_gc[i]);
      }
#pragma unroll
      for (int i = 1; i < 64; ++i) {
        float s = x[i];
#pragma unroll
        for (int j4 = 0; j4 < (i + 3) / 4; ++j4) {
          const float4 a = *(const float4*)(As + i * AST + j4 * 4);
          s -= a.x * x[j4 * 4 + 0];
          if (j4 * 4 + 1 < i) s -= a.y * x[j4 * 4 + 1];
          if (j4 * 4 + 2 < i) s -= a.z * x[j4 * 4 + 2];
          if (j4 * 4 + 3 < i) s -= a.w * x[j4 * 4 + 3];
        }
        x[i] = s;
        if ((i & 3) == 3) SCHED_FENCE;
      }
      if (mat) {
#pragma unroll
        for (int i = 0; i < 64; ++i) rec_w[i * 128 + c] = f2bf(x[i]);
      } else {
        const int ug = c >> 4, ul = c & 15;
#pragma unroll
        for (int mt = 0; mt < 4; ++mt)
#pragma unroll
          for (int qq = 0; qq < 4; ++qq) {
            const int i0 = mt * 16 + qq * 4;
            uint2 o; o.x = pack2(x[i0], x[i0 + 1]); o.y = pack2(x[i0 + 2], x[i0 + 3]);
            *(uint2*)(rec_u + ((ug * 64 + qq * 16 + ul) * 16 + mt * 4)) = o;
          }
      }
    }
    __syncthreads();
  }
}

DI void phase_scan(const Params& p, int l, char* smem) {
  char* const WS = opqp(p.ws);
  if (blockIdx.x >= 32) { convert_tables(p, l, 32); return; }
  constexpr int ST = 136, ST2 = 72;
  u16* ws_ = (u16*)smem;
  u16* qs_ = ws_ + 64 * ST;
  u16* kts = qs_ + 64 * ST;
  u16* ats = kts + 128 * ST2;
  float* scl = (float*)(ats + 64 * ST2);
  const int tid = opq(threadIdx.x), lane = tid & 63, w = tid >> 6, l15 = lane & 15, q = lane >> 4;
  const int b = blockIdx.x >> 3, h = (blockIdx.x >> 1) & 3, half = blockIdx.x & 1;
  const u16* QKV = (const u16*)(WS + OFF_QKV);
  u16* YB = (u16*)(WS + OFF_YB);
  const int uoff = ((half * 4 + w) * 64 + lane) * 16;
  f32x4 S[8];
#pragma unroll
  for (int i = 0; i < 8; ++i) S[i] = (f32x4){0.f, 0.f, 0.f, 0.f};
  uint4 uc0, uc1;
  {
    const int task = ((b * NCH) << 2) + h;
    const size_t row0 = (size_t)b * LP;
    const char* rec = WS + OFF_R1 + (size_t)task * REC_BYTES;
    const u16* rec_u = (const u16*)rec; const u16* rec_w = rec_u + 8192; const u16* rec_kT = rec_w + 8192; const u16* rec_at = rec_kT + 8192;
    const float* rec_eg = (const float*)(rec + 57344);
#pragma unroll
    for (int i = 0; i < 4; ++i) {
      int idx = tid + i * 256; int row = idx >> 4, c = idx & 15;
      *(uint4*)(ws_ + row * ST + c * 8) = *(const uint4*)(rec_w + row * 128 + c * 8);
      *(uint4*)(qs_ + row * ST + c * 8) = *(const uint4*)(QKV + (row0 + row) * 1536 + h * 128 + c * 8);
      int rk = idx >> 3, ck = idx & 7;
      *(uint4*)(kts + rk * ST2 + ck * 8) = *(const uint4*)(rec_kT + rk * 64 + ck * 8);
    }
#pragma unroll
    for (int i = 0; i < 2; ++i) { int idx = tid + i * 256; int row = idx >> 3, c = idx & 7; *(uint4*)(ats + row * ST2 + c * 8) = *(const uint4*)(rec_at + row * 64 + c * 8); }
    if (tid < 129) scl[tid] = rec_eg[tid];
    uc0 = *(const uint4*)(rec_u + uoff); uc1 = *(const uint4*)(rec_u + uoff + 8);
  }
  __syncthreads();
  for (int n = 0; n < NCH; ++n) {
    const int cur = n & 1;
    const bool has_next = (n + 1 < NCH);
    const size_t row0 = (size_t)b * LP + (size_t)n * 64;
    const int taskn = ((b * NCH + (has_next ? n + 1 : n)) << 2) + h;
    const char* recn = WS + OFF_R1 + (size_t)taskn * REC_BYTES;
    const u16* recn_u = (const u16*)recn; const u16* recn_w = recn_u + 8192; const u16* recn_kT = recn_w + 8192; const u16* recn_at = recn_kT + 8192;
    const float* recn_eg = (const float*)(recn + 57344);
    const size_t row0n = has_next ? row0 + 64 : row0;
    const float* egs = scl + cur * 132;
    const float* egls = egs + 64;
    uint4 ra0, ra1, ra2, ra3, ra4, ra5, ra6, ra7;
    {
      const int tl = opq(threadIdx.x);
#define LD_A(i, RW, RQ) { const int idx = tl + (i) * 256; const int row = idx >> 4, c = idx & 15; \
        RW = *(const uint4*)(recn_w + row * 128 + c * 8); RQ = *(const uint4*)(QKV + (row0n + row) * 1536 + h * 128 + c * 8); }
      LD_A(0, ra0, ra4) LD_A(1, ra1, ra5) LD_A(2, ra2, ra6) LD_A(3, ra3, ra7)
    }
    f32x4 P[4], O[4];
#pragma unroll
    for (int i = 0; i < 4; ++i) { P[i] = O[i] = (f32x4){0.f, 0.f, 0.f, 0.f}; }
#pragma unroll
    for (int ks = 0; ks < 4; ++ks) {
      const bf16x8 sb0 = pack_acc2(S[2 * ks], S[2 * ks + 1]);
#pragma unroll
      for (int mt = 0; mt < 4; ++mt) {
        const bf16x8 aw = read2x4(ws_ + (mt * 16 + l15) * ST, ks * 32 + 4 * q, ks * 32 + 16 + 4 * q);
        const bf16x8 aq = read2x4(qs_ + (mt * 16 + l15) * ST, ks * 32 + 4 * q, ks * 32 + 16 + 4 * q);
        P[mt] = MFMA16(aw, sb0, P[mt]);
        O[mt] = MFMA16(aq, sb0, O[mt]);
      }
    }
    {
      const u32 uw_[8] = {uc0.x, uc0.y, uc0.z, uc0.w, uc1.x, uc1.y, uc1.z, uc1.w};
#pragma unroll
      for (int mt = 0; mt < 4; ++mt)
#pragma unroll
        for (int r = 0; r < 4; ++r) {
          const int i = mt * 16 + 4 * q + r;
          const int ui = mt * 4 + r;
          const float uv = (ui & 1) ? bfhi(uw_[ui >> 1]) : bflo(uw_[ui >> 1]);
          P[mt][r] = uv - P[mt][r];
          O[mt][r] *= egs[i];
        }
    }
    SCHED_FENCE;
    __syncthreads();
    uint4 rb0, rb1, rb2, rb3, rb4, rb5, un0, un1;
    float e_next = 0.f;
    {
      const int tl = opq(threadIdx.x);
#define ST_A(i, RW, RQ) { const int idx = tl + (i) * 256; const int row = idx >> 4, c = idx & 15; \
        *(uint4*)(ws_ + row * ST + c * 8) = RW; *(uint4*)(qs_ + row * ST + c * 8) = RQ; }
      ST_A(0, ra0, ra4) ST_A(1, ra1, ra5) ST_A(2, ra2, ra6) ST_A(3, ra3, ra7)
#define LD_K(i, R) { const int idx = tl + (i) * 256; const int rk = idx >> 3, ck = idx & 7; R = *(const uint4*)(recn_kT + rk * 64 + ck * 8); }
      LD_K(0, rb0) LD_K(1, rb1) LD_K(2, rb2) LD_K(3, rb3)
#define LD_T(i, R) { const int idx = tl + (i) * 256; const int row = idx >> 3, c = idx & 7; R = *(const uint4*)(recn_at + row * 64 + c * 8); }
      LD_T(0, rb4) LD_T(1, rb5)
      un0 = *(const uint4*)(recn_u + uoff);
      un1 = *(const uint4*)(recn_u + uoff + 8);
      if (tl < 129) e_next = recn_eg[tl];
    }
    {
      bf16x8 vb[2];
#pragma unroll
      for (int k2 = 0; k2 < 2; ++k2) vb[k2] = pack_acc2(P[2 * k2], P[2 * k2 + 1]);
#pragma unroll
      for (int k2 = 0; k2 < 2; ++k2)
#pragma unroll
        for (int mt = 0; mt < 4; ++mt) {
          const bf16x8 aa = read2x4(ats + (mt * 16 + l15) * ST2, k2 * 32 + 4 * q, k2 * 32 + 16 + 4 * q);
          O[mt] = MFMA16(aa, vb[k2], O[mt]);
        }
    }
    {
      const int npad = (n == 0) ? PADR : 0;
      u16* yp = YB + (row0 + 4 * q) * 1024 + 512 + h * 128 + half * 64 + w * 16 + l15;
#pragma unroll
      for (int mt = 0; mt < 4; ++mt)
#pragma unroll
        for (int r = 0; r < 4; ++r)
          if (mt * 16 + 4 * q + r >= npad) yp[(mt * 16 + r) * 1024] = f2bf(O[mt][r]);
    }
    {
#pragma unroll
      for (int mt = 0; mt < 4; ++mt)
#pragma unroll
        for (int r = 0; r < 4; ++r) P[mt][r] *= egls[mt * 16 + 4 * q + r];
      bf16x8 vb[2];
#pragma unroll
      for (int k2 = 0; k2 < 2; ++k2) vb[k2] = pack_acc2(P[2 * k2], P[2 * k2 + 1]);
      const float egl = egs[128];
#pragma unroll
      for (int dt = 0; dt < 8; ++dt) S[dt] *= egl;
#pragma unroll
      for (int k2 = 0; k2 < 2; ++k2)
#pragma unroll
        for (int dt = 0; dt < 8; ++dt) {
          const bf16x8 ak = read2x4(kts + (dt * 16 + l15) * ST2, k2 * 32 + 4 * q, k2 * 32 + 16 + 4 * q);
          S[dt] = MFMA16(ak, vb[k2], S[dt]);
        }
    }
    SCHED_FENCE;
    __syncthreads();
    {
      const int tl = opq(threadIdx.x);
#define ST_K(i, R) { const int idx = tl + (i) * 256; const int rk = idx >> 3, ck = idx & 7; *(uint4*)(kts + rk * ST2 + ck * 8) = R; }
      ST_K(0, rb0) ST_K(1, rb1) ST_K(2, rb2) ST_K(3, rb3)
#define ST_T(i, R) { const int idx = tl + (i) * 256; const int row = idx >> 3, c = idx & 7; *(uint4*)(ats + row * ST2 + c * 8) = R; }
      ST_T(0, rb4) ST_T(1, rb5)
      if (tl < 129) scl[(cur ^ 1) * 132 + tl] = e_next;
    }
    uc0 = un0; uc1 = un1;
    __syncthreads();
  }
}

DI void phase_p5(const Params& p, int l) {
  char* const WS = opqp(p.ws);
  const int tid = opq(threadIdx.x), lane = tid & 63, w = tid >> 6;
  const u16* ZB = (const u16*)(WS + OFF_ZB);
  u16* YB = (u16*)(WS + OFF_YB);
  const float* nw = p.gdn_norm_w + l * 128;
  const int c0 = (lane & 15) * 8;
  const float4 n0 = *(const float4*)(nw + c0), n1 = *(const float4*)(nw + c0 + 4);
  const float nn[8] = {n0.x, n0.y, n0.z, n0.w, n1.x, n1.y, n1.z, n1.w};
  for (int ti = blockIdx.x * 4 + w; ti < NB * (SEQ + NMETA); ti += gridDim.x * 4) {
    const int b = ti / (SEQ + NMETA), pp = PADR + ti % (SEQ + NMETA);
    const size_t r = (size_t)b * LP + pp;
    float ov[8], zf[8], yv[8];
    unpack8(*(const uint4*)(YB + r * 1024 + 512 + lane * 8), ov);
    unpack8(*(const uint4*)(ZB + r * 512 + lane * 8), zf);
    float ss = 0.f;
#pragma unroll
    for (int j = 0; j < 8; ++j) ss += ov[j] * ov[j];
    ss = red16(ss);
    const float rs = rsqrtf(ss * (1.0f / 128.0f) + RMS_EPS);
#pragma unroll
    for (int j = 0; j < 8; ++j) yv[j] = ov[j] * rs * nn[j] * siluf(zf[j]);
    *(uint4*)(YB + r * 1024 + 512 + lane * 8) = pack8(yv);
  }
}

DI void phase_ln1(const Params& p, int l) {
  char* const WS = opqp(p.ws);
  const int tid = opq(threadIdx.x), lane = tid & 63, w = tid >> 6;
  const u16* HB = (const u16*)(WS + OFF_HB);
  const u16* MIX = (const u16*)(WS + OFF_R1);
  u16* H1 = (u16*)(WS + OFF_QKV);
  float lg[16], lb[16];
  load_gb16(lg, lb, p.ln1_g + l * 1024, p.ln1_b + l * 1024, lane);
  const int gwv = blockIdx.x * 4 + w, nwv = gridDim.x * 4;
  const int rchunk = (int)(((unsigned)MR + (unsigned)nwv - 1u) / (unsigned)nwv);
  const int r_beg = min(MR, gwv * rchunk), r_end = min(MR, r_beg + rchunk);
  auto proc = [&](int rr, const uint4& h0, const uint4& h1, const uint4& m0, const uint4& m1) {
    float v[16];
    if (rr % LP < PADR) {
#pragma unroll
      for (int i = 0; i < 16; ++i) v[i] = 0.f;
    } else {
      float hv[16], mv[16];
      unpack8(h0, hv); unpack8(h1, hv + 8); unpack8(m0, mv); unpack8(m1, mv + 8);
#pragma unroll
      for (int i = 0; i < 16; ++i) v[i] = ALPHA * hv[i] + mv[i];
      ln_row16_reg(v, lg, lb);
    }
    store_row16_bf16(H1 + (size_t)rr * 1024, v, lane);
  };
  for (int r = r_beg; r < r_end; r += 2) {
    const int rB = min(r + 1, r_end - 1);
    const uint4 hA0 = *(const uint4*)(HB + (size_t)r * 1024 + lane * 16), hA1 = *(const uint4*)(HB + (size_t)r * 1024 + lane * 16 + 8);
    const uint4 mA0 = *(const uint4*)(MIX + (size_t)r * 1024 + lane * 16), mA1 = *(const uint4*)(MIX + (size_t)r * 1024 + lane * 16 + 8);
    const uint4 hB0 = *(const uint4*)(HB + (size_t)rB * 1024 + lane * 16), hB1 = *(const uint4*)(HB + (size_t)rB * 1024 + lane * 16 + 8);
    const uint4 mB0 = *(const uint4*)(MIX + (size_t)rB * 1024 + lane * 16), mB1 = *(const uint4*)(MIX + (size_t)rB * 1024 + lane * 16 + 8);
    proc(r, hA0, hA1, mA0, mA1);
    if (r + 1 < r_end) proc(rB, hB0, hB1, mB0, mB1);
  }
}

#define CE_DESC(x, y) { const u32 _hi = max(x, y); const u32 _lo = min(x, y); x = _hi; y = _lo; }
#define CE_ASC(x, y)  { const u32 _hi = max(x, y); const u32 _lo = min(x, y); x = _lo; y = _hi; }
DI void bitonic_sort16(u32* v) {
#pragma unroll
  for (int k = 2; k <= 16; k <<= 1)
#pragma unroll
    for (int j = k >> 1; j > 0; j >>= 1)
#pragma unroll
      for (int i = 0; i < 16; ++i) {
        const int l = i ^ j;
        if (l > i) { if ((i & k) == 0) CE_DESC(v[i], v[l]) else CE_ASC(v[i], v[l]) }
      }
}
DI void bitonic_merge16(u32* v) {
#pragma unroll
  for (int j = 8; j > 0; j >>= 1)
#pragma unroll
    for (int i = 0; i < 16; ++i) { const int l = i ^ j; if (l > i) CE_DESC(v[i], v[l]) }
}
DI void merge_top16(u32* a, const u32* b) {
#pragma unroll
  for (int i = 0; i < 16; ++i) a[i] = max(a[i], b[15 - i]);
  bitonic_merge16(a);
}
DI void xmerge_top16(u32* v, int mask) {
  u32 t[16];
  const int ln = __lane_id();
  const bool up32 = (ln & 32) != 0, odd16 = (ln & 16) != 0;
#pragma unroll
  for (int i = 0; i < 16; ++i) t[i] = (mask == 32) ? xch32(v[15 - i], up32) : xch16(v[15 - i], odd16);
#pragma unroll
  for (int i = 0; i < 16; ++i) v[i] = max(v[i], t[i]);
  bitonic_merge16(v);
}
DI float unorder(u32 u) { return __uint_as_float(u ^ ((u >> 31) ? 0x80000000u : 0xffffffffu)); }
__device__ __attribute__((aligned(16))) const unsigned char P6_CAND[64] = {
  0, 1, 2, 3, 4, 5, 6, 7, 8, 9, 10, 11, 12, 13, 14, 15,
  16, 17, 18, 19, 20, 21, 22, 23, 64, 65, 66, 80, 81, 128, 144, 160,
  32, 33, 34, 35, 36, 48, 49, 50, 51, 96, 97, 112, 113, 176, 192, 208,
  224, 240, 255, 255, 255, 255, 255, 255, 255, 255, 255, 255, 255, 255, 255, 255};

DI void phase_p6(const Params& p, int l, char* smem) {
  char* const WS = opqp(p.ws);
  constexpr int KST = 136;
  u16* kh = (u16*)smem;
  u32* lists = (u32*)(smem + 2 * 128 * KST * 2);
  const int tid = opq(threadIdx.x), lane = tid & 63, w = tid >> 6, l15 = lane & 15, q = lane >> 4;
  const u16* QP = (const u16*)(WS + OFF_R1);
  const u16* SK = (const u16*)(WS + OFF_SK) + (size_t)l * 2 * 16384;
  int* IDX = (int*)(WS + OFF_IDX);
  float* GATE = (float*)(WS + OFF_GATE);
  for (int idx = tid; idx < 2 * 128 * 16; idx += 256) {
    const int row = idx >> 4, c = idx & 15;
    *(uint4*)(kh + row * KST + c * 8) = *(const uint4*)(SK + row * 128 + c * 8);
  }
  __syncthreads();
  u32* mylist = lists + (w * 16 + l15) * 32;
  const uint4 cw = *(const uint4*)(P6_CAND + q * 16);
  const u32 cwv[4] = {cw.x, cw.y, cw.z, cw.w};
  const int gw = blockIdx.x * 4 + w, nw_ = gridDim.x * 4;
  for (int task = gw; task < (MR / 16) * 8; task += nw_) {
    const int tt = task >> 3, hd = task & 7;
    const size_t row = (size_t)tt * 16 + l15;
#pragma unroll
    for (int hf = 0; hf < 2; ++hf) {
      f32x4 acc[8];
#pragma unroll
      for (int i = 0; i < 8; ++i) acc[i] = (f32x4){0.f, 0.f, 0.f, 0.f};
      const u16* qrow = QP + row * 2048 + hd * 256 + hf * 128;
      const u16* khh = kh + hf * 128 * KST;
#pragma unroll
      for (int ks = 0; ks < 4; ++ks) {
        const bf16x8 aq = *(const bf16x8*)(qrow + ks * 32 + q * 8);
#pragma unroll
        for (int nt = 0; nt < 8; ++nt) {
          const bf16x8 bk = *(const bf16x8*)(khh + (nt * 16 + l15) * KST + ks * 32 + q * 8);
          acc[nt] = MFMA16(bk, aq, acc[nt]);
        }
      }
      u32 va[16], vb2[16];
#pragma unroll
      for (int nt = 0; nt < 4; ++nt)
#pragma unroll
        for (int r = 0; r < 4; ++r) {
          va[nt * 4 + r] = (orderable(acc[nt][r]) & ~127u) | (u32)(127 - (nt * 16 + 4 * q + r));
          vb2[nt * 4 + r] = (orderable(acc[nt + 4][r]) & ~127u) | (u32)(127 - ((nt + 4) * 16 + 4 * q + r));
        }
      bitonic_sort16(va);
      bitonic_sort16(vb2);
      merge_top16(va, vb2);
      xmerge_top16(va, 16);
      xmerge_top16(va, 32);
      if (q == 0) {
#pragma unroll
        for (int i = 0; i < 4; ++i) *(uint4*)(mylist + hf * 16 + i * 4) = make_uint4(va[i * 4], va[i * 4 + 1], va[i * 4 + 2], va[i * 4 + 3]);
      }
    }
    u32 vc[16];
#pragma unroll
    for (int s_ = 0; s_ < 16; ++s_) {
      const u32 ci = (cwv[s_ >> 2] >> ((s_ & 3) * 8)) & 255u;
      const bool ok = (ci != 255u);
      const u32 a_ = ok ? (ci >> 4) : 0u, b_ = ok ? (ci & 15u) : 0u;
      const float sum = unorder(mylist[a_] & ~127u) + unorder(mylist[16 + b_] & ~127u);
      vc[s_] = ok ? ((orderable(sum) & ~255u) | (255u - ci)) : 0u;
    }
    bitonic_sort16(vc);
    xmerge_top16(vc, 16);
    xmerge_top16(vc, 32);
    const float mx = unorder(vc[0] & ~255u);
    float den = 0.f;
#pragma unroll
    for (int k = 0; k < 16; ++k) den += __expf(unorder(vc[k] & ~255u) - mx);
    const float inv = 1.0f / den;
    int ex[4]; float gt[4];
#pragma unroll
    for (int j = 0; j < 4; ++j) {
      const u32 pk = (q == 0) ? vc[j] : ((q == 1) ? vc[4 + j] : ((q == 2) ? vc[8 + j] : vc[12 + j]));
      const u32 ci = 255u - (pk & 255u);
      const u32 p1 = mylist[ci >> 4], p2 = mylist[16 + (ci & 15u)];
      ex[j] = (int)((127u - (p1 & 127u)) * 128u + (127u - (p2 & 127u)));
      gt[j] = __expf(unorder(p1 & ~127u) + unorder(p2 & ~127u) - mx) * inv;
    }
#pragma unroll
    for (int j = 0; j < 4; ++j) {
      const int ps = p7_pos(hd * 16 + q * 4 + j);
      IDX[row * 128 + ps] = ex[j];
      GATE[row * 128 + ps] = gt[j];
    }
  }
}

DI void phase_p7(const Params& p, int l) {
  char* const WS = opqp(p.ws);
  const int tid = opq(threadIdx.x), lane = tid & 63, w = tid >> 6;
  const u16* H1 = (const u16*)(WS + OFF_QKV);
  u16* HB = (u16*)(WS + OFF_HB);
  const char* TU = WS + OFF_TAB;
  const char* TV = TU + (size_t)16384 * 1024;
  const int* IDX = (const int*)(WS + OFF_IDX);
  const float* GATE = (const float*)(WS + OFF_GATE);
  const bool last = (l == 1);
  const int per_b = last ? SEQ : (SEQ + NMETA);
  const int ntok = NB * per_b;
  float lg[16], lb[16];
  load_gb16(lg, lb, p.ln2_g + l * 1024, p.ln2_b + l * 1024, lane);
  for (int ti = blockIdx.x * 4 + w; ti < ntok; ti += gridDim.x * 4) {
    const int b = ti / per_b, pp = (last ? 64 : PADR) + ti % per_b;
    const size_t r = (size_t)b * LP + pp;
    float x[16];
    unpack8(*(const uint4*)(H1 + r * 1024 + lane * 16), x);
    unpack8(*(const uint4*)(H1 + r * 1024 + lane * 16 + 8), x + 8);
    const int id0 = IDX[r * 128 + lane], id1 = IDX[r * 128 + 64 + lane];
    const float g0 = GATE[r * 128 + lane], g1 = GATE[r * 128 + 64 + lane];
    float d0 = 0.f, d1 = 0.f;
    for (int eb = 0; eb < 128; eb += 8) {
      uint4 ud[8];
#pragma unroll
      for (int j = 0; j < 8; ++j) {
        const int e = eb + j;
        const int id = __builtin_amdgcn_readlane((eb < 64) ? id0 : id1, e & 63);
        ud[j] = *(const uint4*)(TU + (size_t)id * 1024 + lane * 16);
      }
#pragma unroll
      for (int j = 0; j < 8; ++j) {
        float f[16]; dec_fp8x16(ud[j], f);
        float s = 0.f;
#pragma unroll
        for (int i = 0; i < 16; ++i) s += x[i] * f[i];
        s = wsum(s);
        const int e = eb + j;
        if (lane == (e & 63)) { if (eb < 64) d0 = s; else d1 = s; }
      }
    }
    float c0, c1;
    { const float a = d0 * TINV; c0 = g0 * 0.5f * a * (1.0f + erf_as(a * 0.7071067811865476f)) * TINV; }
    { const float a = d1 * TINV; c1 = g1 * 0.5f * a * (1.0f + erf_as(a * 0.7071067811865476f)) * TINV; }
    float acc[16];
#pragma unroll
    for (int i = 0; i < 16; ++i) acc[i] = 0.f;
    for (int eb = 0; eb < 128; eb += 8) {
      uint4 vd[8];
#pragma unroll
      for (int j = 0; j < 8; ++j) {
        const int e = eb + j;
        const int id = __builtin_amdgcn_readlane((eb < 64) ? id0 : id1, e & 63);
        vd[j] = *(const uint4*)(TV + (size_t)id * 1024 + lane * 16);
      }
#pragma unroll
      for (int j = 0; j < 8; ++j) {
        const int e = eb + j;
        const float cf = __int_as_float(__builtin_amdgcn_readlane(__float_as_int((eb < 64) ? c0 : c1), e & 63));
        float f[16]; dec_fp8x16(vd[j], f);
#pragma unroll
        for (int i = 0; i < 16; ++i) acc[i] += cf * f[i];
      }
    }
#pragma unroll
    for (int i = 0; i < 16; ++i) acc[i] += ALPHA * x[i];
    ln_row16_reg(acc, lg, lb);
    if (!last) {
      store_row16_bf16(HB + r * 1024, acc, lane);
    } else {
      float* o = p.out + ((size_t)b * SEQ + (pp - 64)) * 1024 + lane * 16;
#pragma unroll
      for (int i4 = 0; i4 < 4; ++i4) *(float4*)(o + i4 * 4) = make_float4(acc[i4 * 4], acc[i4 * 4 + 1], acc[i4 * 4 + 2], acc[i4 * 4 + 3]);
    }
  }
}

constexpr size_t OFF_PD = OFF_R1;
DI void p7_token(int ti, bool last, int& b, int& pp, size_t& r) {
  const int per_b = last ? SEQ : (SEQ + NMETA);
  b = ti / per_b; pp = (last ? 64 : PADR) + ti % per_b; r = (size_t)b * LP + pp;
}
DI void phase_p7a(const Params& p, int l) {
  char* const WS = opqp(p.ws);
  const int tid = opq(threadIdx.x), lane = tid & 63, w = tid >> 6;
  const int j = blockIdx.x & 7, wr = (blockIdx.x >> 3) * 4 + w, nwv = (gridDim.x >> 3) * 4;
  const u16* H1 = (const u16*)(WS + OFF_QKV);
  const char* TU = WS + OFF_TAB + j * 128 + (lane & 7) * 16;
  const int* IDX = (const int*)(WS + OFF_IDX);
  float* PD = (float*)(WS + OFF_PD) + (size_t)j * MR * 128;
  const bool last = (l == 1);
  const int ntok = NB * (last ? SEQ : (SEQ + NMETA));
  const int l7 = lane & 7, lg = lane >> 3;
#define P7A_LOADI(t, IV, X0, X1, R) { int b_, pp_; p7_token(min((t), ntok - 1), last, b_, pp_, R); \
    IV[0] = *(const int4*)(IDX + R * 128 + lg * 16); IV[1] = *(const int4*)(IDX + R * 128 + lg * 16 + 4); \
    IV[2] = *(const int4*)(IDX + R * 128 + lg * 16 + 8); IV[3] = *(const int4*)(IDX + R * 128 + lg * 16 + 12); \
    X0 = *(const uint4*)(H1 + R * 1024 + j * 128 + l7 * 16); X1 = *(const uint4*)(H1 + R * 1024 + j * 128 + l7 * 16 + 8); }
#define P7_IDV(IV, i) ((((i) & 3) == 0) ? IV[(i) >> 2].x : ((((i) & 3) == 1) ? IV[(i) >> 2].y : ((((i) & 3) == 2) ? IV[(i) >> 2].z : IV[(i) >> 2].w)))
#define P7_GATHER(TAB, IV, DST) { _Pragma("unroll") for (int i = 0; i < 16; ++i) DST[i] = *(const uint4*)(TAB + (size_t)P7_IDV(IV, i) * 1024); }
  int4 idN[4]; uint4 xN0, xN1; size_t rN;
  uint4 ud[16]; uint4 xc0, xc1; size_t rc;
  P7A_LOADI(wr, idN, xN0, xN1, rN)
  P7_GATHER(TU, idN, ud)
  xc0 = xN0; xc1 = xN1; rc = rN;
  P7A_LOADI(wr + nwv, idN, xN0, xN1, rN)
  for (int ti = wr; ti < ntok; ti += nwv) {
    uint4 udn[16];
    P7_GATHER(TU, idN, udn)
    const uint4 xG0 = xN0, xG1 = xN1; const size_t rG = rN;
    P7A_LOADI(ti + 2 * nwv, idN, xN0, xN1, rN)
    float xs[16];
    unpack8(xc0, xs); unpack8(xc1, xs + 8);
    float sel0 = 0.f, sel1 = 0.f;
#pragma unroll
    for (int i = 0; i < 16; ++i) {
      f32x2 f[8]; dec_fp8x16_v2(ud[i], f);
      f32x2 s2 = {0.f, 0.f};
#pragma unroll
      for (int c = 0; c < 8; ++c) { const f32x2 xv = {xs[2 * c], xs[2 * c + 1]}; s2 = __builtin_elementwise_fma(xv, f[c], s2); }
      const float sacc = red8(s2[0] + s2[1]);
      if ((i & 7) == l7) { if (i < 8) sel0 = sacc; else sel1 = sacc; }
    }
    PD[rc * 128 + 8 * l7 + lg] = sel0;
    PD[rc * 128 + 64 + 8 * l7 + lg] = sel1;
#pragma unroll
    for (int i = 0; i < 16; ++i) ud[i] = udn[i];
    xc0 = xG0; xc1 = xG1; rc = rG;
  }
}
DI void phase_p7coef(const Params& p, int l) {
  char* const WS = opqp(p.ws);
  const int tid = opq(threadIdx.x), lane = tid & 63, w = tid >> 6;
  float* GATE = (float*)(WS + OFF_GATE);
  const float* PD = (const float*)(WS + OFF_PD);
  const bool last = (l == 1);
  const int ntok = NB * (last ? SEQ : (SEQ + NMETA));
  for (int ti = blockIdx.x * 4 + w; ti < ntok; ti += gridDim.x * 4) {
    int b, pp; size_t r; p7_token(ti, last, b, pp, r);
    float d0 = 0.f, d1 = 0.f;
#pragma unroll
    for (int k = 0; k < 8; ++k) { d0 += PD[((size_t)k * MR + r) * 128 + lane]; d1 += PD[((size_t)k * MR + r) * 128 + 64 + lane]; }
    const int ps0 = p7_pos(lane), ps1 = p7_pos(64 + lane);
    const float g0 = GATE[r * 128 + ps0], g1 = GATE[r * 128 + ps1];
    const float a0 = d0 * TINV, a1 = d1 * TINV;
    GATE[r * 128 + ps0] = g0 * 0.5f * a0 * (1.0f + erf_as(a0 * 0.7071067811865476f)) * TINV;
    GATE[r * 128 + ps1] = g1 * 0.5f * a1 * (1.0f + erf_as(a1 * 0.7071067811865476f)) * TINV;
  }
}
DI void phase_p7b(const Params& p, int l) {
  char* const WS = opqp(p.ws);
  const int tid = opq(threadIdx.x), lane = tid & 63, w = tid >> 6;
  const int j = blockIdx.x & 7, wr = (blockIdx.x >> 3) * 4 + w, nwv = (gridDim.x >> 3) * 4;
  const char* TV = WS + OFF_TAB + (size_t)16384 * 1024 + j * 128 + (lane & 7) * 16;
  const int* IDX = (const int*)(WS + OFF_IDX);
  const float* COEF = (const float*)(WS + OFF_GATE);
  u16* OUTB = (u16*)(WS + OFF_YB);
  const bool last = (l == 1);
  const int ntok = NB * (last ? SEQ : (SEQ + NMETA));
  const int l7 = lane & 7, lg = lane >> 3;
#define P7B_LOADI(t, IV, CV, R) { int b_, pp_; p7_token(min((t), ntok - 1), last, b_, pp_, R); \
    _Pragma("unroll") for (int k4 = 0; k4 < 4; ++k4) { IV[k4] = *(const int4*)(IDX + R * 128 + lg * 16 + k4 * 4); CV[k4] = *(const float4*)(COEF + R * 128 + lg * 16 + k4 * 4); } }
#define P7_CFV(CV, i) ((((i) & 3) == 0) ? CV[(i) >> 2].x : ((((i) & 3) == 1) ? CV[(i) >> 2].y : ((((i) & 3) == 2) ? CV[(i) >> 2].z : CV[(i) >> 2].w)))
  int4 idN[4]; float4 cN[4]; size_t rN;
  P7B_LOADI(wr, idN, cN, rN)
  for (int ti = wr; ti < ntok; ti += nwv) {
    uint4 vd[16];
    P7_GATHER(TV, idN, vd)
    float4 cc[4];
#pragma unroll
    for (int k4 = 0; k4 < 4; ++k4) cc[k4] = cN[k4];
    const size_t rc = rN;
    P7B_LOADI(ti + nwv, idN, cN, rN)
    f32x2 acc2[8];
#pragma unroll
    for (int c = 0; c < 8; ++c) acc2[c] = (f32x2){0.f, 0.f};
#pragma unroll
    for (int i = 0; i < 16; ++i) {
      f32x2 f[8]; dec_fp8x16_v2(vd[i], f);
      const float cfi = P7_CFV(cc, i);
      const f32x2 cv = {cfi, cfi};
#pragma unroll
      for (int c = 0; c < 8; ++c) acc2[c] = __builtin_elementwise_fma(cv, f[c], acc2[c]);
    }
    float acc[16];
#pragma unroll
    for (int c = 0; c < 8; ++c) { acc[2 * c] = acc2[c][0]; acc[2 * c + 1] = acc2[c][1]; }
    float r8[8], r4[4];
    {
      const bool hi = (lane & 32) != 0;
#pragma unroll
      for (int k = 0; k < 8; ++k) {
        const float mine = hi ? acc[8 + k] : acc[k], send = hi ? acc[k] : acc[8 + k];
        r8[k] = mine + __uint_as_float(xch32(__float_as_uint(send), hi));
      }
    }
    {
      const bool hi = (lane & 16) != 0;
#pragma unroll
      for (int k = 0; k < 4; ++k) {
        const float mine = hi ? r8[4 + k] : r8[k], send = hi ? r8[k] : r8[4 + k];
        r4[k] = mine + __uint_as_float(xch16(__float_as_uint(send), hi));
      }
    }
    {
      const bool hi = (lane & 8) != 0;
      const float m0 = hi ? r4[2] : r4[0], m1 = hi ? r4[3] : r4[1], s0 = hi ? r4[0] : r4[2], s1 = hi ? r4[1] : r4[3];
      const float o0 = m0 + dpp_get<0x128>(s0);
      const float o1 = m1 + dpp_get<0x128>(s1);
      *(u32*)(OUTB + rc * 1024 + j * 128 + l7 * 16 + 2 * lg) = pack2(o0, o1);
    }
  }
}
DI void phase_p7c(const Params& p, int l) {
  char* const WS = opqp(p.ws);
  const int tid = opq(threadIdx.x), lane = tid & 63, w = tid >> 6;
  const u16* H1 = (const u16*)(WS + OFF_QKV);
  const u16* OUTB = (const u16*)(WS + OFF_YB);
  u16* HB = (u16*)(WS + OFF_HB);
  const bool last = (l == 1);
  const int ntok = NB * (last ? SEQ : (SEQ + NMETA));
  float lg_[16], lb_[16];
  load_gb16(lg_, lb_, p.ln2_g + l * 1024, p.ln2_b + l * 1024, lane);
  auto proc = [&](int b, int pp, size_t r, const uint4& x0, const uint4& x1, const uint4& f0, const uint4& f1) {
    float x[16], f[16];
    unpack8(x0, x); unpack8(x1, x + 8); unpack8(f0, f); unpack8(f1, f + 8);
#pragma unroll
    for (int i = 0; i < 16; ++i) f[i] += ALPHA * x[i];
    ln_row16_reg(f, lg_, lb_);
    if (!last) {
      store_row16_bf16(HB + r * 1024, f, lane);
    } else {
      float* o = p.out + ((size_t)b * SEQ + (pp - 64)) * 1024 + lane * 16;
#pragma unroll
      for (int i4 = 0; i4 < 4; ++i4) *(float4*)(o + i4 * 4) = make_float4(f[i4 * 4], f[i4 * 4 + 1], f[i4 * 4 + 2], f[i4 * 4 + 3]);
    }
  };
  const int stride = gridDim.x * 4;
  for (int ti = blockIdx.x * 4 + w; ti < ntok; ti += 2 * stride) {
    const int tB = min(ti + stride, ntok - 1);
    int bA, ppA, bB, ppB; size_t rA, rB;
    p7_token(ti, last, bA, ppA, rA); p7_token(tB, last, bB, ppB, rB);
    const uint4 xA0 = *(const uint4*)(H1 + rA * 1024 + lane * 16), xA1 = *(const uint4*)(H1 + rA * 1024 + lane * 16 + 8);
    const uint4 fA0 = *(const uint4*)(OUTB + rA * 1024 + lane * 16), fA1 = *(const uint4*)(OUTB + rA * 1024 + lane * 16 + 8);
    const uint4 xB0 = *(const uint4*)(H1 + rB * 1024 + lane * 16), xB1 = *(const uint4*)(H1 + rB * 1024 + lane * 16 + 8);
    const uint4 fB0 = *(const uint4*)(OUTB + rB * 1024 + lane * 16), fB1 = *(const uint4*)(OUTB + rB * 1024 + lane * 16 + 8);
    proc(bA, ppA, rA, xA0, xA1, fA0, fA1);
    if (ti + stride < ntok) proc(bB, ppB, rB, xB0, xB1, fB0, fB1);
  }
}

#define XB_TMO      128
#define XB_XCNT(j)  (256  + 64 * (j))
#define XB_XSUB(j)  (1280 + 64 * (j))
#define XB_XGEN(j)  (2304 + 64 * (j))
#define XB_TOP      3328
#define XB_TOPGEN   3392
#define XCD_BAR_WORDS 3456
#define XB_SPIN_CAP (1u << 22)
#define LAS __attribute__((address_space(3)))
DI unsigned xb_ld(unsigned* p)              { return __hip_atomic_load(p, __ATOMIC_RELAXED, __HIP_MEMORY_SCOPE_AGENT); }
DI unsigned xb_add(unsigned* p, unsigned v) { return __hip_atomic_fetch_add(p, v, __ATOMIC_RELAXED, __HIP_MEMORY_SCOPE_AGENT); }
DI unsigned xb_xcc_id() { return (unsigned)__builtin_amdgcn_s_getreg((3 << 11) | 20) & 0xFu; }
#define XB_SPIN(cond, bar) do { unsigned _sp = 0; while (cond) { __builtin_amdgcn_s_sleep(1); \
    if ((++_sp & 255u) == 0u) { if (xb_ld(&(bar)[XB_TMO])) break; if (_sp > XB_SPIN_CAP) { atomicAdd(&(bar)[XB_TMO], 1u); break; } } } } while (0)
struct XcdBarrier { unsigned* bar; unsigned x; volatile LAS unsigned* st; };
DI XcdBarrier xcd_barrier_post(unsigned* bar, volatile LAS unsigned* st) {
  XcdBarrier b; b.bar = bar; b.x = xb_xcc_id(); b.st = st;
  if (threadIdx.x == 0) (void)xb_add(&bar[XB_XCNT(b.x)], 1u);
  return b;
}
DI void xcd_barrier_complete(unsigned* bar, unsigned x, unsigned& nloc, unsigned& nx) {
  const unsigned G = gridDim.x * gridDim.y * gridDim.z;
  unsigned sum, cnt, mine, sp = 0u;
  for (;;) {
    sum = 0u; cnt = 0u; mine = 0u;
#pragma unroll
    for (unsigned j = 0; j < 16; ++j) { const unsigned c = xb_ld(&bar[XB_XCNT(j)]); sum += c; cnt += (c > 0u) ? 1u : 0u; mine = (j == x) ? c : mine; }
    if (sum == G) break;
    __builtin_amdgcn_s_sleep(1);
    if ((++sp & 255u) == 0u) { if (xb_ld(&bar[XB_TMO])) break; if (sp > XB_SPIN_CAP) { atomicAdd(&bar[XB_TMO], 1u); break; } }
  }
  nloc = mine > 0u ? mine : 1u; nx = cnt > 0u ? cnt : 1u;
}
DI void xcd_barrier(const XcdBarrier& b) {
  asm volatile("s_waitcnt vmcnt(0)" ::: "memory");
  __syncthreads();
  if (threadIdx.x == 0) {
    unsigned* bar = b.bar;
    __builtin_amdgcn_s_waitcnt(0);
    unsigned nloc = b.st[0], nx = b.st[1];
    if (nloc == 0u) { xcd_barrier_complete(bar, b.x, nloc, nx); b.st[0] = nloc; b.st[1] = nx; }
    const unsigned old = xb_add(&bar[XB_XSUB(b.x)], 1u);
    const unsigned gen = old / nloc;
    if (old + 1u == (gen + 1u) * nloc) {
      __builtin_amdgcn_fence(__ATOMIC_RELEASE, "agent");
      asm volatile("s_waitcnt vmcnt(0)" ::: "memory");
      const unsigned og = xb_add(&bar[XB_TOP], 1u);
      const unsigned tg = og / nx;
      if (og + 1u == (tg + 1u) * nx) xb_add(&bar[XB_TOPGEN], 1u);
      else XB_SPIN(xb_ld(&bar[XB_TOPGEN]) == tg, bar);
      __builtin_amdgcn_fence(__ATOMIC_ACQUIRE, "agent");
      xb_add(&bar[XB_XGEN(b.x)], 1u);
      asm volatile("s_waitcnt vmcnt(0)" ::: "memory");
    } else {
      XB_SPIN(xb_ld(&bar[XB_XGEN(b.x)]) == gen, bar);
      __builtin_amdgcn_fence(__ATOMIC_ACQUIRE, "agent");
      asm volatile("s_waitcnt vmcnt(0)" ::: "memory");
    }
  }
  __syncthreads();
}

#ifndef DUP_GEMM
#define DUP_GEMM 0
#endif
#ifndef DUP_P7
#define DUP_P7 0
#endif
#ifndef DUP_SCAN
#define DUP_SCAN 0
#endif
#ifndef DUP_P3
#define DUP_P3 0
#endif
#ifndef DUP_P6
#define DUP_P6 0
#endif
#ifndef DUP_MISC
#define DUP_MISC 0
#endif
template <int l>
DI void layer(const Params& p, char* smem, const XcdBarrier& xb) {
  for (int rep = 0; rep <= DUP_GEMM; ++rep) { gemm_phase<1>(p, OFF_HB, OFF_WIN + l * SZ_WIN1, NPROJP / 128, smem); xcd_barrier(xb); }
  for (int rep = 0; rep <= DUP_MISC; ++rep) { phase_p2(p, l, smem); xcd_barrier(xb); }
  for (int rep = 0; rep <= DUP_P3; ++rep) { phase_p3(p, smem); xcd_barrier(xb); }
  for (int rep = 0; rep <= DUP_SCAN; ++rep) { phase_scan(p, l, smem); xcd_barrier(xb); }
  phase_p5(p, l); xcd_barrier(xb);
  for (int rep = 0; rep <= DUP_GEMM; ++rep) { gemm_phase<2>(p, OFF_YB, OFF_WOUT + l * SZ_WOUT1, 8, smem); xcd_barrier(xb); }
  for (int rep = 0; rep <= DUP_MISC; ++rep) { phase_ln1(p, l); xcd_barrier(xb); }
  for (int rep = 0; rep <= DUP_GEMM; ++rep) { gemm_phase<3>(p, OFF_QKV, OFF_WQ + l * SZ_WQ1, 16, smem); xcd_barrier(xb); }
  for (int rep = 0; rep <= DUP_P6; ++rep) { phase_p6(p, l, smem); xcd_barrier(xb); }
#ifdef P7_GATHER_IC
  for (int rep = 0; rep <= DUP_P7; ++rep) { phase_p7(p, l); if (rep < DUP_P7) xcd_barrier(xb); }
#else
  phase_p7a(p, l); xcd_barrier(xb);
  phase_p7coef(p, l); xcd_barrier(xb);
  phase_p7b(p, l); xcd_barrier(xb);
  phase_p7c(p, l);
#endif
}
__global__ void __launch_bounds__(256, 2) fwd_megakernel(Params p) {
  __shared__ __attribute__((aligned(16))) char smem[78848];
  cg::grid_group grid = cg::this_grid();
  if (threadIdx.x == 0) *(uint4*)(smem + 78832) = make_uint4(0u, 0u, 0u, 0u);
  __syncthreads();
  const XcdBarrier xb = xcd_barrier_post((unsigned*)(p.ws + OFF_BAR), (volatile LAS unsigned*)(smem + 78832));
  phase_prologue(p, smem);
  grid.sync();
  layer<0>(p, smem, xb);
  xcd_barrier(xb);
  layer<1>(p, smem, xb);
}

extern "C" void kernel_launch(void* const* d_in, const int* in_sizes, int n_in, void* d_out,
                              int out_size, void* d_ws, size_t ws_size, hipStream_t stream) {
  static int grid_blocks = 0;
  if (!grid_blocks) {
    int dev = 0, cus = 0, per_cu = 0;
    (void)hipGetDevice(&dev);
    (void)hipDeviceGetAttribute(&cus, hipDeviceAttributeMultiprocessorCount, dev);
    (void)hipOccupancyMaxActiveBlocksPerMultiprocessor(&per_cu, fwd_megakernel, 256, 0);
    if (per_cu > 2) per_cu = 2;
    if (per_cu < 1) per_cu = 1;
    grid_blocks = cus * per_cu;
  }
  if (ws_size < WS_NEED) { fprintf(stderr, "workspace too small\n"); return; }
  Params p{};
  p.x = (const float*)d_in[0]; p.meta = (const float*)d_in[1]; p.ln_in_g = (const float*)d_in[2]; p.ln_in_b = (const float*)d_in[3];
  p.w_in = (const float*)d_in[4]; p.conv_w = (const float*)d_in[5]; p.gdn_conv_w = (const float*)d_in[6]; p.a_log = (const float*)d_in[7];
  p.dt_bias = (const float*)d_in[8]; p.gdn_norm_w = (const float*)d_in[9]; p.w_out = (const float*)d_in[10]; p.ln1_g = (const float*)d_in[11];
  p.ln1_b = (const float*)d_in[12]; p.w_q = (const float*)d_in[13]; p.k1 = (const float*)d_in[14]; p.k2 = (const float*)d_in[15];
  p.pu = (const float*)d_in[16]; p.pv = (const float*)d_in[17]; p.ln2_g = (const float*)d_in[18]; p.ln2_b = (const float*)d_in[19];
  p.out = (float*)d_out; p.ws = (char*)d_ws;
  (void)hipMemsetAsync((char*)d_ws + OFF_BAR, 0, 16384, stream);
  void* args[] = {&p};
  hipError_t e = hipLaunchCooperativeKernel((void*)fwd_megakernel, dim3(grid_blocks), dim3(256), args, 0, stream);
  if (e != hipSuccess) fprintf(stderr, "cooperative launch failed: %s (grid %d)\n", hipGetErrorString(e), grid_blocks);
}
```

```cpp
#include <hip/hip_runtime.h>
#include <hip/hip_cooperative_groups.h>
#include <cstdio>
namespace cg = cooperative_groups;

typedef unsigned short u16;
typedef unsigned int u32;
using bf16x8 = __attribute__((ext_vector_type(8))) short;
using s16x4 = __attribute__((ext_vector_type(4))) short;
using f32x4 = __attribute__((ext_vector_type(4))) float;
using f32x2 = __attribute__((ext_vector_type(2))) float;

#define DI __device__ __forceinline__
#define MFMA16(a, b, c) __builtin_amdgcn_mfma_f32_16x16x32_bf16((a), (b), (c), 0, 0, 0)

constexpr int NB = 4, SEQ = 8192, NMETA = 16, DM = 1024;
constexpr int LP = 8256;
constexpr int PADR = 48;
constexpr int MR = NB * LP;
constexpr int NCH = 129;
constexpr int NPROJ = 3592, NPROJP = 3712;
constexpr float ALPHA = 1.4142135623730951f;
constexpr float LN_EPS = 1e-5f, RMS_EPS = 1e-6f;
constexpr float TSCALE = 64.0f, TINV = 1.0f / 64.0f;

constexpr size_t SZ_HB = (size_t)MR * 1024 * 2;
constexpr size_t OFF_HB = 0;
constexpr size_t OFF_R1 = OFF_HB + SZ_HB;
constexpr size_t SZ_R1 = (size_t)MR * 3072 * 2;
constexpr size_t OFF_ZB = OFF_R1 + SZ_R1;
constexpr size_t SZ_ZB = (size_t)MR * 512 * 2;
constexpr size_t OFF_QKV = OFF_ZB + SZ_ZB;
constexpr size_t SZ_QKV = (size_t)MR * 1536 * 2;
constexpr size_t OFF_YB = OFF_QKV + SZ_QKV;
constexpr size_t OFF_AB = OFF_YB + SZ_HB;
constexpr size_t SZ_AB = (size_t)MR * 8 * 4;
constexpr size_t OFF_GB = OFF_AB + SZ_AB;
constexpr size_t OFF_WIN = OFF_GB + SZ_AB;
constexpr size_t SZ_WIN1 = (size_t)NPROJP * 1024 * 2;
constexpr size_t OFF_WOUT = OFF_WIN + 2 * SZ_WIN1;
constexpr size_t SZ_WOUT1 = (size_t)1024 * 1024 * 2;
constexpr size_t OFF_WQ = OFF_WOUT + 2 * SZ_WOUT1;
constexpr size_t SZ_WQ1 = (size_t)2048 * 1024 * 2;
constexpr size_t OFF_SK = OFF_WQ + 2 * SZ_WQ1;
constexpr size_t SZ_SK1 = (size_t)2 * 128 * 128 * 2;
constexpr size_t OFF_BAR = OFF_SK + 2 * SZ_SK1;
constexpr size_t WS_NEED = OFF_BAR + 16384;
constexpr size_t REC_BYTES = 58368;
constexpr size_t OFF_IDX = OFF_R1 + (size_t)MR * 2048 * 2;
constexpr size_t OFF_GATE = OFF_IDX + (size_t)MR * 128 * 4;
constexpr size_t OFF_TAB = OFF_GATE + (size_t)MR * 128 * 4;
static_assert((size_t)NB * NCH * 4 * REC_BYTES <= SZ_R1, "rec");
static_assert(OFF_GATE + (size_t)MR * 128 * 4 <= OFF_R1 + SZ_R1, "idx");
static_assert(OFF_TAB + (size_t)2 * 16384 * 1024 <= OFF_R1 + SZ_R1, "tab");
static_assert(WS_NEED <= (size_t)512 * 1024 * 1024, "ws");

struct Params {
  const float* x; const float* meta; const float* ln_in_g; const float* ln_in_b;
  const float* w_in; const float* conv_w; const float* gdn_conv_w; const float* a_log; const float* dt_bias;
  const float* gdn_norm_w; const float* w_out; const float* ln1_g; const float* ln1_b;
  const float* w_q; const float* k1; const float* k2; const float* pu; const float* pv;
  const float* ln2_g; const float* ln2_b;
  float* out; char* ws;
};

DI int opq(int x) { asm volatile("" : "+v"(x)); return x; }
DI char* opqp(char* w) { long z = 0; asm volatile("" : "+s"(z)); return w + z; }
DI int opqs(int x) { asm volatile("" : "+s"(x)); return x; }
#define SCHED_FENCE __builtin_amdgcn_sched_barrier(0)
typedef __bf16 hbf16x2 __attribute__((ext_vector_type(2)));
DI u32 pack2(float a, float b) { f32x2 v = {a, b}; hbf16x2 r = __builtin_convertvector(v, hbf16x2); return __builtin_bit_cast(u32, r); }
DI u16 f2bf(float x) { return (u16)(pack2(x, 0.f) & 0xffffu); }
DI float bf2f(u16 h) { return __uint_as_float(((u32)h) << 16); }
DI float bflo(u32 w) { return __uint_as_float(w << 16); }
DI float bfhi(u32 w) { return __uint_as_float(w & 0xffff0000u); }
template <int CTRL, int ROWMASK>
DI float dpp_get_rm(float v) { return __int_as_float(__builtin_amdgcn_update_dpp(0, __float_as_int(v), CTRL, ROWMASK, 0xF, false)); }
DI float red16(float v) {
  v += dpp_get_rm<0xB1, 0xF>(v); v += dpp_get_rm<0x4E, 0xF>(v); v += dpp_get_rm<0x141, 0xF>(v); v += dpp_get_rm<0x140, 0xF>(v);
  return v;
}
DI float wsum(float v) {
  v = red16(v);
  v += dpp_get_rm<0x142, 0xA>(v);
  v += dpp_get_rm<0x143, 0xC>(v);
  return __int_as_float(__builtin_amdgcn_readlane(__float_as_int(v), 63));
}
DI float erf_as(float x) {
  const float ax = fabsf(x);
  const float t = 1.0f / (1.0f + 0.3275911f * ax);
  const float poly = t * (0.254829592f + t * (-0.284496736f + t * (1.421413741f + t * (-1.453152027f + t * 1.061405429f))));
  const float r = 1.0f - poly * __expf(-ax * ax);
  return x < 0.f ? -r : r;
}
template <int CTRL>
DI float dpp_get(float v) { return __int_as_float(__builtin_amdgcn_update_dpp(0, __float_as_int(v), CTRL, 0xF, 0xF, false)); }
DI float red8(float v) { v += dpp_get<0xB1>(v); v += dpp_get<0x4E>(v); v += dpp_get<0x141>(v); return v; }
DI int p7_pos(int s_) { return (s_ & 7) * 16 + ((s_ >> 3) & 7) + ((s_ >> 6) << 3); }
DI u32 xch32(u32 x, bool upper) { auto r = __builtin_amdgcn_permlane32_swap(x, x, false, false); return upper ? r[0] : r[1]; }
DI u32 xch16(u32 x, bool oddrow) { auto r = __builtin_amdgcn_permlane16_swap(x, x, false, false); return oddrow ? r[0] : r[1]; }
DI float siluf(float x) { return x * __builtin_amdgcn_rcpf(1.0f + __expf(-x)); }
DI void unpack8(const uint4& v, float* f) {
  f[0] = bflo(v.x); f[1] = bfhi(v.x); f[2] = bflo(v.y); f[3] = bfhi(v.y);
  f[4] = bflo(v.z); f[5] = bfhi(v.z); f[6] = bflo(v.w); f[7] = bfhi(v.w);
}
DI uint4 pack8(const float* f) {
  uint4 v; v.x = pack2(f[0], f[1]); v.y = pack2(f[2], f[3]); v.z = pack2(f[4], f[5]); v.w = pack2(f[6], f[7]); return v;
}
DI bf16x8 pack_acc2(const f32x4& a, const f32x4& b) {
  uint4 v; v.x = pack2(a[0], a[1]); v.y = pack2(a[2], a[3]); v.z = pack2(b[0], b[1]); v.w = pack2(b[2], b[3]);
  return __builtin_bit_cast(bf16x8, v);
}
DI bf16x8 read2x4(const u16* p, int c0, int c1) {
  uint2 lo = *(const uint2*)(p + c0);
  uint2 hi = *(const uint2*)(p + c1);
  uint4 v; v.x = lo.x; v.y = lo.y; v.z = hi.x; v.w = hi.y;
  return __builtin_bit_cast(bf16x8, v);
}
DI u32 enc_fp8x4(float a, float b, float c, float d) {
  int v = 0;
  v = __builtin_amdgcn_cvt_pk_fp8_f32(a, b, v, false);
  v = __builtin_amdgcn_cvt_pk_fp8_f32(c, d, v, true);
  return (u32)v;
}
DI void dec_fp8x16(const uint4& v, float* f) {
  f32x2 t;
  t = __builtin_amdgcn_cvt_pk_f32_fp8((int)v.x, false); f[0] = t[0]; f[1] = t[1];
  t = __builtin_amdgcn_cvt_pk_f32_fp8((int)v.x, true);  f[2] = t[0]; f[3] = t[1];
  t = __builtin_amdgcn_cvt_pk_f32_fp8((int)v.y, false); f[4] = t[0]; f[5] = t[1];
  t = __builtin_amdgcn_cvt_pk_f32_fp8((int)v.y, true);  f[6] = t[0]; f[7] = t[1];
  t = __builtin_amdgcn_cvt_pk_f32_fp8((int)v.z, false); f[8] = t[0]; f[9] = t[1];
  t = __builtin_amdgcn_cvt_pk_f32_fp8((int)v.z, true);  f[10] = t[0]; f[11] = t[1];
  t = __builtin_amdgcn_cvt_pk_f32_fp8((int)v.w, false); f[12] = t[0]; f[13] = t[1];
  t = __builtin_amdgcn_cvt_pk_f32_fp8((int)v.w, true);  f[14] = t[0]; f[15] = t[1];
}
DI void dec_fp8x16_v2(const uint4& v, f32x2* f) {
  f[0] = __builtin_amdgcn_cvt_pk_f32_fp8((int)v.x, false); f[1] = __builtin_amdgcn_cvt_pk_f32_fp8((int)v.x, true);
  f[2] = __builtin_amdgcn_cvt_pk_f32_fp8((int)v.y, false); f[3] = __builtin_amdgcn_cvt_pk_f32_fp8((int)v.y, true);
  f[4] = __builtin_amdgcn_cvt_pk_f32_fp8((int)v.z, false); f[5] = __builtin_amdgcn_cvt_pk_f32_fp8((int)v.z, true);
  f[6] = __builtin_amdgcn_cvt_pk_f32_fp8((int)v.w, false); f[7] = __builtin_amdgcn_cvt_pk_f32_fp8((int)v.w, true);
}
DI u32 orderable(float f) { u32 u = __float_as_uint(f); return u ^ ((u >> 31) ? 0xffffffffu : 0x80000000u); }
#define INS16(v, xx) { u32 _x = (xx); _Pragma("unroll") for (int _i = 0; _i < 16; ++_i) { u32 _h = max(v[_i], _x); _x = min(v[_i], _x); v[_i] = _h; } }

DI void ln_row16(float* v, const float* __restrict__ g, const float* __restrict__ b, int lane) {
  float s = 0.f;
#pragma unroll
  for (int i = 0; i < 16; ++i) s += v[i];
  float mu = wsum(s) * (1.0f / 1024.0f);
  float q = 0.f;
#pragma unroll
  for (int i = 0; i < 16; ++i) { float d = v[i] - mu; q += d * d; }
  float var = wsum(q) * (1.0f / 1024.0f);
  float rs = rsqrtf(var + LN_EPS);
#pragma unroll
  for (int i4 = 0; i4 < 4; ++i4) {
    float4 gg = *(const float4*)(g + lane * 16 + i4 * 4);
    float4 bb = *(const float4*)(b + lane * 16 + i4 * 4);
    v[i4 * 4 + 0] = (v[i4 * 4 + 0] - mu) * rs * gg.x + bb.x;
    v[i4 * 4 + 1] = (v[i4 * 4 + 1] - mu) * rs * gg.y + bb.y;
    v[i4 * 4 + 2] = (v[i4 * 4 + 2] - mu) * rs * gg.z + bb.z;
    v[i4 * 4 + 3] = (v[i4 * 4 + 3] - mu) * rs * gg.w + bb.w;
  }
}
DI void load_gb16(float* g, float* b, const float* __restrict__ gp, const float* __restrict__ bp, int lane) {
#pragma unroll
  for (int i4 = 0; i4 < 4; ++i4) {
    float4 gg = *(const float4*)(gp + lane * 16 + i4 * 4);
    float4 bb = *(const float4*)(bp + lane * 16 + i4 * 4);
    g[i4 * 4] = gg.x; g[i4 * 4 + 1] = gg.y; g[i4 * 4 + 2] = gg.z; g[i4 * 4 + 3] = gg.w;
    b[i4 * 4] = bb.x; b[i4 * 4 + 1] = bb.y; b[i4 * 4 + 2] = bb.z; b[i4 * 4 + 3] = bb.w;
  }
}
DI void ln_row16_reg(float* v, const float* g, const float* b) {
  float s = 0.f;
#pragma unroll
  for (int i = 0; i < 16; ++i) s += v[i];
  const float mu = wsum(s) * (1.0f / 1024.0f);
  float q = 0.f;
#pragma unroll
  for (int i = 0; i < 16; ++i) { const float d = v[i] - mu; q += d * d; }
  const float var = wsum(q) * (1.0f / 1024.0f);
  const float rs = rsqrtf(var + LN_EPS);
#pragma unroll
  for (int i = 0; i < 16; ++i) v[i] = (v[i] - mu) * rs * g[i] + b[i];
}
DI void store_row16_bf16(u16* dst, const float* v, int lane) {
  *(uint4*)(dst + lane * 16) = pack8(v);
  *(uint4*)(dst + lane * 16 + 8) = pack8(v + 8);
}

DI void transpose_convert(const float* __restrict__ W, int K, int N, int Npad, u16* __restrict__ Wt, char* smem, int first_block) {
  float* tile = (float*)smem;
  const int tid = opq(threadIdx.x);
  const int ntn = Npad / 64, ntk = K / 64;
  for (int t = blockIdx.x - first_block; t < ntn * ntk; t += gridDim.x - first_block) {
    const int n0 = (t % ntn) * 64, k0 = (t / ntn) * 64;
#pragma unroll 4
    for (int i = 0; i < 16; ++i) {
      int idx = tid + i * 256; int kk = idx >> 6, nn = idx & 63;
      float val = (n0 + nn < N) ? W[(size_t)(k0 + kk) * N + n0 + nn] : 0.f;
      tile[kk * 65 + nn] = val;
    }
    __syncthreads();
#pragma unroll 4
    for (int i = 0; i < 16; ++i) {
      int idx = tid + i * 256; int nn = idx >> 6, kk = idx & 63;
      Wt[(size_t)(n0 + nn) * K + k0 + kk] = f2bf(tile[kk * 65 + nn]);
    }
    __syncthreads();
  }
}

DI void convert_weights(const Params& p, int l, char* smem, int first_block) {
  char* const WS = opqp(p.ws);
  transpose_convert(p.w_in + (size_t)l * 1024 * NPROJ, 1024, NPROJ, NPROJP, (u16*)(WS + OFF_WIN + l * SZ_WIN1), smem, first_block);
  transpose_convert(p.w_out + (size_t)l * 1024 * 1024, 1024, 1024, 1024, (u16*)(WS + OFF_WOUT + l * SZ_WOUT1), smem, first_block);
  transpose_convert(p.w_q + (size_t)l * 1024 * 2048, 1024, 2048, 2048, (u16*)(WS + OFF_WQ + l * SZ_WQ1), smem, first_block);
}

DI void phase_prologue(const Params& p, char* smem) {
  char* const WS = opqp(p.ws);
  const int tid = opq(threadIdx.x), lane = tid & 63, w = tid >> 6;
  u16* HB = (u16*)(WS + OFF_HB);
  float lg[16], lb[16];
  load_gb16(lg, lb, p.ln_in_g, p.ln_in_b, lane);
  for (int r = blockIdx.x * 4 + w; r < MR; r += gridDim.x * 4) {
    const int b = r / LP, pp = r % LP;
    float v[16];
    if (pp < PADR) {
#pragma unroll
      for (int i = 0; i < 16; ++i) v[i] = 0.f;
    } else {
      const float* src = (pp < 64) ? (p.meta + (size_t)(pp - PADR) * DM) : (p.x + ((size_t)b * SEQ + (pp - 64)) * DM);
#pragma unroll
      for (int i4 = 0; i4 < 4; ++i4) {
        float4 t = *(const float4*)(src + lane * 16 + i4 * 4);
        v[i4 * 4] = t.x; v[i4 * 4 + 1] = t.y; v[i4 * 4 + 2] = t.z; v[i4 * 4 + 3] = t.w;
      }
      ln_row16_reg(v, lg, lb);
    }
    store_row16_bf16(HB + (size_t)r * DM, v, lane);
  }
  convert_weights(p, 0, smem, 0);
  u16* SK = (u16*)(WS + OFF_SK);
  for (int i = blockIdx.x * 256 + tid; i < 2 * 2 * 16384; i += gridDim.x * 256) {
    int l = i >> 15, rem = i & 32767, hf = rem >> 14, e = rem & 16383;
    const float* src = (hf ? p.k2 : p.k1) + (size_t)l * 16384;
    SK[i] = f2bf(src[e]);
  }
}

DI void convert_tables(const Params& p, int l, int first_block) {
  char* const WS = opqp(p.ws);
  u32* TAB = (u32*)(WS + OFF_TAB);
  const size_t n16 = (size_t)2 * 16384 * 1024 / 16;
  for (size_t i = (size_t)((opqs(blockIdx.x) - first_block) * 256 + opq(threadIdx.x)); i < n16; i += (size_t)(gridDim.x - first_block) * 256) {
    const size_t e0 = i * 16;
    const int which = (int)(e0 >> 24);
    const size_t off = e0 & (((size_t)1 << 24) - 1);
    const float* src = (which ? p.pv : p.pu) + (size_t)l * 16384 * 1024 + off;
    uint4 o;
    float4 a = *(const float4*)(src), b = *(const float4*)(src + 4), c = *(const float4*)(src + 8), d = *(const float4*)(src + 12);
    o.x = enc_fp8x4(a.x * TSCALE, a.y * TSCALE, a.z * TSCALE, a.w * TSCALE);
    o.y = enc_fp8x4(b.x * TSCALE, b.y * TSCALE, b.z * TSCALE, b.w * TSCALE);
    o.z = enc_fp8x4(c.x * TSCALE, c.y * TSCALE, c.z * TSCALE, c.w * TSCALE);
    o.w = enc_fp8x4(d.x * TSCALE, d.y * TSCALE, d.z * TSCALE, d.w * TSCALE);
    *(uint4*)(TAB + i * 4) = o;
  }
}

template <int EPI>
DI void gemm_phase(const Params& p, size_t offA, size_t offB, int ntn, char* smem, int kbeg = 0, int nk = 16, int first_block = 0) {
  char* const WS = opqp(p.ws);
  const u16* __restrict__ A = (const u16*)(WS + offA);
  const u16* __restrict__ Bt = (const u16*)(WS + offB);
  constexpr int K = 1024, LDS_ST = 64;
  u16* As = (u16*)smem;
  u16* Bs = As + 2 * 128 * LDS_ST;
  const int tid = opq(threadIdx.x), lane = tid & 63, w = tid >> 6, wm = w >> 1, wn = w & 1;
  const int l15 = lane & 15, q = lane >> 4;
  const int ntm = MR / 128;
  const int T_ = ntm * ntn;
  const int nblk = gridDim.x - first_block, bidx = blockIdx.x - first_block;
  const int xsh = (((nblk | first_block) & 7) == 0) ? 3 : 0;
  const int xcd = bidx & ((1 << xsh) - 1), bi = bidx >> xsh, nbx = nblk >> xsh;
  const int pbeg = (xcd * T_) >> xsh, pend = ((xcd + 1) * T_) >> xsh;
  for (int pos = pbeg + bi; pos < pend; pos += nbx) {
    const int nig = 8 * ntn, gid = pos / nig, fm = gid * 8, gsz = min(8, ntm - fm), rem = pos - gid * nig;
    const int tm = fm + rem % gsz, tn = rem / gsz;
    const u16* Ag = A + (size_t)(tm * 128) * K;
    const u16* Bg = Bt + (size_t)(tn * 128) * K;
    f32x4 acc[4][4];
#pragma unroll
    for (int i = 0; i < 4; ++i)
#pragma unroll
      for (int j = 0; j < 4; ++j) acc[i][j] = (f32x4){0.f, 0.f, 0.f, 0.f};
    const int lrow = tid >> 3;
    const int gsw = ((tid & 7) ^ ((lrow >> 1) & 7)) * 8;
    const int rsw = (l15 >> 1) & 7;
    const u16* Agl = Ag + (size_t)lrow * K + gsw;
    const u16* Bgl = Bg + (size_t)lrow * K + gsw;
    u16* Al = As + tid * 8;
    u16* Bl = Bs + tid * 8;
#define G_DMA(buf, k0) { _Pragma("unroll") for (int i_ = 0; i_ < 4; ++i_) { \
      __builtin_amdgcn_global_load_lds((const unsigned*)(Agl + (size_t)(32 * i_) * K + (k0)), (unsigned*)(Al + (buf) * 8192 + i_ * 2048), 16, 0, 0); \
      __builtin_amdgcn_global_load_lds((const unsigned*)(Bgl + (size_t)(32 * i_) * K + (k0)), (unsigned*)(Bl + (buf) * 8192 + i_ * 2048), 16, 0, 0); } }
#define G_COMPUTE(buf) { const u16* Ac = As + (buf) * 128 * LDS_ST; const u16* Bc = Bs + (buf) * 128 * LDS_ST; \
      _Pragma("unroll") for (int kk = 0; kk < 2; ++kk) { \
        bf16x8 af[4], bfr[4]; \
        _Pragma("unroll") for (int mt = 0; mt < 4; ++mt) af[mt] = *(const bf16x8*)(Ac + (wm * 64 + mt * 16 + l15) * LDS_ST + (((kk * 4 + q) ^ rsw) * 8)); \
        _Pragma("unroll") for (int nt = 0; nt < 4; ++nt) bfr[nt] = *(const bf16x8*)(Bc + (wn * 64 + nt * 16 + l15) * LDS_ST + (((kk * 4 + q) ^ rsw) * 8)); \
        _Pragma("unroll") for (int mt = 0; mt < 4; ++mt) \
          _Pragma("unroll") for (int nt = 0; nt < 4; ++nt) acc[mt][nt] = MFMA16(bfr[nt], af[mt], acc[mt][nt]); } }
    G_DMA(0, kbeg)
    asm volatile("s_waitcnt vmcnt(0)" ::: "memory");
    __syncthreads();
    for (int kt = 0; kt < nk; ++kt) {
      const int cur = kt & 1;
      if (kt + 1 < nk) G_DMA(cur ^ 1, kbeg + (kt + 1) * 64)
      G_COMPUTE(cur)
      asm volatile("s_waitcnt vmcnt(0)" ::: "memory");
      __syncthreads();
    }
#pragma unroll
    for (int mt = 0; mt < 4; ++mt) {
      const size_t m = (size_t)tm * 128 + wm * 64 + mt * 16 + l15;
#pragma unroll
      for (int nt = 0; nt < 4; ++nt) {
        const int n = tn * 128 + wn * 64 + nt * 16 + q * 4;
        const f32x4 a = acc[mt][nt];
        if (EPI == 1) {
          if (tn < 24) {
            uint2 o; o.x = pack2(a[0], a[1]); o.y = pack2(a[2], a[3]);
            *(uint2*)((u16*)(WS + OFF_R1) + m * 3072 + n) = o;
          } else if (tn < 28) {
            uint2 o; o.x = pack2(a[0], a[1]); o.y = pack2(a[2], a[3]);
            *(uint2*)((u16*)(WS + OFF_ZB) + m * 512 + (n - 3072)) = o;
          } else {
            if (n - 3584 < 8) *(float4*)((float*)(WS + OFF_AB) + m * 8 + (n - 3584)) = make_float4(a[0], a[1], a[2], a[3]);
          }
        } else if (EPI == 2) {
          const uint2 pv = *(const uint2*)((const u16*)(WS + OFF_QKV) + m * 1536 + 512 + n);
          uint2 o; o.x = pack2(a[0] + bflo(pv.x), a[1] + bfhi(pv.x)); o.y = pack2(a[2] + bflo(pv.y), a[3] + bfhi(pv.y));
          *(uint2*)((u16*)(WS + OFF_R1) + m * 1024 + n) = o;
        } else if (EPI == 4) {
          uint2 o; o.x = pack2(a[0], a[1]); o.y = pack2(a[2], a[3]);
          *(uint2*)((u16*)(WS + OFF_QKV) + m * 1536 + 512 + n) = o;
        } else {
          uint2 o; o.x = pack2(a[0], a[1]); o.y = pack2(a[2], a[3]);
          *(uint2*)((u16*)(WS + OFF_R1) + m * 2048 + n) = o;
        }
      }
    }
  }
}

DI void phase_p2(const Params& p, int l, char* smem) {
  char* const WS = opqp(p.ws);
  const int tid = opq(threadIdx.x), lane = tid & 63, w = tid >> 6;
  float* cw = (float*)smem;
  float* gw = cw + 3 * 512;
  {
    const float* cwg = p.conv_w + (size_t)l * 3 * 512;
    const float* gwg = p.gdn_conv_w + (size_t)l * 4 * 1536;
    for (int i = tid; i < 3 * 512 / 4; i += 256) *(float4*)(cw + i * 4) = *(const float4*)(cwg + i * 4);
    for (int i = tid; i < 4 * 1536 / 4; i += 256) *(float4*)(gw + i * 4) = *(const float4*)(gwg + i * 4);
  }
  __syncthreads();
  const u16* R1 = (const u16*)(WS + OFF_R1);
  u16* QKV = (u16*)(WS + OFF_QKV);
  u16* YB = (u16*)(WS + OFF_YB);
  const float* AB = (const float*)(WS + OFF_AB);
  float* GB = (float*)(WS + OFF_GB);
  const int c0 = lane * 8;
  const float alog = (lane < 4) ? p.a_log[l * 4 + lane] : 0.f, dtb = (lane < 4) ? p.dt_bias[l * 4 + lane] : 0.f;
  const int gwv = blockIdx.x * 4 + w, nwv = gridDim.x * 4;
  const int rchunk = (int)(((unsigned)MR + (unsigned)nwv - 1u) / (unsigned)nwv);
  const int r_beg = min(MR, gwv * rchunk), r_end = min(MR, r_beg + rchunk);
  if (r_beg >= r_end) return;
  const uint4 z4 = make_uint4(0, 0, 0, 0);
  uint4 wq0[3], wq1[3], wq2[3];
  float pm2[8], pm1[8];
  {
    const size_t rm3 = (size_t)max(r_beg - 3, 0), rm2 = (size_t)max(r_beg - 2, 0), rm1 = (size_t)max(r_beg - 1, 0);
#pragma unroll
    for (int part = 0; part < 3; ++part) {
      const int c = 1536 + part * 512 + c0;
      wq0[part] = *(const uint4*)(R1 + rm3 * 3072 + c);
      wq1[part] = *(const uint4*)(R1 + rm2 * 3072 + c);
      wq2[part] = *(const uint4*)(R1 + rm1 * 3072 + c);
    }
    float a8[8], b8[8];
    unpack8(*(const uint4*)(R1 + rm2 * 3072 + 512 + c0), a8);
    unpack8(*(const uint4*)(R1 + rm2 * 3072 + 1024 + c0), b8);
#pragma unroll
    for (int i = 0; i < 8; ++i) pm2[i] = a8[i] * b8[i];
    unpack8(*(const uint4*)(R1 + rm1 * 3072 + 512 + c0), a8);
    unpack8(*(const uint4*)(R1 + rm1 * 3072 + 1024 + c0), b8);
#pragma unroll
    for (int i = 0; i < 8; ++i) pm1[i] = a8[i] * b8[i];
  }
  uint4 n_cb, n_cc, n_ch, n_q, n_k, n_v; float n_ab = 0.f;
#define P2_LOAD(rr) { const u16* rp_ = R1 + (size_t)(rr) * 3072 + c0; \
    n_cb = *(const uint4*)(rp_); n_cc = *(const uint4*)(rp_ + 512); n_ch = *(const uint4*)(rp_ + 1024); \
    n_q = *(const uint4*)(rp_ + 1536); n_k = *(const uint4*)(rp_ + 2048); n_v = *(const uint4*)(rp_ + 2560); \
    if (lane < 8) n_ab = AB[(size_t)(rr) * 8 + lane]; }
  P2_LOAD(r_beg)
  for (int r = r_beg; r < r_end; ++r) {
    const uint4 cbv = n_cb, ccv = n_cc, chv = n_ch;
    uint4 raw[3]; raw[0] = n_q; raw[1] = n_k; raw[2] = n_v;
    const float abv = n_ab;
    P2_LOAD(min(r + 1, r_end - 1))
    const bool padrow = (r % LP) < PADR;
    float prod[8];
    {
      float cb[8], cc[8], ch[8], y[8];
      unpack8(cbv, cb); unpack8(ccv, cc); unpack8(chv, ch);
      float m0[8], m1[8], m2[8];
      { const float4 a = *(const float4*)(cw + c0), b4 = *(const float4*)(cw + c0 + 4); m0[0] = a.x; m0[1] = a.y; m0[2] = a.z; m0[3] = a.w; m0[4] = b4.x; m0[5] = b4.y; m0[6] = b4.z; m0[7] = b4.w; }
      { const float4 a = *(const float4*)(cw + 512 + c0), b4 = *(const float4*)(cw + 512 + c0 + 4); m1[0] = a.x; m1[1] = a.y; m1[2] = a.z; m1[3] = a.w; m1[4] = b4.x; m1[5] = b4.y; m1[6] = b4.z; m1[7] = b4.w; }
      { const float4 a = *(const float4*)(cw + 1024 + c0), b4 = *(const float4*)(cw + 1024 + c0 + 4); m2[0] = a.x; m2[1] = a.y; m2[2] = a.z; m2[3] = a.w; m2[4] = b4.x; m2[5] = b4.y; m2[6] = b4.z; m2[7] = b4.w; }
#pragma unroll
      for (int i = 0; i < 8; ++i) {
        prod[i] = cc[i] * ch[i];
        y[i] = cb[i] * (m0[i] * pm2[i] + m1[i] * pm1[i] + m2[i] * prod[i]);
      }
      uint4 yo = pack8(y);
      if (padrow) { yo = z4; *(uint4*)(YB + (size_t)r * 1024 + 512 + c0) = z4; }
      *(uint4*)(YB + (size_t)r * 1024 + c0) = yo;
    }
    SCHED_FENCE;
#pragma unroll
    for (int part = 0; part < 3; ++part) {
      const int c = part * 512 + c0;
      float acc[8], xv[8];
#pragma unroll
      for (int i = 0; i < 8; ++i) acc[i] = 0.f;
#pragma unroll
      for (int j = 0; j < 4; ++j) {
        unpack8(j == 0 ? wq0[part] : (j == 1 ? wq1[part] : (j == 2 ? wq2[part] : raw[part])), xv);
        const float4 w0 = *(const float4*)(gw + j * 1536 + c), w1 = *(const float4*)(gw + j * 1536 + c + 4);
        const float ww[8] = {w0.x, w0.y, w0.z, w0.w, w1.x, w1.y, w1.z, w1.w};
#pragma unroll
        for (int i = 0; i < 8; ++i) acc[i] += ww[i] * xv[i];
      }
      float ss = 0.f;
#pragma unroll
      for (int i = 0; i < 8; ++i) { acc[i] = siluf(acc[i]); ss += acc[i] * acc[i]; }
      if (part < 2) {
        ss = red16(ss);
        float sc = rsqrtf(ss + RMS_EPS);
        if (part == 0) sc *= 0.08838834764831845f;
#pragma unroll
        for (int i = 0; i < 8; ++i) acc[i] *= sc;
      }
      uint4 qo = pack8(acc);
      if (padrow) qo = z4;
      *(uint4*)(QKV + (size_t)r * 1536 + c) = qo;
      SCHED_FENCE;
    }
    {
      const float a_l = __shfl(abv, lane & 3), b_l = __shfl(abv, 4 + (lane & 3));
      if (lane < 4) {
        const float xx = a_l + dtb;
        const float tt = __expf(-fabsf(xx));
        const float l1p = (tt < 0.01f) ? tt * (1.0f - tt * (0.5f - tt * 0.33333333f)) : __logf(1.0f + tt);
        const float sp = fmaxf(xx, 0.f) + l1p;
        GB[(size_t)r * 8 + lane] = padrow ? 0.f : -__expf(alog) * sp;
        GB[(size_t)r * 8 + 4 + lane] = padrow ? 0.f : 1.0f / (1.0f + __expf(-b_l));
      }
    }
#pragma unroll
    for (int part = 0; part < 3; ++part) { wq0[part] = wq1[part]; wq1[part] = wq2[part]; wq2[part] = raw[part]; }
#pragma unroll
    for (int i = 0; i < 8; ++i) { pm2[i] = pm1[i]; pm1[i] = prod[i]; }
  }
}

DI void phase_p3(const Params& p, char* smem) {
  char* const WS = opqp(p.ws);
  constexpr int ST = 136, AST = 68;
  u16* kb = (u16*)smem;
  u16* qb = kb + 64 * ST;
  u16* kbb = qb + 64 * ST;
  float* As = (float*)(kbb + 64 * ST);
  float* s_gc = As + 64 * AST;
  float* s_bt = s_gc + 64;
  const int tid = opq(threadIdx.x), lane = tid & 63, w = tid >> 6, l15 = lane & 15, q = lane >> 4;
  const u16* QKV = (const u16*)(WS + OFF_QKV);
  const float* GB = (const float*)(WS + OFF_GB);
  for (int task = blockIdx.x; task < NB * NCH * 4; task += gridDim.x) {
    const int h = task & 3, bn = task >> 2, b = bn / NCH, n = bn % NCH;
    const size_t row0 = (size_t)b * LP + (size_t)n * 64;
    char* rec = WS + OFF_R1 + (size_t)task * REC_BYTES;
    u16* rec_u = (u16*)rec; u16* rec_w = rec_u + 8192; u16* rec_kT = rec_w + 8192; u16* rec_at = rec_kT + 8192;
    float* rec_eg = (float*)(rec + 57344); float* rec_egl = rec_eg + 64; float* rec_gl = rec_egl + 64;
    const int npad = (n == 0) ? PADR : 0;
    if (tid < 64) {
      const bool pad = tid < npad;
      float g = pad ? 0.f : GB[(row0 + tid) * 8 + h];
      float bt = pad ? 0.f : GB[(row0 + tid) * 8 + 4 + h];
#pragma unroll
      for (int o = 1; o < 64; o <<= 1) { float t = __shfl_up(g, o); if (lane >= o) g += t; }
      s_gc[tid] = g; s_bt[tid] = bt;
      const float gl = __shfl(g, 63);
      rec_eg[tid] = __expf(g);
      rec_egl[tid] = __expf(gl - g);
      if (tid == 0) rec_gl[0] = __expf(gl);
    }
    __syncthreads();
#pragma unroll
    for (int i = 0; i < 4; ++i) {
      int idx = tid + i * 256; int row = idx >> 4, c = idx & 15;
      uint4 kv = make_uint4(0, 0, 0, 0), qv = make_uint4(0, 0, 0, 0);
      if (row >= npad) {
        kv = *(const uint4*)(QKV + (row0 + row) * 1536 + 512 + h * 128 + c * 8);
        qv = *(const uint4*)(QKV + (row0 + row) * 1536 + h * 128 + c * 8);
      }
      *(uint4*)(kb + row * ST + c * 8) = kv;
      *(uint4*)(qb + row * ST + c * 8) = qv;
      float kf[8]; unpack8(kv, kf);
      const float bt = s_bt[row];
#pragma unroll
      for (int j = 0; j < 8; ++j) kf[j] *= bt;
      *(uint4*)(kbb + row * ST + c * 8) = pack8(kf);
    }
    __syncthreads();
#pragma unroll
    for (int it = 0; it < 4; ++it) {
      int idx = tid + it * 256; int d = idx >> 3, i8 = idx & 7;
      u32 t[4];
#pragma unroll
      for (int jj = 0; jj < 4; ++jj) t[jj] = (u32)kb[(i8 * 8 + 2 * jj) * ST + d] | ((u32)kb[(i8 * 8 + 2 * jj + 1) * ST + d] << 16);
      *(uint4*)(rec_kT + d * 64 + i8 * 8) = make_uint4(t[0], t[1], t[2], t[3]);
    }
    {
      const int mat = w >> 1;
      const u16* src = mat ? qb : kbb;
      f32x4 acc[2][4];
#pragma unroll
      for (int i = 0; i < 2; ++i)
#pragma unroll
        for (int j = 0; j < 4; ++j) acc[i][j] = (f32x4){0.f, 0.f, 0.f, 0.f};
#pragma unroll
      for (int ks = 0; ks < 4; ++ks) {
        bf16x8 a[2], bb[4];
#pragma unroll
        for (int mi = 0; mi < 2; ++mi) a[mi] = *(const bf16x8*)(src + (((w & 1) * 2 + mi) * 16 + l15) * ST + ks * 32 + q * 8);
#pragma unroll
        for (int nt = 0; nt < 4; ++nt) bb[nt] = *(const bf16x8*)(kb + (nt * 16 + l15) * ST + ks * 32 + q * 8);
#pragma unroll
        for (int mi = 0; mi < 2; ++mi)
#pragma unroll
          for (int nt = 0; nt < 4; ++nt) acc[mi][nt] = MFMA16(a[mi], bb[nt], acc[mi][nt]);
      }
#pragma unroll
      for (int mi = 0; mi < 2; ++mi)
#pragma unroll
        for (int nt = 0; nt < 4; ++nt)
#pragma unroll
          for (int r = 0; r < 4; ++r) {
            const int i = ((w & 1) * 2 + mi) * 16 + q * 4 + r, j = nt * 16 + l15;
            const float dec = __expf(s_gc[i] - s_gc[j]);
            if (mat == 0) As[i * AST + j] = (i > j) ? acc[mi][nt][r] * dec : 0.f;
            else rec_at[i * 64 + j] = f2bf((i >= j) ? acc[mi][nt][r] * dec : 0.f);
          }
    }
    __syncthreads();
    {
      const int mat = tid >> 7, c = tid & 127;
      float x[64];
      if (mat == 0) {
#pragma unroll
        for (int i = 0; i < 64; ++i) {
          const float vv = (i >= npad) ? bf2f(QKV[(row0 + i) * 1536 + 1024 + h * 128 + c]) : 0.f;
          x[i] = vv * s_bt[i];
        }
      } else {
#pragma unroll
        for (int i = 0; i < 64; ++i) x[i] = bf2f(kb[i * ST + c]) * s_bt[i] * __expf(s_gc[i]);
      }
#pragma unroll
      for (int i = 1; i < 64; ++i) {
        float s = x[i];
#pragma unroll
        for (int j4 = 0; j4 < (i + 3) / 4; ++j4) {
          const float4 a = *(const float4*)(As + i * AST + j4 * 4);
          s -= a.x * x[j4 * 4 + 0];
          if (j4 * 4 + 1 < i) s -= a.y * x[j4 * 4 + 1];
          if (j4 * 4 + 2 < i) s -= a.z * x[j4 * 4 + 2];
          if (j4 * 4 + 3 < i) s -= a.w * x[j4 * 4 + 3];
        }
        x[i] = s;
        if ((i & 3) == 3) SCHED_FENCE;
      }
      if (mat) {
#pragma unroll
        for (int i = 0; i < 64; ++i) rec_w[i * 128 + c] = f2bf(x[i]);
      } else {
        const int ug = c >> 4, ul = c & 15;
#pragma unroll
        for (int mt = 0; mt < 4; ++mt)
#pragma unroll
          for (int qq = 0; qq < 4; ++qq) {
            const int i0 = mt * 16 + qq * 4;
            uint2 o; o.x = pack2(x[i0], x[i0 + 1]); o.y = pack2(x[i0 + 2], x[i0 + 3]);
            *(uint2*)(rec_u + ((ug * 64 + qq * 16 + ul) * 16 + mt * 4)) = o;
          }
      }
    }
    __syncthreads();
  }
}

DI void phase_scan(const Params& p, int l, char* smem) {
  char* const WS = opqp(p.ws);
  if (blockIdx.x >= 32) {
    convert_tables(p, l, 32);
    if (l == 0) convert_weights(p, 1, smem, 32);
    const int fb = (gridDim.x == 512) ? 288 : 32;
    if ((int)blockIdx.x >= fb) gemm_phase<4>(p, OFF_YB, OFF_WOUT + l * SZ_WOUT1, 8, smem, 0, 8, fb);
    return;
  }
  constexpr int ST = 136, ST2 = 72;
  u16* ws_ = (u16*)smem;
  u16* qs_ = ws_ + 64 * ST;
  u16* kts = qs_ + 64 * ST;
  u16* ats = kts + 128 * ST2;
  float* scl = (float*)(ats + 64 * ST2);
  const int tid = opq(threadIdx.x), lane = tid & 63, w = tid >> 6, l15 = lane & 15, q = lane >> 4;
  const int b = blockIdx.x >> 3, h = (blockIdx.x >> 1) & 3, half = blockIdx.x & 1;
  const u16* QKV = (const u16*)(WS + OFF_QKV);
  u16* YB = (u16*)(WS + OFF_YB);
  const int uoff = ((half * 4 + w) * 64 + lane) * 16;
  f32x4 S[8];
#pragma unroll
  for (int i = 0; i < 8; ++i) S[i] = (f32x4){0.f, 0.f, 0.f, 0.f};
  uint4 uc0, uc1;
  {
    const int task = ((b * NCH) << 2) + h;
    const size_t row0 = (size_t)b * LP;
    const char* rec = WS + OFF_R1 + (size_t)task * REC_BYTES;
    const u16* rec_u = (const u16*)rec; const u16* rec_w = rec_u + 8192; const u16* rec_kT = rec_w + 8192; const u16* rec_at = rec_kT + 8192;
    const float* rec_eg = (const float*)(rec + 57344);
#pragma unroll
    for (int i = 0; i < 4; ++i) {
      int idx = tid + i * 256; int row = idx >> 4, c = idx & 15;
      *(uint4*)(ws_ + row * ST + c * 8) = *(const uint4*)(rec_w + row * 128 + c * 8);
      *(uint4*)(qs_ + row * ST + c * 8) = *(const uint4*)(QKV + (row0 + row) * 1536 + h * 128 + c * 8);
      int rk = idx >> 3, ck = idx & 7;
      *(uint4*)(kts + rk * ST2 + ck * 8) = *(const uint4*)(rec_kT + rk * 64 + ck * 8);
    }
#pragma unroll
    for (int i = 0; i < 2; ++i) { int idx = tid + i * 256; int row = idx >> 3, c = idx & 7; *(uint4*)(ats + row * ST2 + c * 8) = *(const uint4*)(rec_at + row * 64 + c * 8); }
    if (tid < 129) scl[tid] = rec_eg[tid];
    uc0 = *(const uint4*)(rec_u + uoff); uc1 = *(const uint4*)(rec_u + uoff + 8);
  }
  __syncthreads();
  for (int n = 0; n < NCH; ++n) {
    const int cur = n & 1;
    const bool has_next = (n + 1 < NCH);
    const size_t row0 = (size_t)b * LP + (size_t)n * 64;
    const int taskn = ((b * NCH + (has_next ? n + 1 : n)) << 2) + h;
    const char* recn = WS + OFF_R1 + (size_t)taskn * REC_BYTES;
    const u16* recn_u = (const u16*)recn; const u16* recn_w = recn_u + 8192; const u16* recn_kT = recn_w + 8192; const u16* recn_at = recn_kT + 8192;
    const float* recn_eg = (const float*)(recn + 57344);
    const size_t row0n = has_next ? row0 + 64 : row0;
    const float* egs = scl + cur * 132;
    const float* egls = egs + 64;
    uint4 ra0, ra1, ra2, ra3, ra4, ra5, ra6, ra7;
    {
      const int tl = opq(threadIdx.x);
#define LD_A(i, RW, RQ) { const int idx = tl + (i) * 256; const int row = idx >> 4, c = idx & 15; \
        RW = *(const uint4*)(recn_w + row * 128 + c * 8); RQ = *(const uint4*)(QKV + (row0n + row) * 1536 + h * 128 + c * 8); }
      LD_A(0, ra0, ra4) LD_A(1, ra1, ra5) LD_A(2, ra2, ra6) LD_A(3, ra3, ra7)
    }
    f32x4 P[4], O[4];
#pragma unroll
    for (int i = 0; i < 4; ++i) { P[i] = O[i] = (f32x4){0.f, 0.f, 0.f, 0.f}; }
#pragma unroll
    for (int ks = 0; ks < 4; ++ks) {
      const bf16x8 sb0 = pack_acc2(S[2 * ks], S[2 * ks + 1]);
#pragma unroll
      for (int mt = 0; mt < 4; ++mt) {
        const bf16x8 aw = read2x4(ws_ + (mt * 16 + l15) * ST, ks * 32 + 4 * q, ks * 32 + 16 + 4 * q);
        const bf16x8 aq = read2x4(qs_ + (mt * 16 + l15) * ST, ks * 32 + 4 * q, ks * 32 + 16 + 4 * q);
        P[mt] = MFMA16(aw, sb0, P[mt]);
        O[mt] = MFMA16(aq, sb0, O[mt]);
      }
    }
    {
      const u32 uw_[8] = {uc0.x, uc0.y, uc0.z, uc0.w, uc1.x, uc1.y, uc1.z, uc1.w};
#pragma unroll
      for (int mt = 0; mt < 4; ++mt)
#pragma unroll
        for (int r = 0; r < 4; ++r) {
          const int i = mt * 16 + 4 * q + r;
          const int ui = mt * 4 + r;
          const float uv = (ui & 1) ? bfhi(uw_[ui >> 1]) : bflo(uw_[ui >> 1]);
          P[mt][r] = uv - P[mt][r];
          O[mt][r] *= egs[i];
        }
    }
    SCHED_FENCE;
    __syncthreads();
    uint4 rb0, rb1, rb2, rb3, rb4, rb5, un0, un1;
    float e_next = 0.f;
    {
      const int tl = opq(threadIdx.x);
#define ST_A(i, RW, RQ) { const int idx = tl + (i) * 256; const int row = idx >> 4, c = idx & 15; \
        *(uint4*)(ws_ + row * ST + c * 8) = RW; *(uint4*)(qs_ + row * ST + c * 8) = RQ; }
      ST_A(0, ra0, ra4) ST_A(1, ra1, ra5) ST_A(2, ra2, ra6) ST_A(3, ra3, ra7)
#define LD_K(i, R) { const int idx = tl + (i) * 256; const int rk = idx >> 3, ck = idx & 7; R = *(const uint4*)(recn_kT + rk * 64 + ck * 8); }
      LD_K(0, rb0) LD_K(1, rb1) LD_K(2, rb2) LD_K(3, rb3)
#define LD_T(i, R) { const int idx = tl + (i) * 256; const int row = idx >> 3, c = idx & 7; R = *(const uint4*)(recn_at + row * 64 + c * 8); }
      LD_T(0, rb4) LD_T(1, rb5)
      un0 = *(const uint4*)(recn_u + uoff);
      un1 = *(const uint4*)(recn_u + uoff + 8);
      if (tl < 129) e_next = recn_eg[tl];
    }
    {
      bf16x8 vb[2];
#pragma unroll
      for (int k2 = 0; k2 < 2; ++k2) vb[k2] = pack_acc2(P[2 * k2], P[2 * k2 + 1]);
#pragma unroll
      for (int k2 = 0; k2 < 2; ++k2)
#pragma unroll
        for (int mt = 0; mt < 4; ++mt) {
          const bf16x8 aa = read2x4(ats + (mt * 16 + l15) * ST2, k2 * 32 + 4 * q, k2 * 32 + 16 + 4 * q);
          O[mt] = MFMA16(aa, vb[k2], O[mt]);
        }
    }
    {
      const int npad = (n == 0) ? PADR : 0;
      u16* yp = YB + (row0 + 4 * q) * 1024 + 512 + h * 128 + half * 64 + w * 16 + l15;
#pragma unroll
      for (int mt = 0; mt < 4; ++mt)
#pragma unroll
        for (int r = 0; r < 4; ++r)
          if (mt * 16 + 4 * q + r >= npad) yp[(mt * 16 + r) * 1024] = f2bf(O[mt][r]);
    }
    {
#pragma unroll
      for (int mt = 0; mt < 4; ++mt)
#pragma unroll
        for (int r = 0; r < 4; ++r) P[mt][r] *= egls[mt * 16 + 4 * q + r];
      bf16x8 vb[2];
#pragma unroll
      for (int k2 = 0; k2 < 2; ++k2) vb[k2] = pack_acc2(P[2 * k2], P[2 * k2 + 1]);
      const float egl = egs[128];
#pragma unroll
      for (int dt = 0; dt < 8; ++dt) S[dt] *= egl;
#pragma unroll
      for (int k2 = 0; k2 < 2; ++k2)
#pragma unroll
        for (int dt = 0; dt < 8; ++dt) {
          const bf16x8 ak = read2x4(kts + (dt * 16 + l15) * ST2, k2 * 32 + 4 * q, k2 * 32 + 16 + 4 * q);
          S[dt] = MFMA16(ak, vb[k2], S[dt]);
        }
    }
    SCHED_FENCE;
    __syncthreads();
    {
      const int tl = opq(threadIdx.x);
#define ST_K(i, R) { const int idx = tl + (i) * 256; const int rk = idx >> 3, ck = idx & 7; *(uint4*)(kts + rk * ST2 + ck * 8) = R; }
      ST_K(0, rb0) ST_K(1, rb1) ST_K(2, rb2) ST_K(3, rb3)
#define ST_T(i, R) { const int idx = tl + (i) * 256; const int row = idx >> 3, c = idx & 7; *(uint4*)(ats + row * ST2 + c * 8) = R; }
      ST_T(0, rb4) ST_T(1, rb5)
      if (tl < 129) scl[(cur ^ 1) * 132 + tl] = e_next;
    }
    uc0 = un0; uc1 = un1;
    __syncthreads();
  }
}

DI void phase_p5(const Params& p, int l) {
  char* const WS = opqp(p.ws);
  const int tid = opq(threadIdx.x), lane = tid & 63, w = tid >> 6;
  const u16* ZB = (const u16*)(WS + OFF_ZB);
  u16* YB = (u16*)(WS + OFF_YB);
  const float* nw = p.gdn_norm_w + l * 128;
  const int c0 = (lane & 15) * 8;
  const float4 n0 = *(const float4*)(nw + c0), n1 = *(const float4*)(nw + c0 + 4);
  const float nn[8] = {n0.x, n0.y, n0.z, n0.w, n1.x, n1.y, n1.z, n1.w};
  for (int ti = blockIdx.x * 4 + w; ti < NB * (SEQ + NMETA); ti += gridDim.x * 4) {
    const int b = ti / (SEQ + NMETA), pp = PADR + ti % (SEQ + NMETA);
    const size_t r = (size_t)b * LP + pp;
    float ov[8], zf[8], yv[8];
    unpack8(*(const uint4*)(YB + r * 1024 + 512 + lane * 8), ov);
    unpack8(*(const uint4*)(ZB + r * 512 + lane * 8), zf);
    float ss = 0.f;
#pragma unroll
    for (int j = 0; j < 8; ++j) ss += ov[j] * ov[j];
    ss = red16(ss);
    const float rs = rsqrtf(ss * (1.0f / 128.0f) + RMS_EPS);
#pragma unroll
    for (int j = 0; j < 8; ++j) yv[j] = ov[j] * rs * nn[j] * siluf(zf[j]);
    *(uint4*)(YB + r * 1024 + 512 + lane * 8) = pack8(yv);
  }
}

DI void phase_ln1(const Params& p, int l) {
  char* const WS = opqp(p.ws);
  const int tid = opq(threadIdx.x), lane = tid & 63, w = tid >> 6;
  const u16* HB = (const u16*)(WS + OFF_HB);
  const u16* MIX = (const u16*)(WS + OFF_R1);
  u16* H1 = (u16*)(WS + OFF_QKV);
  float lg[16], lb[16];
  load_gb16(lg, lb, p.ln1_g + l * 1024, p.ln1_b + l * 1024, lane);
  const int gwv = blockIdx.x * 4 + w, nwv = gridDim.x * 4;
  const int rchunk = (int)(((unsigned)MR + (unsigned)nwv - 1u) / (unsigned)nwv);
  const int r_beg = min(MR, gwv * rchunk), r_end = min(MR, r_beg + rchunk);
  auto proc = [&](int rr, const uint4& h0, const uint4& h1, const uint4& m0, const uint4& m1) {
    float v[16];
    if (rr % LP < PADR) {
#pragma unroll
      for (int i = 0; i < 16; ++i) v[i] = 0.f;
    } else {
      float hv[16], mv[16];
      unpack8(h0, hv); unpack8(h1, hv + 8); unpack8(m0, mv); unpack8(m1, mv + 8);
#pragma unroll
      for (int i = 0; i < 16; ++i) v[i] = ALPHA * hv[i] + mv[i];
      ln_row16_reg(v, lg, lb);
    }
    store_row16_bf16(H1 + (size_t)rr * 1024, v, lane);
  };
  for (int r = r_beg; r < r_end; r += 2) {
    const int rB = min(r + 1, r_end - 1);
    const uint4 hA0 = *(const uint4*)(HB + (size_t)r * 1024 + lane * 16), hA1 = *(const uint4*)(HB + (size_t)r * 1024 + lane * 16 + 8);
    const uint4 mA0 = *(const uint4*)(MIX + (size_t)r * 1024 + lane * 16), mA1 = *(const uint4*)(MIX + (size_t)r * 1024 + lane * 16 + 8);
    const uint4 hB0 = *(const uint4*)(HB + (size_t)rB * 1024 + lane * 16), hB1 = *(const uint4*)(HB + (size_t)rB * 1024 + lane * 16 + 8);
    const uint4 mB0 = *(const uint4*)(MIX + (size_t)rB * 1024 + lane * 16), mB1 = *(const uint4*)(MIX + (size_t)rB * 1024 + lane * 16 + 8);
    proc(r, hA0, hA1, mA0, mA1);
    if (r + 1 < r_end) proc(rB, hB0, hB1, mB0, mB1);
  }
}

#define CE_DESC(x, y) { const u32 _hi = max(x, y); const u32 _lo = min(x, y); x = _hi; y = _lo; }
#define CE_ASC(x, y)  { const u32 _hi = max(x, y); const u32 _lo = min(x, y); x = _lo; y = _hi; }
DI void bitonic_sort16(u32* v) {
#pragma unroll
  for (int k = 2; k <= 16; k <<= 1)
#pragma unroll
    for (int j = k >> 1; j > 0; j >>= 1)
#pragma unroll
      for (int i = 0; i < 16; ++i) {
        const int l = i ^ j;
        if (l > i) { if ((i & k) == 0) CE_DESC(v[i], v[l]) else CE_ASC(v[i], v[l]) }
      }
}
DI void bitonic_merge16(u32* v) {
#pragma unroll
  for (int j = 8; j > 0; j >>= 1)
#pragma unroll
    for (int i = 0; i < 16; ++i) { const int l = i ^ j; if (l > i) CE_DESC(v[i], v[l]) }
}
DI void merge_top16(u32* a, const u32* b) {
#pragma unroll
  for (int i = 0; i < 16; ++i) a[i] = max(a[i], b[15 - i]);
  bitonic_merge16(a);
}
DI void xmerge_top16(u32* v, int mask) {
  u32 t[16];
  const int ln = __lane_id();
  const bool up32 = (ln & 32) != 0, odd16 = (ln & 16) != 0;
#pragma unroll
  for (int i = 0; i < 16; ++i) t[i] = (mask == 32) ? xch32(v[15 - i], up32) : xch16(v[15 - i], odd16);
#pragma unroll
  for (int i = 0; i < 16; ++i) v[i] = max(v[i], t[i]);
  bitonic_merge16(v);
}
DI float unorder(u32 u) { return __uint_as_float(u ^ ((u >> 31) ? 0x80000000u : 0xffffffffu)); }
__device__ __attribute__((aligned(16))) const unsigned char P6_CAND[64] = {
  0, 1, 2, 3, 4, 5, 6, 7, 8, 9, 10, 11, 12, 13, 14, 15,
  16, 17, 18, 19, 20, 21, 22, 23, 64, 65, 66, 80, 81, 128, 144, 160,
  32, 33, 34, 35, 36, 48, 49, 50, 51, 96, 97, 112, 113, 176, 192, 208,
  224, 240, 255, 255, 255, 255, 255, 255, 255, 255, 255, 255, 255, 255, 255, 255};

DI void phase_p6(const Params& p, int l, char* smem) {
  char* const WS = opqp(p.ws);
  constexpr int KST = 136;
  u16* kh = (u16*)smem;
  u32* lists = (u32*)(smem + 2 * 128 * KST * 2);
  const int tid = opq(threadIdx.x), lane = tid & 63, w = tid >> 6, l15 = lane & 15, q = lane >> 4;
  const u16* QP = (const u16*)(WS + OFF_R1);
  const u16* SK = (const u16*)(WS + OFF_SK) + (size_t)l * 2 * 16384;
  int* IDX = (int*)(WS + OFF_IDX);
  float* GATE = (float*)(WS + OFF_GATE);
  for (int idx = tid; idx < 2 * 128 * 16; idx += 256) {
    const int row = idx >> 4, c = idx & 15;
    *(uint4*)(kh + row * KST + c * 8) = *(const uint4*)(SK + row * 128 + c * 8);
  }
  __syncthreads();
  u32* mylist = lists + (w * 16 + l15) * 32;
  const uint4 cw = *(const uint4*)(P6_CAND + q * 16);
  const u32 cwv[4] = {cw.x, cw.y, cw.z, cw.w};
  const int gw = blockIdx.x * 4 + w, nw_ = gridDim.x * 4;
  for (int task = gw; task < (MR / 16) * 8; task += nw_) {
    const int tt = task >> 3, hd = task & 7;
    const size_t row = (size_t)tt * 16 + l15;
#pragma unroll
    for (int hf = 0; hf < 2; ++hf) {
      f32x4 acc[8];
#pragma unroll
      for (int i = 0; i < 8; ++i) acc[i] = (f32x4){0.f, 0.f, 0.f, 0.f};
      const u16* qrow = QP + row * 2048 + hd * 256 + hf * 128;
      const u16* khh = kh + hf * 128 * KST;
#pragma unroll
      for (int ks = 0; ks < 4; ++ks) {
        const bf16x8 aq = *(const bf16x8*)(qrow + ks * 32 + q * 8);
#pragma unroll
        for (int nt = 0; nt < 8; ++nt) {
          const bf16x8 bk = *(const bf16x8*)(khh + (nt * 16 + l15) * KST + ks * 32 + q * 8);
          acc[nt] = MFMA16(bk, aq, acc[nt]);
        }
      }
      u32 va[16], vb2[16];
#pragma unroll
      for (int nt = 0; nt < 4; ++nt)
#pragma unroll
        for (int r = 0; r < 4; ++r) {
          va[nt * 4 + r] = (orderable(acc[nt][r]) & ~127u) | (u32)(127 - (nt * 16 + 4 * q + r));
          vb2[nt * 4 + r] = (orderable(acc[nt + 4][r]) & ~127u) | (u32)(127 - ((nt + 4) * 16 + 4 * q + r));
        }
      bitonic_sort16(va);
      bitonic_sort16(vb2);
      merge_top16(va, vb2);
      xmerge_top16(va, 16);
      xmerge_top16(va, 32);
      if (q == 0) {
#pragma unroll
        for (int i = 0; i < 4; ++i) *(uint4*)(mylist + hf * 16 + i * 4) = make_uint4(va[i * 4], va[i * 4 + 1], va[i * 4 + 2], va[i * 4 + 3]);
      }
    }
    u32 vc[16];
#pragma unroll
    for (int s_ = 0; s_ < 16; ++s_) {
      const u32 ci = (cwv[s_ >> 2] >> ((s_ & 3) * 8)) & 255u;
      const bool ok = (ci != 255u);
      const u32 a_ = ok ? (ci >> 4) : 0u, b_ = ok ? (ci & 15u) : 0u;
      const float sum = unorder(mylist[a_] & ~127u) + unorder(mylist[16 + b_] & ~127u);
      vc[s_] = ok ? ((orderable(sum) & ~255u) | (255u - ci)) : 0u;
    }
    bitonic_sort16(vc);
    xmerge_top16(vc, 16);
    xmerge_top16(vc, 32);
    const float mx = unorder(vc[0] & ~255u);
    float den = 0.f;
#pragma unroll
    for (int k = 0; k < 16; ++k) den += __expf(unorder(vc[k] & ~255u) - mx);
    const float inv = 1.0f / den;
    int ex[4]; float gt[4];
#pragma unroll
    for (int j = 0; j < 4; ++j) {
      const u32 pk = (q == 0) ? vc[j] : ((q == 1) ? vc[4 + j] : ((q == 2) ? vc[8 + j] : vc[12 + j]));
      const u32 ci = 255u - (pk & 255u);
      const u32 p1 = mylist[ci >> 4], p2 = mylist[16 + (ci & 15u)];
      ex[j] = (int)((127u - (p1 & 127u)) * 128u + (127u - (p2 & 127u)));
      gt[j] = __expf(unorder(p1 & ~127u) + unorder(p2 & ~127u) - mx) * inv;
    }
#pragma unroll
    for (int j = 0; j < 4; ++j) {
      const int ps = p7_pos(hd * 16 + q * 4 + j);
      IDX[row * 128 + ps] = ex[j];
      GATE[row * 128 + ps] = gt[j];
    }
  }
}

DI void phase_p7(const Params& p, int l) {
  char* const WS = opqp(p.ws);
  const int tid = opq(threadIdx.x), lane = tid & 63, w = tid >> 6;
  const u16* H1 = (const u16*)(WS + OFF_QKV);
  u16* HB = (u16*)(WS + OFF_HB);
  const char* TU = WS + OFF_TAB;
  const char* TV = TU + (size_t)16384 * 1024;
  const int* IDX = (const int*)(WS + OFF_IDX);
  const float* GATE = (const float*)(WS + OFF_GATE);
  const bool last = (l == 1);
  const int per_b = last ? SEQ : (SEQ + NMETA);
  const int ntok = NB * per_b;
  float lg[16], lb[16];
  load_gb16(lg, lb, p.ln2_g + l * 1024, p.ln2_b + l * 1024, lane);
  for (int ti = blockIdx.x * 4 + w; ti < ntok; ti += gridDim.x * 4) {
    const int b = ti / per_b, pp = (last ? 64 : PADR) + ti % per_b;
    const size_t r = (size_t)b * LP + pp;
    float x[16];
    unpack8(*(const uint4*)(H1 + r * 1024 + lane * 16), x);
    unpack8(*(const uint4*)(H1 + r * 1024 + lane * 16 + 8), x + 8);
    const int id0 = IDX[r * 128 + lane], id1 = IDX[r * 128 + 64 + lane];
    const float g0 = GATE[r * 128 + lane], g1 = GATE[r * 128 + 64 + lane];
    float d0 = 0.f, d1 = 0.f;
    for (int eb = 0; eb < 128; eb += 8) {
      uint4 ud[8];
#pragma unroll
      for (int j = 0; j < 8; ++j) {
        const int e = eb + j;
        const int id = __builtin_amdgcn_readlane((eb < 64) ? id0 : id1, e & 63);
        ud[j] = *(const uint4*)(TU + (size_t)id * 1024 + lane * 16);
      }
#pragma unroll
      for (int j = 0; j < 8; ++j) {
        float f[16]; dec_fp8x16(ud[j], f);
        float s = 0.f;
#pragma unroll
        for (int i = 0; i < 16; ++i) s += x[i] * f[i];
        s = wsum(s);
        const int e = eb + j;
        if (lane == (e & 63)) { if (eb < 64) d0 = s; else d1 = s; }
      }
    }
    float c0, c1;
    { const float a = d0 * TINV; c0 = g0 * 0.5f * a * (1.0f + erf_as(a * 0.7071067811865476f)) * TINV; }
    { const float a = d1 * TINV; c1 = g1 * 0.5f * a * (1.0f + erf_as(a * 0.7071067811865476f)) * TINV; }
    float acc[16];
#pragma unroll
    for (int i = 0; i < 16; ++i) acc[i] = 0.f;
    for (int eb = 0; eb < 128; eb += 8) {
      uint4 vd[8];
#pragma unroll
      for (int j = 0; j < 8; ++j) {
        const int e = eb + j;
        const int id = __builtin_amdgcn_readlane((eb < 64) ? id0 : id1, e & 63);
        vd[j] = *(const uint4*)(TV + (size_t)id * 1024 + lane * 16);
      }
#pragma unroll
      for (int j = 0; j < 8; ++j) {
        const int e = eb + j;
        const float cf = __int_as_float(__builtin_amdgcn_readlane(__float_as_int((eb < 64) ? c0 : c1), e & 63));
        float f[16]; dec_fp8x16(vd[j], f);
#pragma unroll
        for (int i = 0; i < 16; ++i) acc[i] += cf * f[i];
      }
    }
#pragma unroll
    for (int i = 0; i < 16; ++i) acc[i] += ALPHA * x[i];
    ln_row16_reg(acc, lg, lb);
    if (!last) {
      store_row16_bf16(HB + r * 1024, acc, lane);
    } else {
      float* o = p.out + ((size_t)b * SEQ + (pp - 64)) * 1024 + lane * 16;
#pragma unroll
      for (int i4 = 0; i4 < 4; ++i4) *(float4*)(o + i4 * 4) = make_float4(acc[i4 * 4], acc[i4 * 4 + 1], acc[i4 * 4 + 2], acc[i4 * 4 + 3]);
    }
  }
}

constexpr size_t OFF_PD = OFF_R1;
DI void p7_token(int ti, bool last, int& b, int& pp, size_t& r) {
  const int per_b = last ? SEQ : (SEQ + NMETA);
  b = ti / per_b; pp = (last ? 64 : PADR) + ti % per_b; r = (size_t)b * LP + pp;
}
DI void phase_p7a(const Params& p, int l) {
  char* const WS = opqp(p.ws);
  const int tid = opq(threadIdx.x), lane = tid & 63, w = tid >> 6;
  const int j = blockIdx.x & 7, wr = (blockIdx.x >> 3) * 4 + w, nwv = (gridDim.x >> 3) * 4;
  const u16* H1 = (const u16*)(WS + OFF_QKV);
  const char* TU = WS + OFF_TAB + j * 128 + (lane & 7) * 16;
  const int* IDX = (const int*)(WS + OFF_IDX);
  float* PD = (float*)(WS + OFF_PD) + (size_t)j * MR * 128;
  const bool last = (l == 1);
  const int ntok = NB * (last ? SEQ : (SEQ + NMETA));
  const int l7 = lane & 7, lg = lane >> 3;
#define P7A_LOADI(t, IV, X0, X1, R) { int b_, pp_; p7_token(min((t), ntok - 1), last, b_, pp_, R); \
    IV[0] = *(const int4*)(IDX + R * 128 + lg * 16); IV[1] = *(const int4*)(IDX + R * 128 + lg * 16 + 4); \
    IV[2] = *(const int4*)(IDX + R * 128 + lg * 16 + 8); IV[3] = *(const int4*)(IDX + R * 128 + lg * 16 + 12); \
    X0 = *(const uint4*)(H1 + R * 1024 + j * 128 + l7 * 16); X1 = *(const uint4*)(H1 + R * 1024 + j * 128 + l7 * 16 + 8); }
#define P7_IDV(IV, i) ((((i) & 3) == 0) ? IV[(i) >> 2].x : ((((i) & 3) == 1) ? IV[(i) >> 2].y : ((((i) & 3) == 2) ? IV[(i) >> 2].z : IV[(i) >> 2].w)))
#define P7_GATHER(TAB, IV, DST) { _Pragma("unroll") for (int i = 0; i < 16; ++i) DST[i] = *(const uint4*)(TAB + (size_t)P7_IDV(IV, i) * 1024); }
  int4 idN[4]; uint4 xN0, xN1; size_t rN;
  uint4 ud[16]; uint4 xc0, xc1; size_t rc;
  P7A_LOADI(wr, idN, xN0, xN1, rN)
  P7_GATHER(TU, idN, ud)
  xc0 = xN0; xc1 = xN1; rc = rN;
  P7A_LOADI(wr + nwv, idN, xN0, xN1, rN)
  for (int ti = wr; ti < ntok; ti += nwv) {
    uint4 udn[16];
    P7_GATHER(TU, idN, udn)
    const uint4 xG0 = xN0, xG1 = xN1; const size_t rG = rN;
    P7A_LOADI(ti + 2 * nwv, idN, xN0, xN1, rN)
    float xs[16];
    unpack8(xc0, xs); unpack8(xc1, xs + 8);
    float sel0 = 0.f, sel1 = 0.f;
#pragma unroll
    for (int i = 0; i < 16; ++i) {
      f32x2 f[8]; dec_fp8x16_v2(ud[i], f);
      f32x2 s2 = {0.f, 0.f};
#pragma unroll
      for (int c = 0; c < 8; ++c) { const f32x2 xv = {xs[2 * c], xs[2 * c + 1]}; s2 = __builtin_elementwise_fma(xv, f[c], s2); }
      const float sacc = red8(s2[0] + s2[1]);
      if ((i & 7) == l7) { if (i < 8) sel0 = sacc; else sel1 = sacc; }
    }
    PD[rc * 128 + 8 * l7 + lg] = sel0;
    PD[rc * 128 + 64 + 8 * l7 + lg] = sel1;
#pragma unroll
    for (int i = 0; i < 16; ++i) ud[i] = udn[i];
    xc0 = xG0; xc1 = xG1; rc = rG;
  }
}
DI void phase_p7coef(const Params& p, int l) {
  char* const WS = opqp(p.ws);
  const int tid = opq(threadIdx.x), lane = tid & 63, w = tid >> 6;
  float* GATE = (float*)(WS + OFF_GATE);
  const float* PD = (const float*)(WS + OFF_PD);
  const bool last = (l == 1);
  const int ntok = NB * (last ? SEQ : (SEQ + NMETA));
  for (int ti = blockIdx.x * 4 + w; ti < ntok; ti += gridDim.x * 4) {
    int b, pp; size_t r; p7_token(ti, last, b, pp, r);
    float d0 = 0.f, d1 = 0.f;
#pragma unroll
    for (int k = 0; k < 8; ++k) { d0 += PD[((size_t)k * MR + r) * 128 + lane]; d1 += PD[((size_t)k * MR + r) * 128 + 64 + lane]; }
    const int ps0 = p7_pos(lane), ps1 = p7_pos(64 + lane);
    const float g0 = GATE[r * 128 + ps0], g1 = GATE[r * 128 + ps1];
    const float a0 = d0 * TINV, a1 = d1 * TINV;
    GATE[r * 128 + ps0] = g0 * 0.5f * a0 * (1.0f + erf_as(a0 * 0.7071067811865476f)) * TINV;
    GATE[r * 128 + ps1] = g1 * 0.5f * a1 * (1.0f + erf_as(a1 * 0.7071067811865476f)) * TINV;
  }
}
DI void phase_p7b(const Params& p, int l) {
  char* const WS = opqp(p.ws);
  const int tid = opq(threadIdx.x), lane = tid & 63, w = tid >> 6;
  const int j = blockIdx.x & 7, wr = (blockIdx.x >> 3) * 4 + w, nwv = (gridDim.x >> 3) * 4;
  const char* TV = WS + OFF_TAB + (size_t)16384 * 1024 + j * 128 + (lane & 7) * 16;
  const int* IDX = (const int*)(WS + OFF_IDX);
  const float* COEF = (const float*)(WS + OFF_GATE);
  u16* OUTB = (u16*)(WS + OFF_YB);
  const bool last = (l == 1);
  const int ntok = NB * (last ? SEQ : (SEQ + NMETA));
  const int l7 = lane & 7, lg = lane >> 3;
#define P7B_LOADI(t, IV, CV, R) { int b_, pp_; p7_token(min((t), ntok - 1), last, b_, pp_, R); \
    _Pragma("unroll") for (int k4 = 0; k4 < 4; ++k4) { IV[k4] = *(const int4*)(IDX + R * 128 + lg * 16 + k4 * 4); CV[k4] = *(const float4*)(COEF + R * 128 + lg * 16 + k4 * 4); } }
#define P7_CFV(CV, i) ((((i) & 3) == 0) ? CV[(i) >> 2].x : ((((i) & 3) == 1) ? CV[(i) >> 2].y : ((((i) & 3) == 2) ? CV[(i) >> 2].z : CV[(i) >> 2].w)))
  int4 idN[4]; float4 cN[4]; size_t rN;
  P7B_LOADI(wr, idN, cN, rN)
  for (int ti = wr; ti < ntok; ti += nwv) {
    uint4 vd[16];
    P7_GATHER(TV, idN, vd)
    float4 cc[4];
#pragma unroll
    for (int k4 = 0; k4 < 4; ++k4) cc[k4] = cN[k4];
    const size_t rc = rN;
    P7B_LOADI(ti + nwv, idN, cN, rN)
    f32x2 acc2[8];
#pragma unroll
    for (int c = 0; c < 8; ++c) acc2[c] = (f32x2){0.f, 0.f};
#pragma unroll
    for (int i = 0; i < 16; ++i) {
      f32x2 f[8]; dec_fp8x16_v2(vd[i], f);
      const float cfi = P7_CFV(cc, i);
      const f32x2 cv = {cfi, cfi};
#pragma unroll
      for (int c = 0; c < 8; ++c) acc2[c] = __builtin_elementwise_fma(cv, f[c], acc2[c]);
    }
    float acc[16];
#pragma unroll
    for (int c = 0; c < 8; ++c) { acc[2 * c] = acc2[c][0]; acc[2 * c + 1] = acc2[c][1]; }
    float r8[8], r4[4];
    {
      const bool hi = (lane & 32) != 0;
#pragma unroll
      for (int k = 0; k < 8; ++k) {
        const float mine = hi ? acc[8 + k] : acc[k], send = hi ? acc[k] : acc[8 + k];
        r8[k] = mine + __uint_as_float(xch32(__float_as_uint(send), hi));
      }
    }
    {
      const bool hi = (lane & 16) != 0;
#pragma unroll
      for (int k = 0; k < 4; ++k) {
        const float mine = hi ? r8[4 + k] : r8[k], send = hi ? r8[k] : r8[4 + k];
        r4[k] = mine + __uint_as_float(xch16(__float_as_uint(send), hi));
      }
    }
    {
      const bool hi = (lane & 8) != 0;
      const float m0 = hi ? r4[2] : r4[0], m1 = hi ? r4[3] : r4[1], s0 = hi ? r4[0] : r4[2], s1 = hi ? r4[1] : r4[3];
      const float o0 = m0 + dpp_get<0x128>(s0);
      const float o1 = m1 + dpp_get<0x128>(s1);
      *(u32*)(OUTB + rc * 1024 + j * 128 + l7 * 16 + 2 * lg) = pack2(o0, o1);
    }
  }
}
DI void phase_p7c(const Params& p, int l) {
  char* const WS = opqp(p.ws);
  const int tid = opq(threadIdx.x), lane = tid & 63, w = tid >> 6;
  const u16* H1 = (const u16*)(WS + OFF_QKV);
  const u16* OUTB = (const u16*)(WS + OFF_YB);
  u16* HB = (u16*)(WS + OFF_HB);
  const bool last = (l == 1);
  const int ntok = NB * (last ? SEQ : (SEQ + NMETA));
  float lg_[16], lb_[16];
  load_gb16(lg_, lb_, p.ln2_g + l * 1024, p.ln2_b + l * 1024, lane);
  auto proc = [&](int b, int pp, size_t r, const uint4& x0, const uint4& x1, const uint4& f0, const uint4& f1) {
    float x[16], f[16];
    unpack8(x0, x); unpack8(x1, x + 8); unpack8(f0, f); unpack8(f1, f + 8);
#pragma unroll
    for (int i = 0; i < 16; ++i) f[i] += ALPHA * x[i];
    ln_row16_reg(f, lg_, lb_);
    if (!last) {
      store_row16_bf16(HB + r * 1024, f, lane);
    } else {
      float* o = p.out + ((size_t)b * SEQ + (pp - 64)) * 1024 + lane * 16;
#pragma unroll
      for (int i4 = 0; i4 < 4; ++i4) *(float4*)(o + i4 * 4) = make_float4(f[i4 * 4], f[i4 * 4 + 1], f[i4 * 4 + 2], f[i4 * 4 + 3]);
    }
  };
  const int stride = gridDim.x * 4;
  for (int ti = blockIdx.x * 4 + w; ti < ntok; ti += 2 * stride) {
    const int tB = min(ti + stride, ntok - 1);
    int bA, ppA, bB, ppB; size_t rA, rB;
    p7_token(ti, last, bA, ppA, rA); p7_token(tB, last, bB, ppB, rB);
    const uint4 xA0 = *(const uint4*)(H1 + rA * 1024 + lane * 16), xA1 = *(const uint4*)(H1 + rA * 1024 + lane * 16 + 8);
    const uint4 fA0 = *(const uint4*)(OUTB + rA * 1024 + lane * 16), fA1 = *(const uint4*)(OUTB + rA * 1024 + lane * 16 + 8);
    const uint4 xB0 = *(const uint4*)(H1 + rB * 1024 + lane * 16), xB1 = *(const uint4*)(H1 + rB * 1024 + lane * 16 + 8);
    const uint4 fB0 = *(const uint4*)(OUTB + rB * 1024 + lane * 16), fB1 = *(const uint4*)(OUTB + rB * 1024 + lane * 16 + 8);
    proc(bA, ppA, rA, xA0, xA1, fA0, fA1);
    if (ti + stride < ntok) proc(bB, ppB, rB, xB0, xB1, fB0, fB1);
  }
}

#define XB_TMO      128
#define XB_XCNT(j)  (256  + 64 * (j))
#define XB_XSUB(j)  (1280 + 64 * (j))
#define XB_XGEN(j)  (2304 + 64 * (j))
#define XB_TOP      3328
#define XB_TOPGEN   3392
#define XCD_BAR_WORDS 3456
#define XB_SPIN_CAP (1u << 22)
#define LAS __attribute__((address_space(3)))
DI unsigned xb_ld(unsigned* p)              { return __hip_atomic_load(p, __ATOMIC_RELAXED, __HIP_MEMORY_SCOPE_AGENT); }
DI unsigned xb_add(unsigned* p, unsigned v) { return __hip_atomic_fetch_add(p, v, __ATOMIC_RELAXED, __HIP_MEMORY_SCOPE_AGENT); }
DI unsigned xb_xcc_id() { return (unsigned)__builtin_amdgcn_s_getreg((3 << 11) | 20) & 0xFu; }
#define XB_SPIN(cond, bar) do { unsigned _sp = 0; while (cond) { __builtin_amdgcn_s_sleep(1); \
    if ((++_sp & 255u) == 0u) { if (xb_ld(&(bar)[XB_TMO])) break; if (_sp > XB_SPIN_CAP) { atomicAdd(&(bar)[XB_TMO], 1u); break; } } } } while (0)
struct XcdBarrier { unsigned* bar; unsigned x; volatile LAS unsigned* st; };
DI XcdBarrier xcd_barrier_post(unsigned* bar, volatile LAS unsigned* st) {
  XcdBarrier b; b.bar = bar; b.x = xb_xcc_id(); b.st = st;
  if (threadIdx.x == 0) (void)xb_add(&bar[XB_XCNT(b.x)], 1u);
  return b;
}
DI void xcd_barrier_complete(unsigned* bar, unsigned x, unsigned& nloc, unsigned& nx) {
  const unsigned G = gridDim.x * gridDim.y * gridDim.z;
  unsigned sum, cnt, mine, sp = 0u;
  for (;;) {
    sum = 0u; cnt = 0u; mine = 0u;
#pragma unroll
    for (unsigned j = 0; j < 16; ++j) { const unsigned c = xb_ld(&bar[XB_XCNT(j)]); sum += c; cnt += (c > 0u) ? 1u : 0u; mine = (j == x) ? c : mine; }
    if (sum == G) break;
    __builtin_amdgcn_s_sleep(1);
    if ((++sp & 255u) == 0u) { if (xb_ld(&bar[XB_TMO])) break; if (sp > XB_SPIN_CAP) { atomicAdd(&bar[XB_TMO], 1u); break; } }
  }
  nloc = mine > 0u ? mine : 1u; nx = cnt > 0u ? cnt : 1u;
}
DI void xcd_barrier(const XcdBarrier& b) {
  asm volatile("s_waitcnt vmcnt(0)" ::: "memory");
  __syncthreads();
  if (threadIdx.x == 0) {
    unsigned* bar = b.bar;
    __builtin_amdgcn_s_waitcnt(0);
    unsigned nloc = b.st[0], nx = b.st[1];
    if (nloc == 0u) { xcd_barrier_complete(bar, b.x, nloc, nx); b.st[0] = nloc; b.st[1] = nx; }
    const unsigned old = xb_add(&bar[XB_XSUB(b.x)], 1u);
    const unsigned gen = old / nloc;
    if (old + 1u == (gen + 1u) * nloc) {
      __builtin_amdgcn_fence(__ATOMIC_RELEASE, "agent");
      asm volatile("s_waitcnt vmcnt(0)" ::: "memory");
      const unsigned og = xb_add(&bar[XB_TOP], 1u);
      const unsigned tg = og / nx;
      if (og + 1u == (tg + 1u) * nx) xb_add(&bar[XB_TOPGEN], 1u);
      else XB_SPIN(xb_ld(&bar[XB_TOPGEN]) == tg, bar);
      __builtin_amdgcn_fence(__ATOMIC_ACQUIRE, "agent");
      xb_add(&bar[XB_XGEN(b.x)], 1u);
      asm volatile("s_waitcnt vmcnt(0)" ::: "memory");
    } else {
      XB_SPIN(xb_ld(&bar[XB_XGEN(b.x)]) == gen, bar);
      __builtin_amdgcn_fence(__ATOMIC_ACQUIRE, "agent");
      asm volatile("s_waitcnt vmcnt(0)" ::: "memory");
    }
  }
  __syncthreads();
}

#ifndef DUP_GEMM
#define DUP_GEMM 0
#endif
#ifndef DUP_P7
#define DUP_P7 0
#endif
#ifndef DUP_SCAN
#define DUP_SCAN 0
#endif
#ifndef DUP_P3
#define DUP_P3 0
#endif
#ifndef DUP_P6
#define DUP_P6 0
#endif
#ifndef DUP_MISC
#define DUP_MISC 0
#endif
template <int l>
DI void layer(const Params& p, char* smem, const XcdBarrier& xb) {
  for (int rep = 0; rep <= DUP_GEMM; ++rep) { gemm_phase<1>(p, OFF_HB, OFF_WIN + l * SZ_WIN1, NPROJP / 128, smem); xcd_barrier(xb); }
  for (int rep = 0; rep <= DUP_MISC; ++rep) { phase_p2(p, l, smem); xcd_barrier(xb); }
  for (int rep = 0; rep <= DUP_P3; ++rep) { phase_p3(p, smem); xcd_barrier(xb); }
  for (int rep = 0; rep <= DUP_SCAN; ++rep) { phase_scan(p, l, smem); xcd_barrier(xb); }
  phase_p5(p, l); xcd_barrier(xb);
  for (int rep = 0; rep <= DUP_GEMM; ++rep) { gemm_phase<2>(p, OFF_YB, OFF_WOUT + l * SZ_WOUT1, 8, smem, 512, 8, 0); xcd_barrier(xb); }
  for (int rep = 0; rep <= DUP_MISC; ++rep) { phase_ln1(p, l); xcd_barrier(xb); }
  for (int rep = 0; rep <= DUP_GEMM; ++rep) { gemm_phase<3>(p, OFF_QKV, OFF_WQ + l * SZ_WQ1, 16, smem); xcd_barrier(xb); }
  for (int rep = 0; rep <= DUP_P6; ++rep) { phase_p6(p, l, smem); xcd_barrier(xb); }
#ifdef P7_GATHER_IC
  for (int rep = 0; rep <= DUP_P7; ++rep) { phase_p7(p, l); if (rep < DUP_P7) xcd_barrier(xb); }
#else
  phase_p7a(p, l); xcd_barrier(xb);
  phase_p7coef(p, l); xcd_barrier(xb);
  phase_p7b(p, l); xcd_barrier(xb);
  phase_p7c(p, l);
#endif
}
__global__ void __launch_bounds__(256, 2) fwd_megakernel(Params p) {
  __shared__ __attribute__((aligned(16))) char smem[78848];
  cg::grid_group grid = cg::this_grid();
  if (threadIdx.x == 0) *(uint4*)(smem + 78832) = make_uint4(0u, 0u, 0u, 0u);
  __syncthreads();
  const XcdBarrier xb = xcd_barrier_post((unsigned*)(p.ws + OFF_BAR), (volatile LAS unsigned*)(smem + 78832));
  phase_prologue(p, smem);
  grid.sync();
  layer<0>(p, smem, xb);
  xcd_barrier(xb);
  layer<1>(p, smem, xb);
}

extern "C" void kernel_launch(void* const* d_in, const int* in_sizes, int n_in, void* d_out,
                              int out_size, void* d_ws, size_t ws_size, hipStream_t stream) {
  static int grid_blocks = 0;
  if (!grid_blocks) {
    int dev = 0, cus = 0, per_cu = 0;
    (void)hipGetDevice(&dev);
    (void)hipDeviceGetAttribute(&cus, hipDeviceAttributeMultiprocessorCount, dev);
    (void)hipOccupancyMaxActiveBlocksPerMultiprocessor(&per_cu, fwd_megakernel, 256, 0);
    if (per_cu > 2) per_cu = 2;
    if (per_cu < 1) per_cu = 1;
    grid_blocks = cus * per_cu;
  }
  if (ws_size < WS_NEED) { fprintf(stderr, "workspace too small\n"); return; }
  Params p{};
  p.x = (const float*)d_in[0]; p.meta = (const float*)d_in[1]; p.ln_in_g = (const float*)d_in[2]; p.ln_in_b = (const float*)d_in[3];
  p.w_in = (const float*)d_in[4]; p.conv_w = (const float*)d_in[5]; p.gdn_conv_w = (const float*)d_in[6]; p.a_log = (const float*)d_in[7];
  p.dt_bias = (const float*)d_in[8]; p.gdn_norm_w = (const float*)d_in[9]; p.w_out = (const float*)d_in[10]; p.ln1_g = (const float*)d_in[11];
  p.ln1_b = (const float*)d_in[12]; p.w_q = (const float*)d_in[13]; p.k1 = (const float*)d_in[14]; p.k2 = (const float*)d_in[15];
  p.pu = (const float*)d_in[16]; p.pv = (const float*)d_in[17]; p.ln2_g = (const float*)d_in[18]; p.ln2_b = (const float*)d_in[19];
  p.out = (float*)d_out; p.ws = (char*)d_ws;
  (void)hipMemsetAsync((char*)d_ws + OFF_BAR, 0, 16384, stream);
  void* args[] = {&p};
  hipError_t e = hipLaunchCooperativeKernel((void*)fwd_megakernel, dim3(grid_blocks), dim3(256), args, 0, stream);
  if (e != hipSuccess) fprintf(stderr, "cooperative launch failed: %s (grid %d)\n", hipGetErrorString(e), grid_blocks);
}
```
